# Optimizing an MI355X kernel written in HIP

```python
import jax, jax.numpy as jnp
from jax import lax
import numpy as np

D_MODEL = 4096
BATCH = 2
SEQ = 8192
DEPTH = 2
DEC_BATCH = 8
DEC_SEQ = 16
PAST_LEN = 2048

CHUNK = 64
D_MIX = D_MODEL
D_A = D_MIX // 2
D_B = D_MIX - D_A
HEAD_DIM = 128
H_A = D_A // HEAD_DIM
LRU_BLOCK = 128
H_B = D_B // LRU_BLOCK
CONV_W = 4
LRU_C = 8.0
D_FF = 4 * D_MODEL
N_IN = 4 * D_A + 2 * H_A + 2 * D_B
SPLITS = (3 * D_A, 4 * D_A, 4 * D_A + H_A, 4 * D_A + 2 * H_A, 4 * D_A + 2 * H_A + D_B)
EPS = 1e-6

kernel_name = "hymba_gdn_rglru_stream_step"


def _rmsnorm(x, w):
    xf = x.astype(jnp.float32)
    y = xf * lax.rsqrt(jnp.mean(xf * xf, axis=-1, keepdims=True) + EPS)
    return (y * w.astype(jnp.float32)).astype(x.dtype)


def _l2norm(x):
    xf = x.astype(jnp.float32)
    return xf * lax.rsqrt(jnp.sum(xf * xf, axis=-1, keepdims=True) + EPS)


def _causal_conv(x, prev, w):
    L = x.shape[1]
    xp = jnp.concatenate([prev.astype(x.dtype), x], axis=1)
    y = xp[:, 0:L] * w[0]
    for j in range(1, CONV_W):
        y = y + xp[:, j:j + L] * w[j]
    return y, xp[:, L:]


def _gated_delta_rule(q, k, v, g, beta, s0):
    B, L, H, K = q.shape
    V = v.shape[-1]
    pad = (-L) % CHUNK
    n = (L + pad) // CHUNK

    def blocks(t):
        t = jnp.pad(t, [(0, 0), (0, pad)] + [(0, 0)] * (t.ndim - 2))
        t = jnp.swapaxes(t, 1, 2)
        return t.reshape((B, H, n, CHUNK) + t.shape[3:])

    qc, kc, vc, gc, bc = blocks(q), blocks(k), blocks(v), blocks(g), blocks(beta)
    G = jnp.cumsum(gc, axis=-1)
    idx = jnp.arange(CHUNK)
    causal = idx[:, None] >= idx[None, :]
    strict = idx[:, None] > idx[None, :]
    diff = G[..., :, None] - G[..., None, :]
    decay = jnp.where(causal, jnp.exp(jnp.where(causal, diff, 0.0)), 0.0)
    kb = kc * bc[..., None]
    a_mat = jnp.where(strict, jnp.einsum('bhnik,bhnjk->bhnij', kb, kc) * decay, 0.0)
    rhs = jnp.concatenate([vc * bc[..., None], kb * jnp.exp(G)[..., None]], axis=-1)
    lhs = jnp.eye(CHUNK, dtype=jnp.float32) + a_mat
    sol = lax.linalg.triangular_solve(lhs, rhs, left_side=True, lower=True)
    u, w = sol[..., :V], sol[..., V:]
    qk = jnp.einsum('bhnik,bhnjk->bhnij', qc, kc) * decay
    qg = qc * jnp.exp(G)[..., None]
    kd = kc * jnp.exp(G[..., -1:] - G)[..., None]
    glast = jnp.exp(G[..., -1])

    def step(S, xs):
        u_i, w_i, qk_i, qg_i, kd_i, gl_i = xs
        v_new = u_i - jnp.einsum('bhck,bhkv->bhcv', w_i, S)
        o_i = jnp.einsum('bhck,bhkv->bhcv', qg_i, S) + jnp.einsum('bhij,bhjv->bhiv', qk_i, v_new)
        S = S * gl_i[..., None, None] + jnp.einsum('bhck,bhcv->bhkv', kd_i, v_new)
        return S, o_i

    xs = (jnp.moveaxis(u, 2, 0), jnp.moveaxis(w, 2, 0), jnp.moveaxis(qk, 2, 0),
          jnp.moveaxis(qg, 2, 0), jnp.moveaxis(kd, 2, 0), jnp.moveaxis(glast, 2, 0))
    s_final, o = lax.scan(step, s0, xs)
    o = jnp.moveaxis(o, 0, 2).reshape(B, H, n * CHUNK, V)[:, :, :L]
    return jnp.swapaxes(o, 1, 2), s_final


def _lru_scan(a, b, h0):
    b = b.at[:, 0].add(a[:, 0] * h0)

    def combine(lhs, rhs):
        a_l, b_l = lhs
        a_r, b_r = rhs
        return a_r * a_l, a_r * b_l + b_r

    _, h = lax.associative_scan(combine, (a, b), axis=1)
    return h, h[:, -1]


def _layer(x, conv_d, s_d, conv_l, h_l, p):
    B, L, _ = x.shape
    f32 = jnp.float32
    xn = _rmsnorm(x, p['w_norm_mix'])
    proj = xn @ p['w_in']
    qkv, z, b_logit, a_logit, xl, yl = jnp.split(proj, SPLITS, axis=-1)

    qkv_c, conv_d_new = _causal_conv(qkv, conv_d, p['w_conv_delta'])
    qkv_c = jax.nn.silu(qkv_c).reshape(B, L, 3, H_A, HEAD_DIM)
    q = _l2norm(qkv_c[:, :, 0]) * (HEAD_DIM ** -0.5)
    k = _l2norm(qkv_c[:, :, 1])
    v = qkv_c[:, :, 2].astype(f32)
    beta = jax.nn.sigmoid(b_logit.astype(f32))
    g = -jnp.exp(p['a_log'].astype(f32)) * jax.nn.softplus(a_logit.astype(f32) + p['dt_bias'].astype(f32))
    o, s_d_new = _gated_delta_rule(q, k, v, g, beta, s_d.astype(f32))
    o = _rmsnorm(o, p['w_norm_delta']) * jax.nn.silu(z.astype(f32).reshape(B, L, H_A, HEAD_DIM))
    delta_out = o.reshape(B, L, D_A).astype(x.dtype)

    xc, conv_l_new = _causal_conv(xl, conv_l, p['w_conv_lru'])
    xc = (xc + p['b_conv_lru']).astype(f32).reshape(B, L, H_B, LRU_BLOCK)
    gate_r = jax.nn.sigmoid(jnp.einsum('blhi,hij->blhj', xc, p['w_gate_a'].astype(f32))
                            + p['b_gate_a'].astype(f32).reshape(H_B, LRU_BLOCK))
    gate_i = jax.nn.sigmoid(jnp.einsum('blhi,hij->blhj', xc, p['w_gate_x'].astype(f32))
                            + p['b_gate_x'].astype(f32).reshape(H_B, LRU_BLOCK))
    log_a = -LRU_C * gate_r * jax.nn.softplus(-p['lam'].astype(f32).reshape(H_B, LRU_BLOCK))
    a = jnp.exp(log_a)
    b_in = jnp.sqrt(-jnp.expm1(2.0 * log_a)) * gate_i * xc
    h, h_last = _lru_scan(a.reshape(B, L, D_B), b_in.reshape(B, L, D_B), h_l.astype(f32))
    lru_out = _rmsnorm(jax.nn.gelu(yl.astype(f32)) * h, p['w_norm_lru']).astype(x.dtype)

    x = x + jnp.concatenate([delta_out, lru_out], axis=-1) @ p['w_out']
    hid = jax.nn.relu(_rmsnorm(x, p['w_norm_mlp']) @ p['w_mlp_up'])
    x = x + (hid * hid) @ p['w_mlp_down']
    return x, s_d_new, conv_d_new, h_last, conv_l_new


def _trunk(x, s_d, conv_d, h_l, conv_l, layers, w_norm_final):
    sds, cds, hls, cls = [], [], [], []
    for i in range(DEPTH):
        x, sd, cd, hl, cl = _layer(x, conv_d[i], s_d[i], conv_l[i], h_l[i], layers[i])
        sds.append(sd.astype(x.dtype))
        cds.append(cd.astype(x.dtype))
        hls.append(hl.astype(x.dtype))
        cls.append(cl.astype(x.dtype))
    y = _rmsnorm(x, w_norm_final)
    return y, jnp.stack(sds), jnp.stack(cds), jnp.stack(hls), jnp.stack(cls)


def setup_inputs(seed: int = 0) -> dict:
    key = jax.random.key(seed)
    ks = jax.random.split(key, 26)
    f32 = jnp.float32
    nrm = lambda k, shape, s: jax.random.normal(k, shape, f32) * s
    x_prompt = jax.random.normal(ks[0], (BATCH, SEQ, D_MODEL), f32)
    x_sample = jax.random.normal(ks[1], (DEC_BATCH, DEC_SEQ, D_MODEL), f32)
    state_delta = nrm(ks[2], (DEPTH, DEC_BATCH, H_A, HEAD_DIM, HEAD_DIM), 0.1)
    state_conv_delta = jax.random.normal(ks[3], (DEPTH, DEC_BATCH, CONV_W - 1, 3 * D_A), f32)
    state_lru = nrm(ks[4], (DEPTH, DEC_BATCH, D_B), 0.5)
    state_conv_lru = jax.random.normal(ks[5], (DEPTH, DEC_BATCH, CONV_W - 1, D_B), f32)
    w_norm_mix = 1.0 + nrm(ks[6], (DEPTH, D_MODEL), 0.02)
    w_in = nrm(ks[7], (DEPTH, D_MODEL, N_IN), D_MODEL ** -0.5)
    w_conv_delta = nrm(ks[8], (DEPTH, CONV_W, 3 * D_A), CONV_W ** -0.5)
    a_log = jnp.log(jax.random.uniform(ks[9], (DEPTH, H_A), f32, 1.0, 16.0))
    dt = jnp.exp(jax.random.uniform(ks[10], (DEPTH, H_A), f32, np.log(1e-3), np.log(1e-1)))
    dt_bias = dt + jnp.log(-jnp.expm1(-dt))
    w_norm_delta = 1.0 + nrm(ks[11], (DEPTH, HEAD_DIM), 0.02)
    w_conv_lru = nrm(ks[12], (DEPTH, CONV_W, D_B), CONV_W ** -0.5)
    b_conv_lru = nrm(ks[13], (DEPTH, D_B), 0.02)
    w_gate_a = nrm(ks[14], (DEPTH, H_B, LRU_BLOCK, LRU_BLOCK), LRU_BLOCK ** -0.5)
    b_gate_a = nrm(ks[15], (DEPTH, D_B), 0.02)
    w_gate_x = nrm(ks[16], (DEPTH, H_B, LRU_BLOCK, LRU_BLOCK), LRU_BLOCK ** -0.5)
    b_gate_x = nrm(ks[17], (DEPTH, D_B), 0.02)
    a_max = jax.random.uniform(ks[18], (DEPTH, D_B), f32, 0.9, 0.999)
    s = a_max ** (1.0 / LRU_C)
    lam = jnp.log(s) - jnp.log1p(-s)
    w_norm_lru = 1.0 + nrm(ks[19], (DEPTH, D_B), 0.02)
    w_out = nrm(ks[20], (DEPTH, D_MIX, D_MODEL), D_MIX ** -0.5)
    w_norm_mlp = 1.0 + nrm(ks[21], (DEPTH, D_MODEL), 0.02)
    w_mlp_up = nrm(ks[22], (DEPTH, D_MODEL, D_FF), D_MODEL ** -0.5)
    w_mlp_down = nrm(ks[23], (DEPTH, D_FF, D_MODEL), D_FF ** -0.5)
    w_norm_final = 1.0 + nrm(ks[24], (D_MODEL,), 0.02)
    return {"x_prompt": x_prompt, "x_sample": x_sample,
            "state_delta": state_delta, "state_conv_delta": state_conv_delta,
            "state_lru": state_lru, "state_conv_lru": state_conv_lru,
            "w_norm_mix": w_norm_mix, "w_in": w_in, "w_conv_delta": w_conv_delta,
            "a_log": a_log, "dt_bias": dt_bias, "w_norm_delta": w_norm_delta,
            "w_conv_lru": w_conv_lru, "b_conv_lru": b_conv_lru,
            "w_gate_a": w_gate_a, "b_gate_a": b_gate_a, "w_gate_x": w_gate_x, "b_gate_x": b_gate_x,
            "lam": lam, "w_norm_lru": w_norm_lru, "w_out": w_out,
            "w_norm_mlp": w_norm_mlp, "w_mlp_up": w_mlp_up, "w_mlp_down": w_mlp_down,
            "w_norm_final": w_norm_final}


def reference(x_prompt, x_sample, state_delta, state_conv_delta, state_lru, state_conv_lru,
              w_norm_mix, w_in, w_conv_delta, a_log, dt_bias, w_norm_delta,
              w_conv_lru, b_conv_lru, w_gate_a, b_gate_a, w_gate_x, b_gate_x,
              lam, w_norm_lru, w_out, w_norm_mlp, w_mlp_up, w_mlp_down, w_norm_final):
    layers = [dict(w_norm_mix=w_norm_mix[i], w_in=w_in[i], w_conv_delta=w_conv_delta[i],
                   a_log=a_log[i], dt_bias=dt_bias[i], w_norm_delta=w_norm_delta[i],
                   w_conv_lru=w_conv_lru[i], b_conv_lru=b_conv_lru[i],
                   w_gate_a=w_gate_a[i], b_gate_a=b_gate_a[i],
                   w_gate_x=w_gate_x[i], b_gate_x=b_gate_x[i],
                   lam=lam[i], w_norm_lru=w_norm_lru[i], w_out=w_out[i],
                   w_norm_mlp=w_norm_mlp[i], w_mlp_up=w_mlp_up[i], w_mlp_down=w_mlp_down[i])
              for i in range(DEPTH)]
    bp = x_prompt.shape[0]
    dt_x = x_prompt.dtype
    z_sd = jnp.zeros((DEPTH, bp, H_A, HEAD_DIM, HEAD_DIM), jnp.float32)
    z_cd = jnp.zeros((DEPTH, bp, CONV_W - 1, 3 * D_A), dt_x)
    z_hl = jnp.zeros((DEPTH, bp, D_B), jnp.float32)
    z_cl = jnp.zeros((DEPTH, bp, CONV_W - 1, D_B), dt_x)
    y_prompt, p_delta, p_conv_delta, p_lru, p_conv_lru = _trunk(
        x_prompt, z_sd, z_cd, z_hl, z_cl, layers, w_norm_final)
    y_sample, s_delta, s_conv_delta, s_lru, s_conv_lru = _trunk(
        x_sample, state_delta, state_conv_delta, state_lru, state_conv_lru, layers, w_norm_final)
    return (y_prompt, y_sample, p_delta, p_conv_delta, p_lru, p_conv_lru,
            s_delta, s_conv_delta, s_lru, s_conv_lru)
```

```cpp
#include <hip/hip_runtime.h>
#include <cstdio>
#include <cstdint>
namespace pg8 {
#define PG8_LAS __attribute__((address_space(3)))
typedef unsigned short bf16_t;
typedef short bf16x8 __attribute__((ext_vector_type(8)));
typedef float f32x4 __attribute__((ext_vector_type(4)));
typedef unsigned u32x4 __attribute__((ext_vector_type(4)));
constexpr int BM = 256, BK = 64, HALF = 128, HTB = HALF * BK * 2  , STAGE_BYTES = 8 * HTB, NXCD = 8, WGM = 8;

__host__ __device__ __forceinline__ int lds_byte(int r, int c) { const int st = (r >> 4) * 2 + (c >> 5), rr = r & 15, cc = c & 31, ob = rr * 64 + cc * 2; return st * 1024 + (ob ^ (((ob >> 9) & 1) << 5)); }
__host__ __device__ __forceinline__ void stage_rc(int b, int& R, int& C) { const int st = b / 1024, sb = b % 1024, swz = sb ^ (((sb >> 9) & 1) << 5); R = (st >> 1) * 16 + swz / 64; C = (st & 1) * 32 + (swz % 64) / 2; }
__host__ __device__ __forceinline__ int perm32(int rho) { const int n = rho >> 4, i = rho & 15; return 8 * (i >> 2) + 4 * n + (i & 3); }

struct Unit { int pm, pn; };
struct Gemm { const bf16_t* A; const bf16_t* Bt; int M, N, K; };
struct StaticOrder {
    int nM, nN, nwg, G, c;
    __host__ __device__ void init(int M, int N, int G_, int c_) { nM = M / BM; nN = N / BM; nwg = nM * nN; G = G_; c = c_; }
    __host__ __device__ bool next(int i, Unit& u) const {
        const long L = (long)i * G + c; if (L >= nwg) return false;
        int wgid = (int)L; { const int q = nwg / NXCD, r = nwg % NXCD, xcd = wgid % NXCD, off = wgid / NXCD; wgid = (xcd < r ? xcd * (q + 1) : r * (q + 1) + (xcd - r) * q) + off; }
        const int nig = WGM * nN, gid = wgid / nig, fm = gid * WGM, gsz = (nM - fm) < WGM ? (nM - fm) : WGM;
        u.pm = fm + ((wgid % nig) % gsz); u.pn = (wgid % nig) / gsz; return true;
    }
    __device__ __forceinline__ void a_ready(const Unit&) const {}
    __device__ __forceinline__ void done(const Unit&) const {}
};
__device__ __forceinline__ unsigned cvt_pk_bf16(float lo, float hi) { unsigned r; asm volatile("v_cvt_pk_bf16_f32 %0, %1, %2" : "=v"(r) : "v"(lo), "v"(hi)); return r; }
template <int ACT  > struct EpiBf16 {
    static constexpr bool PERM = true, AFTER_DRAIN = false;
    bf16_t* O; int ldc;
    __device__ __forceinline__ void operator()(const f32x4 (&acc)[2][2][4][2], const Unit& u, int wr, int wc, int fr, int fq) const {
        const int row0 = u.pm * BM + wr * 64 + fr; const int col0 = u.pn * BM + wc * 32 + 8 * fq;
#pragma unroll
        for (int ai = 0; ai < 2; ++ai)
#pragma unroll
            for (int m = 0; m < 4; ++m) { bf16_t* rowp = O + (size_t)(row0 + ai * HALF + m * 16) * ldc + col0;
#pragma unroll
                for (int bj = 0; bj < 2; ++bj) { f32x4 v0 = acc[ai][bj][m][0], v1 = acc[ai][bj][m][1];
                    if (ACT == 1) {
#pragma unroll
                        for (int j = 0; j < 4; ++j) { const float a = fmaxf(v0[j], 0.f), b = fmaxf(v1[j], 0.f); v0[j] = a * a; v1[j] = b * b; } }
                    u32x4 w; w.x = cvt_pk_bf16(v0[0], v0[1]); w.y = cvt_pk_bf16(v0[2], v0[3]); w.z = cvt_pk_bf16(v1[0], v1[1]); w.w = cvt_pk_bf16(v1[2], v1[3]);
                    *(u32x4*)(rowp + bj * HALF) = w; } }
    }
};
struct EpiResid {
    static constexpr bool PERM = false, AFTER_DRAIN = false;
    float* X; int ldc; int mreal;
    __device__ __forceinline__ void operator()(const f32x4 (&acc)[2][2][4][2], const Unit& u, int wr, int wc, int fr, int fq) const {
        const int row0 = u.pm * BM + wr * 64 + fr, col0 = u.pn * BM + wc * 32 + 4 * fq;
#pragma unroll
        for (int ai = 0; ai < 2; ++ai)
#pragma unroll
            for (int m = 0; m < 4; ++m) { const int row = row0 + ai * HALF + m * 16;
                if (row < mreal) { float* rowp = X + (size_t)row * ldc + col0;
                    f32x4 v[2][2];
#pragma unroll
                    for (int bj = 0; bj < 2; ++bj)
#pragma unroll
                        for (int n = 0; n < 2; ++n) v[bj][n] = *(const f32x4*)(rowp + bj * HALF + n * 16);
#pragma unroll
                    for (int bj = 0; bj < 2; ++bj)
#pragma unroll
                        for (int n = 0; n < 2; ++n) *(f32x4*)(rowp + bj * HALF + n * 16) = v[bj][n] + acc[ai][bj][m][n]; }
                asm volatile("" ::: "memory"); }
    }
};
template <class Epi, class Sched, bool ALIGN_EPI = false, bool SP2 = false>
__device__ __forceinline__ void gemm_phase(PG8_LAS unsigned char* lds, const Gemm g, const Sched& S, const Epi& E, const int tid) {
    const int wid = __builtin_amdgcn_readfirstlane(tid >> 6), lane = tid & 63, wr = wid >> 2, wc = wid & 3, fr = lane & 15, fq = lane >> 4;
    const int K = g.K, nt = K / BK;
    unsigned voffA[2], voffB[2];
#pragma unroll
    for (int i = 0; i < 2; ++i) { int R, C; stage_rc(tid * 16 + i * 8192, R, C); const int Rb = Epi::PERM ? ((R & ~31) + perm32(R & 31)) : R;
        voffA[i] = (unsigned)(R * K + C) * 2u; voffB[i] = (unsigned)(Rb * K + C) * 2u; }
    const size_t kstep = (size_t)(BK * 2);
    const size_t hstep = (size_t)HALF * K * 2;
    const size_t tstep = 2 * hstep;
    const unsigned ldsw = (unsigned)wid * 1024u;
    const int aoff = lds_byte(wr * 64 + fr, fq * 8), boff = lds_byte(wc * 32 + fr, fq * 8);
#define PG8_SA(b, h) (((b) * 2 + (h)) * HTB)
#define PG8_SB(b, h) ((4 + (b) * 2 + (h)) * HTB)
#define PG8_STAGE(bufoff, gbase, voff) do { _Pragma("unroll") for (int _i = 0; _i < 2; ++_i) \
        __builtin_amdgcn_global_load_lds((const unsigned*)((const char*)(gbase) + (voff)[_i]), (PG8_LAS unsigned*)(lds + (bufoff) + ldsw + _i * 8192), 16, 0, 0); } while (0)
#define PG8_LDA(dst, b, h) do { _Pragma("unroll") for (int m = 0; m < 4; ++m) _Pragma("unroll") for (int k = 0; k < 2; ++k) dst[m][k] = *(const PG8_LAS bf16x8*)(lds + PG8_SA(b, h) + aoff + m * 2048 + k * 1024); } while (0)
#define PG8_LDB(dst, b, h) do { _Pragma("unroll") for (int n = 0; n < 2; ++n) _Pragma("unroll") for (int k = 0; k < 2; ++k) dst[n][k] = *(const PG8_LAS bf16x8*)(lds + PG8_SB(b, h) + boff + n * 2048 + k * 1024); } while (0)
#define PG8_MMA(ai, bj, At, Bt) do { __builtin_amdgcn_s_setprio(1); _Pragma("unroll") for (int m = 0; m < 4; ++m) _Pragma("unroll") for (int n = 0; n < 2; ++n) _Pragma("unroll") for (int k = 0; k < 2; ++k) \
        acc[ai][bj][m][n] = __builtin_amdgcn_mfma_f32_16x16x32_bf16(Bt[n][k], At[m][k], acc[ai][bj][m][n], 0, 0, 0); __builtin_amdgcn_s_setprio(0); } while (0)
#define PG8_WAIT_V(n) asm volatile("s_waitcnt vmcnt(" #n ")" ::: "memory")
#define PG8_WAIT_L(n) asm volatile("s_waitcnt lgkmcnt(" #n ")" ::: "memory")
#define PG8_BAR __builtin_amdgcn_s_barrier()
#define PG8_SCHED __builtin_amdgcn_sched_barrier(0)
    Unit cur, nxt; int ui = 0;
    if (!S.next(0, cur)) return;
    f32x4 acc[2][2][4][2];
#pragma unroll
    for (int a = 0; a < 2; ++a)
#pragma unroll
        for (int b = 0; b < 2; ++b)
#pragma unroll
            for (int m = 0; m < 4; ++m)
#pragma unroll
                for (int n = 0; n < 2; ++n) acc[a][b][m][n] = (f32x4){0.f, 0.f, 0.f, 0.f};
    bf16x8 At[4][2], B0[2][2], B1[2][2];
    const char* cA = (const char*)g.A + (size_t)cur.pm * tstep; const char* cB = (const char*)g.Bt + (size_t)cur.pn * tstep;
    S.a_ready(cur);
    if constexpr (SP2) {
        PG8_STAGE(PG8_SB(0, 0), cB, voffB); PG8_STAGE(PG8_SB(0, 1), cB + hstep, voffB); PG8_STAGE(PG8_SA(0, 0), cA, voffA); PG8_STAGE(PG8_SA(0, 1), cA + hstep, voffA);
        if (wr == 1) PG8_BAR;
        PG8_WAIT_V(2); PG8_BAR;
        PG8_STAGE(PG8_SB(1, 0), cB + kstep, voffB); PG8_STAGE(PG8_SA(1, 0), cA + kstep, voffA); PG8_STAGE(PG8_SB(1, 1), cB + hstep + kstep, voffB);
        PG8_WAIT_V(6); PG8_BAR;
    } else {
        PG8_STAGE(PG8_SB(0, 0), cB, voffB); PG8_STAGE(PG8_SA(0, 0), cA, voffA); PG8_STAGE(PG8_SB(0, 1), cB + hstep, voffB); PG8_STAGE(PG8_SA(0, 1), cA + hstep, voffA);
        if (wr == 1) PG8_BAR;
        PG8_WAIT_V(4); PG8_BAR;
        PG8_STAGE(PG8_SB(1, 0), cB + kstep, voffB); PG8_STAGE(PG8_SA(1, 0), cA + kstep, voffA); PG8_STAGE(PG8_SB(1, 1), cB + hstep + kstep, voffB);
        PG8_WAIT_V(6); PG8_BAR;
    }
    for (;;) {
        const bool has_next = S.next(ui + 1, nxt);
        const char* nA = has_next ? (const char*)g.A + (size_t)nxt.pm * tstep : cA; const char* nB = has_next ? (const char*)g.Bt + (size_t)nxt.pn * tstep : cB;
        for (int t = 0; t < nt; t += 2) {
            const bool last = (t == nt - 2);
            const char* a1 = cA + (size_t)(t + 1) * kstep;
            const char* a2 = last ? nA : cA + (size_t)(t + 2) * kstep; const char* b2 = last ? nB : cB + (size_t)(t + 2) * kstep;
            const char* a3 = a2 + kstep; const char* b3 = b2 + kstep;
            if (last && has_next) S.a_ready(nxt);
            if constexpr (SP2) {
            PG8_LDB(B0, 0, 0); PG8_LDB(B1, 0, 1); PG8_SCHED; PG8_LDA(At, 0, 0); PG8_STAGE(PG8_SA(1, 1), a1 + hstep, voffA);
            PG8_WAIT_V(8); PG8_WAIT_L(0); PG8_BAR; PG8_MMA(0, 0, At, B0); PG8_MMA(0, 1, At, B1); PG8_BAR; PG8_SCHED;
            PG8_LDA(At, 0, 1); PG8_STAGE(PG8_SB(0, 0), b2, voffB); PG8_STAGE(PG8_SB(0, 1), b2 + hstep, voffB); PG8_STAGE(PG8_SA(0, 0), a2, voffA);
            PG8_WAIT_V(8); PG8_WAIT_L(0); PG8_BAR; PG8_MMA(1, 0, At, B0); PG8_MMA(1, 1, At, B1); PG8_BAR; PG8_SCHED;
            PG8_LDB(B0, 1, 0); PG8_LDB(B1, 1, 1); PG8_SCHED; PG8_LDA(At, 1, 0); PG8_STAGE(PG8_SA(0, 1), a2 + hstep, voffA);
            PG8_WAIT_V(8); PG8_WAIT_L(0); PG8_BAR; PG8_MMA(0, 0, At, B0); PG8_MMA(0, 1, At, B1); PG8_BAR; PG8_SCHED;
            PG8_LDA(At, 1, 1); PG8_STAGE(PG8_SB(1, 0), b3, voffB); PG8_STAGE(PG8_SB(1, 1), b3 + hstep, voffB); PG8_STAGE(PG8_SA(1, 0), a3, voffA);
            PG8_WAIT_V(8); PG8_WAIT_L(0); PG8_BAR; PG8_MMA(1, 0, At, B0); PG8_MMA(1, 1, At, B1); PG8_BAR; PG8_SCHED;
            } else {
            PG8_LDB(B0, 0, 0); PG8_SCHED; PG8_LDA(At, 0, 0); PG8_STAGE(PG8_SA(1, 1), a1 + hstep, voffA);
            PG8_WAIT_L(8); PG8_BAR; PG8_WAIT_L(0); PG8_MMA(0, 0, At, B0); PG8_BAR; PG8_SCHED;
            PG8_LDB(B1, 0, 1); PG8_STAGE(PG8_SB(0, 0), b2, voffB);
            PG8_BAR; PG8_WAIT_L(0); PG8_MMA(0, 1, At, B1); PG8_BAR;
            PG8_LDA(At, 0, 1); PG8_STAGE(PG8_SA(0, 0), a2, voffA);
            PG8_BAR; PG8_WAIT_L(0); PG8_MMA(1, 0, At, B0); PG8_BAR; PG8_SCHED;
            PG8_STAGE(PG8_SB(0, 1), b2 + hstep, voffB);
            PG8_WAIT_V(6); PG8_BAR; PG8_MMA(1, 1, At, B1); PG8_BAR;
            PG8_LDB(B0, 1, 0); PG8_SCHED; PG8_LDA(At, 1, 0); PG8_STAGE(PG8_SA(0, 1), a2 + hstep, voffA);
            PG8_WAIT_L(8); PG8_BAR; PG8_WAIT_L(0); PG8_MMA(0, 0, At, B0); PG8_BAR; PG8_SCHED;
            PG8_LDB(B1, 1, 1); PG8_STAGE(PG8_SB(1, 0), b3, voffB);
            PG8_BAR; PG8_WAIT_L(0); PG8_MMA(0, 1, At, B1); PG8_BAR;
            PG8_LDA(At, 1, 1); PG8_STAGE(PG8_SA(1, 0), a3, voffA);
            PG8_BAR; PG8_WAIT_L(0); PG8_MMA(1, 0, At, B0); PG8_BAR; PG8_SCHED;
            PG8_STAGE(PG8_SB(1, 1), b3 + hstep, voffB);
            PG8_WAIT_V(6); PG8_BAR; PG8_MMA(1, 1, At, B1); PG8_BAR;
            }
        }
        if constexpr (ALIGN_EPI) { if (wr == 0) PG8_BAR; }
        if constexpr (!Epi::AFTER_DRAIN) { E(acc, cur, wr, wc, fr, fq); S.done(cur); }
        if (!has_next) break;
#pragma unroll
        for (int a = 0; a < 2; ++a)
#pragma unroll
            for (int b = 0; b < 2; ++b)
#pragma unroll
                for (int m = 0; m < 4; ++m)
#pragma unroll
                    for (int n = 0; n < 2; ++n) acc[a][b][m][n] = (f32x4){0.f, 0.f, 0.f, 0.f};
        cur = nxt; cA = nA; cB = nB; ++ui;
        if constexpr (ALIGN_EPI) { if (wr == 1) PG8_BAR; }
    }
    PG8_WAIT_V(0);
    if constexpr (!ALIGN_EPI) { if (wr == 0) PG8_BAR; }
    PG8_BAR;
    if constexpr (Epi::AFTER_DRAIN) { E.fused(acc, cur, wr, wc, fr, fq, lds, wid, lane); S.done(cur); }
#undef PG8_SA
#undef PG8_SB
#undef PG8_STAGE
#undef PG8_LDA
#undef PG8_LDB
#undef PG8_MMA
#undef PG8_WAIT_V
#undef PG8_WAIT_L
#undef PG8_BAR
#undef PG8_SCHED
}
}
constexpr int D = 4096, MP = 16384, MS = 128, MR = MP + MS, MPAD = 16640;
constexpr int SEQ = 8192, NBP = 2, NBS = 8, LS = 16, NCH = SEQ / 64;
constexpr int DA = 2048, DB = 2048, NH = 16, DFF = 16384, QKV = 6144;
constexpr int NIN = 12320, NINP = 12544;
constexpr int C_Q = 0, C_K = 2048, C_V = 4096, C_Z = 6144, C_XL = 8192, C_YL = 10240, C_BL = 12288, C_AL = 12304;
constexpr float EPS = 1e-6f;
constexpr int NWAVES = 8, NTHR = 512;
constexpr int NUNIT_P = 4096, NUNIT = 4224;
constexpr size_t O_YP = 0, O_YS = O_YP + (size_t)MP * D, O_PD = O_YS + (size_t)MS * D, O_PCD = O_PD + (size_t)2 * NBP * NH * 128 * 128, O_PL = O_PCD + (size_t)2 * NBP * 3 * QKV,
    O_PCL = O_PL + (size_t)2 * NBP * DB, O_SD = O_PCL + (size_t)2 * NBP * 3 * DB, O_SCD = O_SD + (size_t)2 * NBS * NH * 128 * 128, O_SL = O_SCD + (size_t)2 * NBS * 3 * QKV,
    O_SCL = O_SL + (size_t)2 * NBS * DB, O_END = O_SCL + (size_t)2 * NBS * 3 * DB;
static_assert(O_END == 73408512, "d_out map");
constexpr size_t AL(size_t x) { return (x + 4095) & ~(size_t)4095; }
constexpr size_t WS_CTL = 0, CTL_ZERO_BYTES = 1u << 20;
constexpr size_t WS_WIN = CTL_ZERO_BYTES, WS_WOUT = WS_WIN + AL((size_t)NINP * D * 2), WS_WUP = WS_WOUT + AL((size_t)D * D * 2), WS_WDN = WS_WUP + AL((size_t)DFF * D * 2),
    WS_WG = WS_WDN + AL((size_t)D * DFF * 2), WS_XN = WS_WG + AL((size_t)2 * NH * 128 * 128 * 2), WS_PROJ = WS_XN + AL((size_t)MPAD * D * 2), WS_MIX = WS_PROJ + AL((size_t)MPAD * NINP * 2),
    WS_HIN = WS_MIX + AL((size_t)MPAD * D * 2), WS_OV = WS_HIN + AL((size_t)NBP * NCH * DB * 4);
constexpr size_t DF_U = 0, DF_NEGW = 32768, DF_QG = 49152, DF_QK = 65536, DF_KDT = 73728, DF_GL = 90112, DF_STRIDE = 90368;
constexpr size_t WS_DF = WS_OV, WS_O = WS_DF + AL((size_t)NUNIT * DF_STRIDE), WS_HLOC = WS_O + AL((size_t)MR * DA * 4), WS_CUM = WS_HLOC + AL((size_t)MR * DB * 4), WS_END1 = WS_CUM + AL((size_t)MR * DB * 4);
constexpr size_t WS_HID = WS_OV, WS_END2 = WS_HID + AL((size_t)MPAD * DFF * 2);
constexpr size_t WS_END = WS_END1 > WS_END2 ? WS_END1 : WS_END2;
static_assert(WS_END <= 2147483648ull, "d_ws map");
constexpr int CW_BAR = 4096;
constexpr int RING_BYTES = 131072, LDSCTL_OFF = 139264, MISC_OFF = LDSCTL_OFF + 320, LDS_BYTES = 147456;
constexpr int L_QN = 0, L_KN = 17408, L_KT = 34816, L_VT = 53248, L_KK = 71680, L_QKT = 88064, L_TU = 104448, L_TW = 113664, L_SC = 122880;
constexpr int L_XCB = 0, L_XCF = 17408, L_AS = L_XCF + 33792, L_BS = L_AS + 33792, L_SEG = L_BS + 33792;
static_assert(L_SEG + 4096 <= LDSCTL_OFF && L_SC + 1024 <= LDSCTL_OFF, "LDS map");

#define GAS __attribute__((address_space(1)))
#define LAS __attribute__((address_space(3)))
#define DI __device__ __forceinline__
typedef unsigned short bf16;
typedef unsigned v4u __attribute__((ext_vector_type(4)));
typedef unsigned v2u __attribute__((ext_vector_type(2)));
typedef float f32x4 __attribute__((ext_vector_type(4)));
typedef short bf16x8 __attribute__((ext_vector_type(8)));
typedef GAS unsigned gu32;
#define RLX_AGENT __ATOMIC_RELAXED, __HIP_MEMORY_SCOPE_AGENT
#define LDS_WAIT() asm volatile("s_waitcnt lgkmcnt(0)" ::: "memory")
#define VM_WAIT() asm volatile("s_waitcnt vmcnt(0)" ::: "memory")
#define MFMA16(a, b, c) __builtin_amdgcn_mfma_f32_16x16x32_bf16((a), (b), (c), 0, 0, 0)
DI unsigned f2bf(float f) { unsigned u = __builtin_bit_cast(unsigned, f); return (u + 0x7fffu + ((u >> 16) & 1u)) >> 16; }
DI unsigned pk2(float lo, float hi) { return f2bf(lo) | (f2bf(hi) << 16); }
DI float bflo(unsigned w) { return __builtin_bit_cast(float, w << 16); }
DI float bfhi(unsigned w) { return __builtin_bit_cast(float, w & 0xffff0000u); }
DI float bf2f(bf16 b) { return __builtin_bit_cast(float, (unsigned)b << 16); }
DI f32x4 bf4_to_f32(v2u w) { return (f32x4){bflo(w.x), bfhi(w.x), bflo(w.y), bfhi(w.y)}; }
DI float sigmoid_(float x) { return 1.f / (1.f + __expf(-x)); }
DI float silu_(float x) { return x / (1.f + __expf(-x)); }
DI float softplus_(float x) { return x > 20.f ? x : log1pf(__expf(x)); }
DI float gelu_tanh_(float x) { return x / (1.f + __expf(-1.5957691216057308f * (x + 0.044715f * x * x * x))); }
DI float wave_sum(float v) {
#pragma unroll
    for (int o = 1; o < 64; o <<= 1) v += __shfl_xor(v, o);
    return v;
}
DI bf16x8 pack8(f32x4 a, f32x4 b) { v4u p; p.x = pk2(a[0], a[1]); p.y = pk2(a[2], a[3]); p.z = pk2(b[0], b[1]); p.w = pk2(b[2], b[3]); return __builtin_bit_cast(bf16x8, p); }
#define XB_TMO      128
#define XB_XCNT(j)  (256  + 64 * (j))
#define XB_XSUB(j)  (1280 + 64 * (j))
#define XB_XGEN(j)  (2304 + 64 * (j))
#define XB_TOP      3328
#define XB_TOPGEN   3392
#define XCD_BAR_WORDS 3456
#define XB_SPIN_CAP (1u << 18)

__device__ __forceinline__ unsigned xb_ld(unsigned* p)              { return __hip_atomic_load(p, __ATOMIC_RELAXED, __HIP_MEMORY_SCOPE_AGENT); }
__device__ __forceinline__ unsigned xb_add(unsigned* p, unsigned v) { return __hip_atomic_fetch_add(p, v, __ATOMIC_RELAXED, __HIP_MEMORY_SCOPE_AGENT); }
__device__ __forceinline__ unsigned xb_xcc_id() { return (unsigned)__builtin_amdgcn_s_getreg((3 << 11) | 20) & 0xFu; }
#define XB_SPIN(cond, bar) do { unsigned _sp = 0; while (cond) { __builtin_amdgcn_s_sleep(1); \
    if ((++_sp & 255u) == 0u) { if (xb_ld(&(bar)[XB_TMO])) break; if (_sp > XB_SPIN_CAP) { atomicAdd(&(bar)[XB_TMO], 1u); break; } } } } while (0)

struct XcdBarrier {
    unsigned* bar; unsigned x;
    volatile LAS unsigned* st;
};

__device__ __forceinline__ XcdBarrier xcd_barrier_post(unsigned* bar, volatile LAS unsigned* st) {
    XcdBarrier b; b.bar = bar; b.x = xb_xcc_id(); b.st = st;
    if (threadIdx.x == 0) (void)xb_add(&bar[XB_XCNT(b.x)], 1u);
    return b;
}
__device__ __forceinline__ void xcd_barrier_complete(unsigned* bar, unsigned x, unsigned& nloc, unsigned& nx) {
    const unsigned G = gridDim.x * gridDim.y * gridDim.z;
    unsigned sum, cnt, mine, sp = 0u;
    for (;;) {
        sum = 0u; cnt = 0u; mine = 0u;
#pragma unroll
        for (unsigned j = 0; j < 16; ++j) { const unsigned c = xb_ld(&bar[XB_XCNT(j)]); sum += c; cnt += (c > 0u) ? 1u : 0u; mine = (j == x) ? c : mine; }
        if (sum == G) break;
        __builtin_amdgcn_s_sleep(1);
        if ((++sp & 255u) == 0u) { if (xb_ld(&bar[XB_TMO])) break; if (sp > XB_SPIN_CAP) { atomicAdd(&bar[XB_TMO], 1u); break; } }
    }
    nloc = mine > 0u ? mine : 1u; nx = cnt > 0u ? cnt : 1u;
}

__device__ __forceinline__ void xcd_barrier(const XcdBarrier& b) {
    asm volatile("s_waitcnt vmcnt(0)" ::: "memory");
    __syncthreads();
    if (threadIdx.x == 0) {
        unsigned* bar = b.bar;
        __builtin_amdgcn_s_waitcnt(0);
        unsigned nloc = b.st[0], nx = b.st[1];
        if (nloc == 0u) { xcd_barrier_complete(bar, b.x, nloc, nx); b.st[0] = nloc; b.st[1] = nx; }
        const unsigned old = xb_add(&bar[XB_XSUB(b.x)], 1u);
        const unsigned gen = old / nloc;
        if (old + 1u == (gen + 1u) * nloc) {
            __builtin_amdgcn_fence(__ATOMIC_RELEASE, "agent");
            asm volatile("s_waitcnt vmcnt(0)" ::: "memory");
            const unsigned og = xb_add(&bar[XB_TOP], 1u);
            const unsigned tg = og / nx;
            if (og + 1u == (tg + 1u) * nx) xb_add(&bar[XB_TOPGEN], 1u);
            else XB_SPIN(xb_ld(&bar[XB_TOPGEN]) == tg, bar);
            __builtin_amdgcn_fence(__ATOMIC_ACQUIRE, "agent");
            xb_add(&bar[XB_XGEN(b.x)], 1u);
            asm volatile("s_waitcnt vmcnt(0)" ::: "memory");
        } else {
            XB_SPIN(xb_ld(&bar[XB_XGEN(b.x)]) == gen, bar);
            __builtin_amdgcn_fence(__ATOMIC_ACQUIRE, "agent");
            asm volatile("s_waitcnt vmcnt(0)" ::: "memory");
        }
    }
    __syncthreads();
}
struct Args { const float* in[25]; float* out; unsigned char* ws; int ph_lo, ph_hi; };

DI void transpose_item(const float* W, int ldw, int k0, int n0src, bf16* WT, int K, int n0dst, LAS float* scr, int lane) {
#pragma unroll 8
    for (int i = 0; i < 32; ++i) { const int kk = 2 * i + (lane >> 5); scr[kk * 33 + (lane & 31)] = *(const GAS float*)(W + (size_t)(k0 + kk) * ldw + n0src + (lane & 31)); }
    LDS_WAIT(); asm volatile("" ::: "memory");
    const int c = lane & 7;
#pragma unroll
    for (int j = 0; j < 4; ++j) { const int n = (lane >> 3) + 8 * j; const LAS float* s = scr + (8 * c) * 33 + n;
        v4u o; o.x = pk2(s[0 * 33], s[1 * 33]); o.y = pk2(s[2 * 33], s[3 * 33]); o.z = pk2(s[4 * 33], s[5 * 33]); o.w = pk2(s[6 * 33], s[7 * 33]);
        *(GAS v4u*)(WT + (size_t)(n0dst + n) * K + k0 + 8 * c) = o; }
    LDS_WAIT(); asm volatile("" ::: "memory");
}
DI void rmsnorm_row(const float* xrow, const float* w, bf16* orow, float* xcopy, int lane) {
    const GAS f32x4* xr = (const GAS f32x4*)xrow + lane; const GAS f32x4* wr = (const GAS f32x4*)w + lane;
    f32x4 v[16]; float s = 0.f;
#pragma unroll
    for (int j = 0; j < 16; ++j) { v[j] = xr[64 * j]; s += (v[j].x * v[j].x + v[j].y * v[j].y) + (v[j].z * v[j].z + v[j].w * v[j].w); }
    const float rstd = rsqrtf(wave_sum(s) * (1.f / D) + EPS);
    if (xcopy) { GAS f32x4* xc = (GAS f32x4*)xcopy + lane;
#pragma unroll
        for (int j = 0; j < 16; ++j) xc[64 * j] = v[j]; }
    GAS v2u* o8 = (GAS v2u*)orow + lane;
#pragma unroll
    for (int j = 0; j < 16; ++j) { const f32x4 g = wr[64 * j]; v2u o; o.x = pk2(v[j].x * rstd * g.x, v[j].y * rstd * g.y); o.y = pk2(v[j].z * rstd * g.z, v[j].w * rstd * g.w); o8[64 * j] = o; }
}
DI void norm_phase(const float* xp, const float* xs, float* X, bool first, const float* w, bf16* XN, int gw, int NGW, int lane) {
    for (int m = gw; m < MPAD; m += NGW) {
        if (m < MR) { const float* src = first ? (m < MP ? xp + (size_t)m * D : xs + (size_t)(m - MP) * D) : X + (size_t)m * D;
            rmsnorm_row(src, w, XN + (size_t)m * D, first ? X + (size_t)m * D : nullptr, lane); }
        else { GAS v4u* o = (GAS v4u*)(XN + (size_t)m * D) + lane;
#pragma unroll
            for (int j = 0; j < 8; ++j) o[64 * j] = (v4u){0u, 0u, 0u, 0u}; }
    }
}
DI void p0_weights(const Args& a, int l, LAS unsigned char* lds, int gw, int NGW, int wave, int lane) {
    LAS float* scr = (LAS float*)(lds + wave * 16384);
    bf16* WIN = (bf16*)(a.ws + WS_WIN); bf16* WOUT = (bf16*)(a.ws + WS_WOUT); bf16* WUP = (bf16*)(a.ws + WS_WUP); bf16* WDN = (bf16*)(a.ws + WS_WDN); bf16* WG = (bf16*)(a.ws + WS_WG);
    const float* w_in = a.in[7] + (size_t)l * D * NIN; const float* w_out = a.in[20] + (size_t)l * D * D; const float* w_up = a.in[22] + (size_t)l * D * DFF; const float* w_dn = a.in[23] + (size_t)l * DFF * D;
    constexpr int I_IN = 64 * 385, I_OUT = 64 * 128, I_UP = 64 * 512, I_DN = 256 * 128, I_G = 2 * NH * 8;
    constexpr int NITEMS = I_IN + I_OUT + I_UP + I_DN + I_G;
    for (int it = gw; it < NITEMS; it += NGW) {
        int r = it;
        if (r < I_IN) { const int kb = r / 385, nb = r % 385; const int nsrc = nb < 256 ? nb : (nb < 384 ? nb + 1 : 256);
            transpose_item(w_in, NIN, 64 * kb, 32 * nsrc, WIN, D, 32 * nb, scr, lane); continue; } r -= I_IN;
        if (r < I_OUT) { transpose_item(w_out, D, 64 * (r / 128), 32 * (r % 128), WOUT, D, 32 * (r % 128), scr, lane); continue; } r -= I_OUT;
        if (r < I_UP) { transpose_item(w_up, DFF, 64 * (r / 512), 32 * (r % 512), WUP, D, 32 * (r % 512), scr, lane); continue; } r -= I_UP;
        if (r < I_DN) { transpose_item(w_dn, D, 64 * (r / 128), 32 * (r % 128), WDN, DFF, 32 * (r % 128), scr, lane); continue; } r -= I_DN;
        { const int gm = r >> 3, sub = r & 7;
          const float* src = (gm < NH ? a.in[14] : a.in[16]) + ((size_t)l * NH + (gm & 15)) * 128 * 128;
          transpose_item(src, 128, 64 * (sub >> 2), 32 * (sub & 3), WG + (size_t)gm * 128 * 128, 128, 32 * (sub & 3), scr, lane); }
    }
    { const int gt = gw * 64 + lane, NT = NGW * 64; GAS v4u* z = (GAS v4u*)(WIN + (size_t)NIN * D);
      for (int i = gt; i < (NINP - NIN) * D / 8; i += NT) z[i] = (v4u){0u, 0u, 0u, 0u}; }
}

DI void unit_decode(int u, bool& samp, int& b, int& n, int& h, int& rowbase, int& L) {
    samp = u >= NUNIT_P;
    if (!samp) { b = u >> 11; n = (u >> 4) & 127; h = u & 15; rowbase = b * SEQ + n * 64; L = 64; }
    else { const int s = u - NUNIT_P; b = s >> 4; h = s & 15; n = 0; rowbase = MP + b * LS; L = LS; }
}
DI void delta_prepass_unit(const Args& a, int l, int u, LAS unsigned char* lds, int tid) {
    asm volatile("" : "+v"(tid)); const int lane = tid & 63, wave = __builtin_amdgcn_readfirstlane(tid >> 6);
    bool samp; int b, n, h, rowbase, L; unit_decode(u, samp, b, n, h, rowbase, L);
    const bf16* PROJ = (const bf16*)(a.ws + WS_PROJ);
    unsigned char* rec = a.ws + WS_DF + (size_t)u * DF_STRIDE;
    LAS float* SCB = (LAS float*)(lds + L_SC); LAS float* SCG = SCB + 64; LAS float* RK2 = SCB + 128; LAS float* QQ2 = SCB + 192;
    const int fr = lane & 15, fq = lane >> 4;
    if (tid < 384) {
        const int p = tid >> 7, cq = tid & 31, rs = (tid >> 5) & 3, t0 = rs * 16;
        const int col = p * 2048 + h * 128 + 4 * cq;
        const float* wc = a.in[8] + (size_t)l * 4 * QKV + col;
        const f32x4 w0 = *(const GAS f32x4*)(wc), w1 = *(const GAS f32x4*)(wc + QKV), w2 = *(const GAS f32x4*)(wc + 2 * QKV), w3 = *(const GAS f32x4*)(wc + 3 * QKV);
        const float* cst = a.in[3] + ((size_t)(l * NBS + b) * 3) * QKV + col;
        f32x4 xr[19];
#pragma unroll
        for (int i = 0; i < 19; ++i) { const int tl = t0 - 3 + i;
            if (tl >= L) xr[i] = (f32x4){0.f, 0.f, 0.f, 0.f};
            else if (tl >= 0 || (!samp && n > 0)) xr[i] = bf4_to_f32(*(const GAS v2u*)(PROJ + (size_t)(rowbase + tl) * NINP + col));
            else if (samp) xr[i] = *(const GAS f32x4*)(cst + (size_t)(3 + tl) * QKV);
            else xr[i] = (f32x4){0.f, 0.f, 0.f, 0.f}; }
        unsigned tp[4][8];
#pragma unroll
        for (int r = 0; r < 16; ++r) {
            f32x4 y = w0 * xr[r] + w1 * xr[r + 1] + w2 * xr[r + 2] + w3 * xr[r + 3];
            f32x4 s; s.x = silu_(y.x); s.y = silu_(y.y); s.z = silu_(y.z); s.w = silu_(y.w);
            if (t0 + r >= L) s = (f32x4){0.f, 0.f, 0.f, 0.f};
            const unsigned b0 = f2bf(s.x), b1 = f2bf(s.y), b2 = f2bf(s.z), b3 = f2bf(s.w);
            if (p < 2) { v2u o; o.x = b0 | (b1 << 16); o.y = b2 | (b3 << 16); *(LAS v2u*)(lds + (p == 0 ? L_QN : L_KN) + (t0 + r) * 272 + 8 * cq) = o; }
            if (r & 1) { tp[0][r >> 1] |= b0 << 16; tp[1][r >> 1] |= b1 << 16; tp[2][r >> 1] |= b2 << 16; tp[3][r >> 1] |= b3 << 16; }
            else { tp[0][r >> 1] = b0; tp[1][r >> 1] = b1; tp[2][r >> 1] = b2; tp[3][r >> 1] = b3; }
        }
        if (p >= 1) { const int base = (p == 1 ? L_KT : L_VT);
#pragma unroll
            for (int e = 0; e < 4; ++e) { LAS v4u* d = (LAS v4u*)(lds + base + (4 * cq + e) * 144 + t0 * 2);
                d[0] = (v4u){tp[e][0], tp[e][1], tp[e][2], tp[e][3]}; d[1] = (v4u){tp[e][4], tp[e][5], tp[e][6], tp[e][7]}; } }
    } else if (wave == 7) {
        const bool valid = lane < L; const size_t row = (size_t)(rowbase + (valid ? lane : 0));
        const float bl = bf2f(*(const GAS bf16*)(PROJ + row * NINP + C_BL + h)), al = bf2f(*(const GAS bf16*)(PROJ + row * NINP + C_AL + h));
        const float beta = valid ? sigmoid_(bl) : 0.f;
        float g = valid ? -__expf(a.in[9][l * NH + h]) * softplus_(al + a.in[10][l * NH + h]) : 0.f;
#pragma unroll
        for (int o = 1; o < 64; o <<= 1) { const float t = __shfl_up(g, o); if (lane >= o) g += t; }
        SCB[lane] = beta; SCG[lane] = g;
        if (lane == 63) *(GAS float*)(rec + DF_GL) = __expf(g);
    }
    __syncthreads();
    {
        const int m = wave >> 1, n0 = 2 * (wave & 1);
        bf16x8 ak[4];
#pragma unroll
        for (int s = 0; s < 4; ++s) ak[s] = *(const LAS bf16x8*)(lds + L_KN + (16 * m + fr) * 272 + 16 * fq + 64 * s);
#pragma unroll
        for (int nn = 0; nn < 2; ++nn) { const int nt = n0 + nn;
            f32x4 kk = {0.f, 0.f, 0.f, 0.f}, qk = {0.f, 0.f, 0.f, 0.f};
#pragma unroll
            for (int s = 0; s < 4; ++s) { const bf16x8 bk = *(const LAS bf16x8*)(lds + L_KN + (16 * nt + fr) * 272 + 16 * fq + 64 * s), bq = *(const LAS bf16x8*)(lds + L_QN + (16 * nt + fr) * 272 + 16 * fq + 64 * s);
                kk = MFMA16(ak[s], bk, kk); qk = MFMA16(ak[s], bq, qk); }
#pragma unroll
            for (int r = 0; r < 4; ++r) { ((LAS float*)(lds + L_KK))[(16 * m + 4 * fq + r) * 64 + 16 * nt + fr] = kk[r]; ((LAS float*)(lds + L_QKT))[(16 * m + 4 * fq + r) * 64 + 16 * nt + fr] = qk[r];
                if (nt == m && 4 * fq + r == fr) RK2[16 * m + fr] = kk[r]; } }
        if (wave < 4) { f32x4 qq = {0.f, 0.f, 0.f, 0.f};
#pragma unroll
            for (int s = 0; s < 4; ++s) { const bf16x8 aq = *(const LAS bf16x8*)(lds + L_QN + (16 * wave + fr) * 272 + 16 * fq + 64 * s); qq = MFMA16(aq, aq, qq); }
#pragma unroll
            for (int r = 0; r < 4; ++r) if (4 * fq + r == fr) QQ2[16 * wave + fr] = qq[r]; }
    }
    __syncthreads();
#pragma unroll
    for (int e = 0; e < 8; ++e) { const int idx = tid + 512 * e, i = idx >> 6, j = idx & 63; LAS float* p = (LAS float*)(lds + L_KK) + idx;
        const float v = (i > j) ? SCB[i] * rsqrtf(RK2[i] + EPS) * rsqrtf(RK2[j] + EPS) * (*p) * __expf(SCG[i] - SCG[j]) : 0.f; *p = v; }
    __syncthreads();
    if (wave == 0) {
        int zoff = 0; asm volatile("v_mov_b32 %0, 0" : "=v"(zoff));
        const LAS float* As = (const LAS float*)(lds + L_KK) + zoff;
        float Tc[64];
#pragma unroll
        for (int i = 0; i < 64; ++i) { float acc = (i == lane) ? 1.f : 0.f;
#pragma unroll
            for (int j = 0; j < i; ++j) acc -= As[i * 64 + j] * Tc[j];
            Tc[i] = acc; }
        const float bj = SCB[lane], wj = bj * rsqrtf(RK2[lane] + EPS) * __expf(SCG[lane]);
#pragma unroll
        for (int i = 0; i < 64; ++i) { *(LAS bf16*)(lds + L_TU + i * 144 + 2 * lane) = (bf16)f2bf(Tc[i] * bj); *(LAS bf16*)(lds + L_TW + i * 144 + 2 * lane) = (bf16)f2bf(Tc[i] * wj); }
    } else {
        const float glast = SCG[63];
        for (int f = wave - 1; f < 40; f += 7) {
            float v[8]; size_t dst;
            if (f < 8) { const int mi = f >> 1, s2 = f & 1, i = 16 * mi + fr; const float si = rsqrtf(QQ2[i] + EPS) * 0.08838834764831845f, Gi = SCG[i];
#pragma unroll
                for (int e = 0; e < 8; ++e) { const int j = 16 * (2 * s2 + (e >> 2)) + 4 * fq + (e & 3);
                    v[e] = (i >= j) ? si * rsqrtf(RK2[j] + EPS) * ((const LAS float*)(lds + L_QKT))[j * 64 + i] * __expf(Gi - SCG[j]) : 0.f; }
                dst = DF_QK + (size_t)(f * 64 + lane) * 16;
            } else if (f < 24) { const int ff = f - 8, m = ff >> 1, s2 = ff & 1, kd = 16 * m + fr;
#pragma unroll
                for (int hh = 0; hh < 2; ++hh) { const int j0 = 16 * (2 * s2 + hh) + 4 * fq; const v2u w = *(const LAS v2u*)(lds + L_KT + kd * 144 + 2 * j0);
                    const f32x4 kv = bf4_to_f32(w);
#pragma unroll
                    for (int e = 0; e < 4; ++e) v[4 * hh + e] = kv[e] * rsqrtf(RK2[j0 + e] + EPS) * __expf(glast - SCG[j0 + e]); }
                dst = DF_KDT + (size_t)(ff * 64 + lane) * 16;
            } else { const int ff = f - 24, mi = ff >> 2, s = ff & 3, i = 16 * mi + fr; const float sc = rsqrtf(QQ2[i] + EPS) * 0.08838834764831845f * __expf(SCG[i]);
#pragma unroll
                for (int hh = 0; hh < 2; ++hh) { const int k0 = 16 * (2 * s + hh) + 4 * fq; const v2u w = *(const LAS v2u*)(lds + L_QN + i * 272 + 2 * k0);
                    const f32x4 qv = bf4_to_f32(w);
#pragma unroll
                    for (int e = 0; e < 4; ++e) v[4 * hh + e] = qv[e] * sc; }
                dst = DF_QG + (size_t)(ff * 64 + lane) * 16;
            }
            v4u o; o.x = pk2(v[0], v[1]); o.y = pk2(v[2], v[3]); o.z = pk2(v[4], v[5]); o.w = pk2(v[6], v[7]);
            *(GAS v4u*)(rec + dst) = o;
        }
    }
    __syncthreads();
    {
        bf16x8 bv[2];
#pragma unroll
        for (int s2 = 0; s2 < 2; ++s2) bv[s2] = *(const LAS bf16x8*)(lds + L_VT + (16 * wave + fr) * 144 + 16 * fq + 64 * s2);
#pragma unroll
        for (int mi = 0; mi < 4; ++mi) { f32x4 acc = {0.f, 0.f, 0.f, 0.f};
#pragma unroll
            for (int s2 = 0; s2 < 2; ++s2) { const bf16x8 at = *(const LAS bf16x8*)(lds + L_TU + (16 * mi + fr) * 144 + 16 * fq + 64 * s2); acc = MFMA16(at, bv[s2], acc); }
            *(GAS f32x4*)(rec + DF_U + (size_t)((wave * 4 + mi) * 64 + lane) * 16) = acc; }
        const int s = wave & 3, ni0 = 2 * (wave >> 2);
        bf16x8 ak[2][2];
#pragma unroll
        for (int hh = 0; hh < 2; ++hh)
#pragma unroll
            for (int s2 = 0; s2 < 2; ++s2) ak[hh][s2] = *(const LAS bf16x8*)(lds + L_KT + (16 * (2 * s + hh) + fr) * 144 + 16 * fq + 64 * s2);
#pragma unroll
        for (int nn = 0; nn < 2; ++nn) { const int ni = ni0 + nn; f32x4 c0 = {0.f, 0.f, 0.f, 0.f}, c1 = {0.f, 0.f, 0.f, 0.f};
#pragma unroll
            for (int s2 = 0; s2 < 2; ++s2) { const bf16x8 bt = *(const LAS bf16x8*)(lds + L_TW + (16 * ni + fr) * 144 + 16 * fq + 64 * s2); c0 = MFMA16(ak[0][s2], bt, c0); c1 = MFMA16(ak[1][s2], bt, c1); }
            *(GAS bf16x8*)(rec + DF_NEGW + (size_t)((ni * 4 + s) * 64 + lane) * 16) = pack8(-c0, -c1); }
    }
    __syncthreads();
}

DI void lru_prepass_unit(const Args& a, int l, int u, LAS unsigned char* lds, int tid) {
    asm volatile("" : "+v"(tid)); const int lane = tid & 63, wave = __builtin_amdgcn_readfirstlane(tid >> 6);
    bool samp; int b, n, g, rowbase, L; unit_decode(u, samp, b, n, g, rowbase, L);
    const bf16* PROJ = (const bf16*)(a.ws + WS_PROJ); const bf16* WG = (const bf16*)(a.ws + WS_WG);
    float* HLOC = (float*)(a.ws + WS_HLOC); float* CUM = (float*)(a.ws + WS_CUM);
    const int fr = lane & 15, fq = lane >> 4;
    LAS float* XCF = (LAS float*)(lds + L_XCF); LAS float* AS = (LAS float*)(lds + L_AS); LAS float* BS = (LAS float*)(lds + L_BS); LAS float* SEGA = (LAS float*)(lds + L_SEG); LAS float* SEGB = SEGA + 512;
    {
        const int cq = tid & 31, rs = tid >> 5, t0 = rs * 4, ch = g * 128 + 4 * cq, col = C_XL + ch;
        const float* wc = a.in[12] + (size_t)l * 4 * DB + ch;
        const f32x4 w0 = *(const GAS f32x4*)(wc), w1 = *(const GAS f32x4*)(wc + DB), w2 = *(const GAS f32x4*)(wc + 2 * DB), w3 = *(const GAS f32x4*)(wc + 3 * DB), bc = *(const GAS f32x4*)(a.in[13] + (size_t)l * DB + ch);
        const float* cst = a.in[5] + ((size_t)(l * NBS + b) * 3) * DB + ch;
        f32x4 xr[7];
#pragma unroll
        for (int i = 0; i < 7; ++i) { const int tl = t0 - 3 + i;
            if (tl >= L) xr[i] = (f32x4){0.f, 0.f, 0.f, 0.f};
            else if (tl >= 0 || (!samp && n > 0)) xr[i] = bf4_to_f32(*(const GAS v2u*)(PROJ + (size_t)(rowbase + tl) * NINP + col));
            else if (samp) xr[i] = *(const GAS f32x4*)(cst + (size_t)(3 + tl) * DB);
            else xr[i] = (f32x4){0.f, 0.f, 0.f, 0.f}; }
#pragma unroll
        for (int r = 0; r < 4; ++r) { const f32x4 y = w0 * xr[r] + w1 * xr[r + 1] + w2 * xr[r + 2] + w3 * xr[r + 3] + bc;
            v2u o; o.x = pk2(y.x, y.y); o.y = pk2(y.z, y.w); *(LAS v2u*)(lds + L_XCB + (t0 + r) * 272 + 8 * cq) = o; *(LAS f32x4*)(XCF + (t0 + r) * 132 + 4 * cq) = y; }
    }
    __syncthreads();
    {
        f32x4 acc[2][4];
#pragma unroll
        for (int gt = 0; gt < 2; ++gt) { bf16x8 bw[4];
#pragma unroll
            for (int s = 0; s < 4; ++s) bw[s] = *(const GAS bf16x8*)(WG + ((size_t)(gt * NH + g) * 128 + 16 * wave + fr) * 128 + 32 * s + 8 * fq);
#pragma unroll
            for (int mi = 0; mi < 4; ++mi) { f32x4 c = {0.f, 0.f, 0.f, 0.f};
#pragma unroll
                for (int s = 0; s < 4; ++s) { const bf16x8 ax = *(const LAS bf16x8*)(lds + L_XCB + (16 * mi + fr) * 272 + 16 * fq + 64 * s); c = MFMA16(ax, bw[s], c); }
                acc[gt][mi] = c; } }
        const int j = 16 * wave + fr, ch = g * 128 + j;
        const float ba = a.in[15][(size_t)l * DB + ch], bx = a.in[17][(size_t)l * DB + ch], c8 = -8.f * softplus_(-a.in[18][(size_t)l * DB + ch]);
#pragma unroll
        for (int mi = 0; mi < 4; ++mi)
#pragma unroll
            for (int r = 0; r < 4; ++r) { const int t = 16 * mi + 4 * fq + r; const float xc = XCF[t * 132 + j];
                const float gr = sigmoid_(acc[0][mi][r] + ba), gi = sigmoid_(acc[1][mi][r] + bx), la = c8 * gr;
                float av = __expf(la), bvv = sqrtf(fmaxf(-expm1f(2.f * la), 0.f)) * gi * xc;
                if (t >= L) { av = 1.f; bvv = 0.f; }
                AS[t * 132 + j] = av; BS[t * 132 + j] = bvv; }
    }
    __syncthreads();
    {
        const int j = tid & 127, seg = tid >> 7; float P = 1.f, H = 0.f;
#pragma unroll
        for (int r = 0; r < 16; ++r) { const int t = seg * 16 + r; const float av = AS[t * 132 + j], bvv = BS[t * 132 + j]; H = av * H + bvv; P *= av; AS[t * 132 + j] = P; BS[t * 132 + j] = H; }
        SEGA[seg * 128 + j] = P; SEGB[seg * 128 + j] = H;
        __syncthreads();
        float Pc = 1.f, Hc = 0.f;
        for (int s = 0; s < seg; ++s) { Hc = SEGA[s * 128 + j] * Hc + SEGB[s * 128 + j]; Pc *= SEGA[s * 128 + j]; }
#pragma unroll
        for (int r = 0; r < 16; ++r) { const int t = seg * 16 + r; if (t < L) { const float pa = AS[t * 132 + j], hb = BS[t * 132 + j]; const size_t o = (size_t)(rowbase + t) * DB + g * 128 + j; *(GAS float*)(HLOC + o) = hb + pa * Hc; *(GAS float*)(CUM + o) = Pc * pa; } }
    }
    __syncthreads();
}

DI void delta_seq_task(const Args& a, int l, bool samp, int b, int h, int vs, int lane) {
    const int fr = lane & 15, fq = lane >> 4;
    float* O = (float*)(a.ws + WS_O);
    f32x4 S[8];
    const int nchunk = samp ? 1 : NCH;
    if (samp) { const float* s0 = a.in[2] + ((size_t)(l * NBS + b) * NH + h) * 128 * 128;
#pragma unroll
        for (int m = 0; m < 8; ++m)
#pragma unroll
            for (int r = 0; r < 4; ++r) S[m][r] = *(const GAS float*)(s0 + (size_t)(16 * m + 4 * fq + r) * 128 + 16 * vs + fr); }
    else {
#pragma unroll
        for (int m = 0; m < 8; ++m) S[m] = (f32x4){0.f, 0.f, 0.f, 0.f}; }
    for (int n = 0; n < nchunk; ++n) {
        const int u = samp ? NUNIT_P + b * NH + h : (b << 11) + (n << 4) + h;
        const unsigned char* rec = a.ws + WS_DF + (size_t)u * DF_STRIDE + (size_t)lane * 16;
        const int rowbase = samp ? MP + b * LS : b * SEQ + n * 64;
        bf16x8 Sb[4];
#pragma unroll
        for (int s = 0; s < 4; ++s) Sb[s] = pack8(S[2 * s], S[2 * s + 1]);
        f32x4 vn[4], o[4];
#pragma unroll
        for (int mi = 0; mi < 4; ++mi) { vn[mi] = *(const GAS f32x4*)(rec + DF_U + (size_t)((vs * 4 + mi) * 64) * 16);
#pragma unroll
            for (int s = 0; s < 4; ++s) vn[mi] = MFMA16(*(const GAS bf16x8*)(rec + DF_NEGW + (size_t)((mi * 4 + s) * 64) * 16), Sb[s], vn[mi]); }
#pragma unroll
        for (int mi = 0; mi < 4; ++mi) { o[mi] = (f32x4){0.f, 0.f, 0.f, 0.f};
#pragma unroll
            for (int s = 0; s < 4; ++s) o[mi] = MFMA16(*(const GAS bf16x8*)(rec + DF_QG + (size_t)((mi * 4 + s) * 64) * 16), Sb[s], o[mi]); }
        bf16x8 Vb[2];
#pragma unroll
        for (int s2 = 0; s2 < 2; ++s2) Vb[s2] = pack8(vn[2 * s2], vn[2 * s2 + 1]);
#pragma unroll
        for (int mi = 0; mi < 4; ++mi) {
#pragma unroll
            for (int s2 = 0; s2 < 2; ++s2) o[mi] = MFMA16(*(const GAS bf16x8*)(rec + DF_QK + (size_t)((mi * 2 + s2) * 64) * 16), Vb[s2], o[mi]);
            if (!samp || mi == 0) {
#pragma unroll
                for (int r = 0; r < 4; ++r) *(GAS float*)(O + (size_t)(rowbase + 16 * mi + 4 * fq + r) * DA + h * 128 + 16 * vs + fr) = o[mi][r]; } }
        const float gl = *(const GAS float*)(a.ws + WS_DF + (size_t)u * DF_STRIDE + DF_GL);
#pragma unroll
        for (int m = 0; m < 8; ++m) { S[m] = S[m] * gl;
#pragma unroll
            for (int s2 = 0; s2 < 2; ++s2) S[m] = MFMA16(*(const GAS bf16x8*)(rec + DF_KDT + (size_t)((m * 2 + s2) * 64) * 16), Vb[s2], S[m]); }
    }
    float* so = a.out + (samp ? O_SD + ((size_t)(l * NBS + b) * NH + h) * 128 * 128 : O_PD + ((size_t)(l * NBP + b) * NH + h) * 128 * 128);
#pragma unroll
    for (int m = 0; m < 8; ++m)
#pragma unroll
        for (int r = 0; r < 4; ++r) *(GAS float*)(so + (size_t)(16 * m + 4 * fq + r) * 128 + 16 * vs + fr) = S[m][r];
}
DI void seq_phase(const Args& a, int l, int c, int wave, int lane) {
    const float* HLOC = (const float*)(a.ws + WS_HLOC); const float* CUM = (const float*)(a.ws + WS_CUM); float* HIN = (float*)(a.ws + WS_HIN);
    if (wave == 0) { const int j = c >> 3, bh = (c & 7) * 4 + (j >> 3), vs = j & 7; delta_seq_task(a, l, false, bh >> 4, bh & 15, vs, lane); }
    else if (wave <= 4) { const int ts = c * 4 + (wave - 1); delta_seq_task(a, l, true, ts >> 7, (ts >> 3) & 15, ts & 7, lane); }
    else if (wave == 5) { if (c < 64) { const int idx = c * 64 + lane, b = idx >> 11, ch = idx & 2047; float H = 0.f;
            for (int n = 0; n < NCH; n += 8) { float A[8], B[8];
#pragma unroll
                for (int k = 0; k < 8; ++k) { const size_t o = (size_t)(b * SEQ + (n + k) * 64 + 63) * DB + ch; A[k] = *(const GAS float*)(CUM + o); B[k] = *(const GAS float*)(HLOC + o); }
#pragma unroll
                for (int k = 0; k < 8; ++k) { *(GAS float*)(HIN + (size_t)(b * NCH + n + k) * DB + ch) = H; H = A[k] * H + B[k]; } }
            *(GAS float*)(a.out + O_PL + (size_t)(l * NBP + b) * DB + ch) = H; } }
    else if (wave == 6) { const int idx = c * 64 + lane, b = idx >> 11, ch = idx & 2047; const size_t o = (size_t)(MP + b * LS + LS - 1) * DB + ch;
        const float h0 = a.in[4][(size_t)(l * NBS + b) * DB + ch];
        *(GAS float*)(a.out + O_SL + (size_t)(l * NBS + b) * DB + ch) = *(const GAS float*)(CUM + o) * h0 + *(const GAS float*)(HLOC + o); }
}

DI void post_row(const Args& a, int l, int row, int lane) {
    const bf16* PROJ = (const bf16*)(a.ws + WS_PROJ); bf16* MIX = (bf16*)(a.ws + WS_MIX);
    const float* O = (const float*)(a.ws + WS_O); const float* HLOC = (const float*)(a.ws + WS_HLOC); const float* CUM = (const float*)(a.ws + WS_CUM);
    const float* hin = row < MP ? (const float*)(a.ws + WS_HIN) + (size_t)((row >> 13) * NCH + ((row & (SEQ - 1)) >> 6)) * DB : a.in[4] + (size_t)(l * NBS + ((row - MP) >> 4)) * DB;
    const int c0 = 32 * lane;
    {
        f32x4 o[8]; float ss = 0.f;
#pragma unroll
        for (int k = 0; k < 8; ++k) { o[k] = *(const GAS f32x4*)(O + (size_t)row * DA + c0 + 4 * k); ss += (o[k].x * o[k].x + o[k].y * o[k].y) + (o[k].z * o[k].z + o[k].w * o[k].w); }
        ss += __shfl_xor(ss, 1); ss += __shfl_xor(ss, 2);
        const float rs = rsqrtf(ss * (1.f / 128.f) + EPS);
        const float* wn = a.in[11] + (size_t)l * 128 + (c0 & 127);
#pragma unroll
        for (int k2 = 0; k2 < 4; ++k2) { const v4u zz = *(const GAS v4u*)(PROJ + (size_t)row * NINP + C_Z + c0 + 8 * k2);
            const f32x4 w0 = *(const GAS f32x4*)(wn + 8 * k2), w1 = *(const GAS f32x4*)(wn + 8 * k2 + 4); const f32x4 a0 = o[2 * k2], a1 = o[2 * k2 + 1];
            v4u r; r.x = pk2(a0.x * rs * w0.x * silu_(bflo(zz.x)), a0.y * rs * w0.y * silu_(bfhi(zz.x))); r.y = pk2(a0.z * rs * w0.z * silu_(bflo(zz.y)), a0.w * rs * w0.w * silu_(bfhi(zz.y)));
            r.z = pk2(a1.x * rs * w1.x * silu_(bflo(zz.z)), a1.y * rs * w1.y * silu_(bfhi(zz.z))); r.w = pk2(a1.z * rs * w1.z * silu_(bflo(zz.w)), a1.w * rs * w1.w * silu_(bfhi(zz.w)));
            *(GAS v4u*)(MIX + (size_t)row * D + c0 + 8 * k2) = r; }
    }
    {
        float y[32]; float ss = 0.f;
#pragma unroll
        for (int k2 = 0; k2 < 4; ++k2) { const v4u yy = *(const GAS v4u*)(PROJ + (size_t)row * NINP + C_YL + c0 + 8 * k2);
            const float gy[8] = {bflo(yy.x), bfhi(yy.x), bflo(yy.y), bfhi(yy.y), bflo(yy.z), bfhi(yy.z), bflo(yy.w), bfhi(yy.w)};
#pragma unroll
            for (int hh = 0; hh < 2; ++hh) { const size_t o = (size_t)row * DB + c0 + 8 * k2 + 4 * hh;
                const f32x4 hl = *(const GAS f32x4*)(HLOC + o), cm = *(const GAS f32x4*)(CUM + o), hi = *(const GAS f32x4*)(hin + c0 + 8 * k2 + 4 * hh);
#pragma unroll
                for (int e = 0; e < 4; ++e) { const float hv = hl[e] + cm[e] * hi[e]; const float v = gelu_tanh_(gy[4 * hh + e]) * hv; y[8 * k2 + 4 * hh + e] = v; ss += v * v; } } }
        const float rs = rsqrtf(wave_sum(ss) * (1.f / DB) + EPS);
        const float* wn = a.in[19] + (size_t)l * DB + c0;
#pragma unroll
        for (int k2 = 0; k2 < 4; ++k2) { const f32x4 w0 = *(const GAS f32x4*)(wn + 8 * k2), w1 = *(const GAS f32x4*)(wn + 8 * k2 + 4);
            v4u r; r.x = pk2(y[8 * k2] * rs * w0.x, y[8 * k2 + 1] * rs * w0.y); r.y = pk2(y[8 * k2 + 2] * rs * w0.z, y[8 * k2 + 3] * rs * w0.w);
            r.z = pk2(y[8 * k2 + 4] * rs * w1.x, y[8 * k2 + 5] * rs * w1.y); r.w = pk2(y[8 * k2 + 6] * rs * w1.z, y[8 * k2 + 7] * rs * w1.w);
            *(GAS v4u*)(MIX + (size_t)row * D + DA + c0 + 8 * k2) = r; }
    }
}
DI void post_phase(const Args& a, int l, int gw, int NGW, int lane) {
    bf16* MIX = (bf16*)(a.ws + WS_MIX); const bf16* PROJ = (const bf16*)(a.ws + WS_PROJ);
    for (int m = gw; m < MPAD; m += NGW) {
        if (m < MR) post_row(a, l, m, lane);
        else { GAS v4u* o = (GAS v4u*)(MIX + (size_t)m * D) + lane;
#pragma unroll
            for (int j = 0; j < 8; ++j) o[64 * j] = (v4u){0u, 0u, 0u, 0u}; }
    }
    const int gt = gw * 64 + lane, NT = NGW * 64;
    for (int i = gt; i < (NBP + NBS) * 3 * 8192; i += NT) { const int col = i & 8191, rr = (i >> 13) % 3, st = i / (3 * 8192);
        const int row = st < NBP ? st * SEQ + SEQ - 3 + rr : MP + (st - NBP) * LS + LS - 3 + rr;
        const float v = bf2f(*(const GAS bf16*)(PROJ + (size_t)row * NINP + (col < QKV ? col : C_XL + col - QKV)));
        if (col < QKV) { float* d = st < NBP ? a.out + O_PCD + ((size_t)(l * NBP + st) * 3 + rr) * QKV : a.out + O_SCD + ((size_t)(l * NBS + st - NBP) * 3 + rr) * QKV; *(GAS float*)(d + col) = v; }
        else { float* d = st < NBP ? a.out + O_PCL + ((size_t)(l * NBP + st) * 3 + rr) * DB : a.out + O_SCL + ((size_t)(l * NBS + st - NBP) * 3 + rr) * DB; *(GAS float*)(d + col - QKV) = v; } }
}
DI void final_norm_phase(const Args& a, int gw, int NGW, int lane) {
    for (int m = gw; m < MR; m += NGW) { GAS f32x4* xr = (GAS f32x4*)(a.out + (size_t)m * D) + lane; const GAS f32x4* wr = (const GAS f32x4*)a.in[24] + lane;
        f32x4 v[16]; float s = 0.f;
#pragma unroll
        for (int j = 0; j < 16; ++j) { v[j] = xr[64 * j]; s += (v[j].x * v[j].x + v[j].y * v[j].y) + (v[j].z * v[j].z + v[j].w * v[j].w); }
        const float rstd = rsqrtf(wave_sum(s) * (1.f / D) + EPS);
#pragma unroll
        for (int j = 0; j < 16; ++j) xr[64 * j] = v[j] * rstd * wr[64 * j]; }
}
constexpr int N_PHASES = 19;
__global__ void __launch_bounds__(NTHR, 2) fwd(Args a) {
    extern __shared__ __attribute__((aligned(16))) unsigned char lds_raw[];
    LAS unsigned char* lds = (LAS unsigned char*)lds_raw;
    const int tid0 = threadIdx.x;
    const int G = gridDim.x, c = blockIdx.x, NGW = G * NWAVES;
#define FRESH() int tid = tid0; asm volatile("" : "+v"(tid)); const int lane = tid & 63, wave = __builtin_amdgcn_readfirstlane(tid >> 6), gw = c * NWAVES + wave; (void)lane; (void)gw
    const int lo = a.ph_lo, hi = a.ph_hi;
    for (int u = tid0; u < (LDS_BYTES - LDSCTL_OFF) / 4; u += NTHR) ((LAS unsigned*)(lds + LDSCTL_OFF))[u] = 0u;
    __syncthreads();
    const bool use_bar = (hi - lo) > 1;
    XcdBarrier bar; bar.bar = (unsigned*)(a.ws + WS_CTL) + CW_BAR; bar.x = 0; bar.st = nullptr;
    if (use_bar) bar = xcd_barrier_post((unsigned*)(a.ws + WS_CTL) + CW_BAR, (volatile LAS unsigned*)(lds + MISC_OFF) + 8);
#define IN(k) (lo <= (k) && (k) < hi)
#define SEAM(k) do { if (IN(k) && IN((k) + 1)) xcd_barrier(bar); } while (0)
    float* X = a.out;
    bf16* XN = (bf16*)(a.ws + WS_XN); bf16* PROJ = (bf16*)(a.ws + WS_PROJ); bf16* MIX = (bf16*)(a.ws + WS_MIX); bf16* HID = (bf16*)(a.ws + WS_HID);
    bf16* WIN = (bf16*)(a.ws + WS_WIN); bf16* WOUT = (bf16*)(a.ws + WS_WOUT); bf16* WUP = (bf16*)(a.ws + WS_WUP); bf16* WDN = (bf16*)(a.ws + WS_WDN);
    for (int l = 0; l < 2; ++l) {
        const int ph = 9 * l;
        if (IN(ph + 0)) { FRESH(); p0_weights(a, l, lds, gw, NGW, wave, lane); norm_phase(a.in[0], a.in[1], X, l == 0, a.in[6] + (size_t)l * D, XN, gw, NGW, lane); }
        SEAM(ph + 0);
        if (IN(ph + 1)) { FRESH(); pg8::Gemm g{XN, WIN, MPAD, NINP, D}; pg8::StaticOrder S; S.init(MPAD, NINP, G, c); pg8::EpiBf16<0> E{PROJ, NINP};
            pg8::gemm_phase<pg8::EpiBf16<0>, pg8::StaticOrder, true, true>(lds, g, S, E, tid); }
        SEAM(ph + 1);
        if (IN(ph + 2)) {
            for (int u = c; u < NUNIT; u += G) delta_prepass_unit(a, l, u, lds, tid0);
            for (int u = (G - 1 - c); u < NUNIT; u += G) lru_prepass_unit(a, l, u, lds, tid0);
        }
        SEAM(ph + 2);
        if (IN(ph + 3)) { FRESH(); seq_phase(a, l, c, wave, lane); }
        SEAM(ph + 3);
        if (IN(ph + 4)) { FRESH(); post_phase(a, l, gw, NGW, lane); }
        SEAM(ph + 4);
        if (IN(ph + 5)) { FRESH(); pg8::Gemm g{MIX, WOUT, MPAD, D, D}; pg8::StaticOrder S; S.init(MPAD, D, G, c); pg8::EpiResid E{X, D, MR};
            pg8::gemm_phase<pg8::EpiResid, pg8::StaticOrder, true, true>(lds, g, S, E, tid); }
        SEAM(ph + 5);
        if (IN(ph + 6)) { FRESH(); norm_phase(nullptr, nullptr, X, false, a.in[21] + (size_t)l * D, XN, gw, NGW, lane); }
        SEAM(ph + 6);
        if (IN(ph + 7)) { FRESH(); pg8::Gemm g{XN, WUP, MPAD, DFF, D}; pg8::StaticOrder S; S.init(MPAD, DFF, G, c); pg8::EpiBf16<1> E{HID, DFF};
            pg8::gemm_phase<pg8::EpiBf16<1>, pg8::StaticOrder, true, true>(lds, g, S, E, tid); }
        SEAM(ph + 7);
        if (IN(ph + 8)) { FRESH(); pg8::Gemm g{HID, WDN, MPAD, D, DFF}; pg8::StaticOrder S; S.init(MPAD, D, G, c); pg8::EpiResid E{X, D, MR};
            pg8::gemm_phase<pg8::EpiResid, pg8::StaticOrder, true, true>(lds, g, S, E, tid); }
        SEAM(ph + 8);
    }
    if (IN(18)) { FRESH(); final_norm_phase(a, gw, NGW, lane); }
#undef IN
#undef SEAM
}

#ifndef MK_SPLIT
#define MK_SPLIT 1
#endif
extern "C" void kernel_launch(void* const* d_in, const int* in_sizes, int n_in, void* d_out, int out_size, void* d_ws, size_t ws_size, hipStream_t stream) {
    static int grid = 0;
    if (grid == 0) {
        if (n_in != 25 || (size_t)out_size != O_END || ws_size < WS_END) { fprintf(stderr, "kernel_launch: unexpected sizes n_in %d out %d ws %zu (need %zu)\n", n_in, out_size, ws_size, (size_t)WS_END); grid = -1; return; }
        int dev = 0, cus = 0, per_cu = 0;
        if (hipGetDevice(&dev) != hipSuccess || hipDeviceGetAttribute(&cus, hipDeviceAttributeMultiprocessorCount, dev) != hipSuccess) { grid = -1; return; }
        if (hipFuncSetAttribute((const void*)fwd, hipFuncAttributeMaxDynamicSharedMemorySize, LDS_BYTES) != hipSuccess) { fprintf(stderr, "kernel_launch: hipFuncSetAttribute failed\n"); grid = -1; return; }
        if (hipOccupancyMaxActiveBlocksPerMultiprocessor(&per_cu, (const void*)fwd, NTHR, LDS_BYTES) != hipSuccess || per_cu < 1) fprintf(stderr, "kernel_launch: occupancy query reports %d\n", per_cu);
        (void)hipGetLastError();
        grid = cus;
    }
    if (grid < 0) return;
    if (hipMemsetAsync((char*)d_ws + WS_CTL, 0, CTL_ZERO_BYTES, stream) != hipSuccess) return;
    Args a{};
    for (int i = 0; i < 25; ++i) a.in[i] = (const float*)d_in[i];
    a.out = (float*)d_out; a.ws = (unsigned char*)d_ws;
#if MK_SPLIT
    for (int k = 0; k < N_PHASES; ++k) { a.ph_lo = k; a.ph_hi = k + 1; hipLaunchKernelGGL(fwd, dim3(grid), dim3(NTHR), LDS_BYTES, stream, a); }
#else
    a.ph_lo = 0; a.ph_hi = N_PHASES; hipLaunchKernelGGL(fwd, dim3(grid), dim3(NTHR), LDS_BYTES, stream, a);
#endif
}
```

```cpp
#include <hip/hip_runtime.h>
#include <cstdio>
#include <cstdint>
namespace pg8 {
#define PG8_LAS __attribute__((address_space(3)))
typedef unsigned short bf16_t;
typedef short bf16x8 __attribute__((ext_vector_type(8)));
typedef float f32x4 __attribute__((ext_vector_type(4)));
typedef unsigned u32x4 __attribute__((ext_vector_type(4)));
constexpr int BM = 256, BK = 64, HALF = 128, HTB = HALF * BK * 2  , STAGE_BYTES = 8 * HTB, NXCD = 8, WGM = 8;

__host__ __device__ __forceinline__ int lds_byte(int r, int c) { const int st = (r >> 4) * 2 + (c >> 5), rr = r & 15, cc = c & 31, ob = rr * 64 + cc * 2; return st * 1024 + (ob ^ (((ob >> 9) & 1) << 5)); }
__host__ __device__ __forceinline__ void stage_rc(int b, int& R, int& C) { const int st = b / 1024, sb = b % 1024, swz = sb ^ (((sb >> 9) & 1) << 5); R = (st >> 1) * 16 + swz / 64; C = (st & 1) * 32 + (swz % 64) / 2; }
__host__ __device__ __forceinline__ int perm32(int rho) { const int n = rho >> 4, i = rho & 15; return 8 * (i >> 2) + 4 * n + (i & 3); }

struct Unit { int pm, pn; };
struct Gemm { const bf16_t* A; const bf16_t* Bt; int M, N, K; int a_blk, b_blk; };
struct StaticOrder {
    int nM, nN, nwg, G, c;
    __host__ __device__ void init(int M, int N, int G_, int c_) { nM = M / BM; nN = N / BM; nwg = nM * nN; G = G_; c = c_; }
    __host__ __device__ bool next(int i, Unit& u) const {
        const long L = (long)i * G + c; if (L >= nwg) return false;
        int wgid = (int)L; { const int q = nwg / NXCD, r = nwg % NXCD, xcd = wgid % NXCD, off = wgid / NXCD; wgid = (xcd < r ? xcd * (q + 1) : r * (q + 1) + (xcd - r) * q) + off; }
        const int nig = WGM * nN, gid = wgid / nig, fm = gid * WGM, gsz = (nM - fm) < WGM ? (nM - fm) : WGM;
        u.pm = fm + ((wgid % nig) % gsz); u.pn = (wgid % nig) / gsz; return true;
    }
    __device__ __forceinline__ void a_ready(const Unit&) const {}
    __device__ __forceinline__ void done(const Unit&) const {}
};
struct DownOrder {
    int c;
    __host__ __device__ void init(int c_) { c = c_; }
    __host__ __device__ bool next(int i, Unit& u) const { if (i >= 4) return false; const int xcd = c & 7, slot = c >> 3; u.pm = (xcd >> 2) * 32 + 8 * i + (slot & 7); u.pn = 4 * (xcd & 3) + (slot >> 3); return true; }
    __device__ __forceinline__ void a_ready(const Unit&) const {}
    __device__ __forceinline__ void done(const Unit&) const {}
};
typedef float f32x2v_ __attribute__((ext_vector_type(2))); typedef __bf16 bf16x2v_ __attribute__((ext_vector_type(2)));
__device__ __forceinline__ unsigned cvt_pk_bf16(float lo, float hi) { f32x2v_ v = {lo, hi}; bf16x2v_ b = __builtin_convertvector(v, bf16x2v_); return __builtin_bit_cast(unsigned, b); }
template <int ACT  > struct EpiBf16 {
    static constexpr bool PERM = true, AFTER_DRAIN = false;
    bf16_t* O; int ldc; int nkt; int nt;
    __device__ __forceinline__ void operator()(const f32x4 (&acc)[2][2][4][2], const Unit& u, int wr, int wc, int fr, int fq) const {
        const int row0 = u.pm * BM + wr * 64 + fr; const int col0 = u.pn * BM + wc * 32 + 8 * fq;
#pragma unroll
        for (int ai = 0; ai < 2; ++ai)
#pragma unroll
            for (int m = 0; m < 4; ++m) { const int rloc = wr * 64 + fr + ai * HALF + m * 16;
                bf16_t* rowp = nkt ? O + ((size_t)u.pm * nkt + 4 * u.pn + (wc >> 1)) * (BM * BK) + rloc * BK + (wc & 1) * 32 + 8 * fq - (size_t)0 : O + (size_t)(row0 + ai * HALF + m * 16) * ldc + col0;
                const size_t bjstep = nkt ? (size_t)2 * BM * BK : (size_t)HALF;
#pragma unroll
                for (int bj = 0; bj < 2; ++bj) { f32x4 v0 = acc[ai][bj][m][0], v1 = acc[ai][bj][m][1];
                    if (ACT == 1) {
#pragma unroll
                        for (int j = 0; j < 4; ++j) { const float a = fmaxf(v0[j], 0.f), b = fmaxf(v1[j], 0.f); v0[j] = a * a; v1[j] = b * b; } }
                    u32x4 w; w.x = cvt_pk_bf16(v0[0], v0[1]); w.y = cvt_pk_bf16(v0[2], v0[3]); w.z = cvt_pk_bf16(v1[0], v1[1]); w.w = cvt_pk_bf16(v1[2], v1[3]);
                    if (nt) __builtin_nontemporal_store(w, (u32x4*)(rowp + bj * bjstep)); else *(u32x4*)(rowp + bj * bjstep) = w; } }
    }
};
template <bool FUSE> struct EpiResid {
    static constexpr bool PERM = true, AFTER_DRAIN = false;
    const float* B; float* X; int ldc; bf16_t* XB; const float* rss; float inv_n, eps;
    __device__ __forceinline__ void operator()(const f32x4 (&acc)[2][2][4][2], const Unit& u, int wr, int wc, int fr, int fq) const {
        const int row0 = u.pm * BM + wr * 64 + fr, col0 = u.pn * BM + wc * 32 + 8 * fq;
#pragma unroll
        for (int ai = 0; ai < 2; ++ai)
#pragma unroll
            for (int m = 0; m < 4; ++m) { const int row = row0 + ai * HALF + m * 16;
                const float* bp = B + (size_t)row * ldc + col0; float* rowp = X + (size_t)row * ldc + col0;
                const float sc = rss ? __builtin_amdgcn_rcpf(rss[row] * inv_n + eps) : 1.f;
                f32x4 v[2][2];
#pragma unroll
                for (int bj = 0; bj < 2; ++bj)
#pragma unroll
                    for (int n = 0; n < 2; ++n) v[bj][n] = *(const f32x4*)(bp + bj * HALF + n * 4);
#pragma unroll
                for (int bj = 0; bj < 2; ++bj) { const f32x4 x0 = v[bj][0] + acc[ai][bj][m][0] * sc, x1 = v[bj][1] + acc[ai][bj][m][1] * sc;
                    *(f32x4*)(rowp + bj * HALF) = x0; *(f32x4*)(rowp + bj * HALF + 4) = x1;
                    if (FUSE) { u32x4 w; w.x = cvt_pk_bf16(x0[0], x0[1]); w.y = cvt_pk_bf16(x0[2], x0[3]); w.z = cvt_pk_bf16(x1[0], x1[1]); w.w = cvt_pk_bf16(x1[2], x1[3]);
                        *(u32x4*)(XB + (size_t)row * ldc + col0 + bj * HALF) = w; } }
                asm volatile("" ::: "memory"); }
    }
};
template <class Epi, class Sched, bool ALIGN_EPI = false, bool SP2 = false>
__device__ __forceinline__ void gemm_phase(PG8_LAS unsigned char* lds, const Gemm g, const Sched& S, const Epi& E, const int tid) {
    const int wid = __builtin_amdgcn_readfirstlane(tid >> 6), lane = tid & 63, wr = wid >> 2, wc = wid & 3, fr = lane & 15, fq = lane >> 4;
    const int K = g.K, nt = K / BK;
    unsigned voffA[2], voffB[2];
#pragma unroll
    for (int i = 0; i < 2; ++i) { int R, C; stage_rc(tid * 16 + i * 8192, R, C); const int Rb = Epi::PERM ? ((R & ~31) + perm32(R & 31)) : R;
        voffA[i] = (unsigned)(R * (g.a_blk ? BK : K) + C) * 2u; voffB[i] = (unsigned)(Rb * (g.b_blk ? BK : K) + C) * 2u; }
    const size_t kstepA = g.a_blk ? (size_t)BM * BK * 2 : (size_t)(BK * 2), kstepB = g.b_blk ? (size_t)BM * BK * 2 : (size_t)(BK * 2);
    const size_t hstepA = g.a_blk ? (size_t)HALF * BK * 2 : (size_t)HALF * K * 2, hstepB = g.b_blk ? (size_t)HALF * BK * 2 : (size_t)HALF * K * 2;
    const size_t tstep = (size_t)BM * K * 2;
    const unsigned ldsw = (unsigned)wid * 1024u;
    const int aoff = lds_byte(wr * 64 + fr, fq * 8), boff = lds_byte(wc * 32 + fr, fq * 8);
#define PG8_SA(b, h) (((b) * 2 + (h)) * HTB)
#define PG8_SB(b, h) ((4 + (b) * 2 + (h)) * HTB)
#define PG8_STAGE(bufoff, gbase, voff) do { _Pragma("unroll") for (int _i = 0; _i < 2; ++_i) \
        __builtin_amdgcn_global_load_lds((const unsigned*)((const char*)(gbase) + (voff)[_i]), (PG8_LAS unsigned*)(lds + (bufoff) + ldsw + _i * 8192), 16, 0, 0); } while (0)
#define PG8_LDA(dst, b, h) do { _Pragma("unroll") for (int m = 0; m < 4; ++m) _Pragma("unroll") for (int k = 0; k < 2; ++k) dst[m][k] = *(const PG8_LAS bf16x8*)(lds + PG8_SA(b, h) + aoff + m * 2048 + k * 1024); } while (0)
#define PG8_LDB(dst, b, h) do { _Pragma("unroll") for (int n = 0; n < 2; ++n) _Pragma("unroll") for (int k = 0; k < 2; ++k) dst[n][k] = *(const PG8_LAS bf16x8*)(lds + PG8_SB(b, h) + boff + n * 2048 + k * 1024); } while (0)
#define PG8_MMA(ai, bj, At, Bt) do { __builtin_amdgcn_s_setprio(1); _Pragma("unroll") for (int m = 0; m < 4; ++m) _Pragma("unroll") for (int n = 0; n < 2; ++n) _Pragma("unroll") for (int k = 0; k < 2; ++k) \
        acc[ai][bj][m][n] = __builtin_amdgcn_mfma_f32_16x16x32_bf16(Bt[n][k], At[m][k], acc[ai][bj][m][n], 0, 0, 0); __builtin_amdgcn_s_setprio(0); } while (0)
#define PG8_WAIT_V(n) asm volatile("s_waitcnt vmcnt(" #n ")" ::: "memory")
#define PG8_WAIT_L(n) asm volatile("s_waitcnt lgkmcnt(" #n ")" ::: "memory")
#define PG8_BAR __builtin_amdgcn_s_barrier()
#define PG8_SCHED __builtin_amdgcn_sched_barrier(0)
    Unit cur, nxt; int ui = 0;
    if (!S.next(0, cur)) return;
    f32x4 acc[2][2][4][2];
#pragma unroll
    for (int a = 0; a < 2; ++a)
#pragma unroll
        for (int b = 0; b < 2; ++b)
#pragma unroll
            for (int m = 0; m < 4; ++m)
#pragma unroll
                for (int n = 0; n < 2; ++n) acc[a][b][m][n] = (f32x4){0.f, 0.f, 0.f, 0.f};
    bf16x8 At[4][2], B0[2][2], B1[2][2];
    const char* cA = (const char*)g.A + (size_t)cur.pm * tstep; const char* cB = (const char*)g.Bt + (size_t)cur.pn * tstep;
    S.a_ready(cur);
    if constexpr (SP2) {
        PG8_STAGE(PG8_SB(0, 0), cB, voffB); PG8_STAGE(PG8_SB(0, 1), cB + hstepB, voffB); PG8_STAGE(PG8_SA(0, 0), cA, voffA); PG8_STAGE(PG8_SA(0, 1), cA + hstepA, voffA);
        if (wr == 1) PG8_BAR;
        PG8_WAIT_V(2); PG8_BAR;
        PG8_STAGE(PG8_SB(1, 0), cB + kstepB, voffB); PG8_STAGE(PG8_SA(1, 0), cA + kstepA, voffA); PG8_STAGE(PG8_SB(1, 1), cB + hstepB + kstepB, voffB);
        PG8_WAIT_V(6); PG8_BAR;
    } else {
        PG8_STAGE(PG8_SB(0, 0), cB, voffB); PG8_STAGE(PG8_SA(0, 0), cA, voffA); PG8_STAGE(PG8_SB(0, 1), cB + hstepB, voffB); PG8_STAGE(PG8_SA(0, 1), cA + hstepA, voffA);
        if (wr == 1) PG8_BAR;
        PG8_WAIT_V(4); PG8_BAR;
        PG8_STAGE(PG8_SB(1, 0), cB + kstepB, voffB); PG8_STAGE(PG8_SA(1, 0), cA + kstepA, voffA); PG8_STAGE(PG8_SB(1, 1), cB + hstepB + kstepB, voffB);
        PG8_WAIT_V(6); PG8_BAR;
    }
    for (;;) {
        const bool has_next = S.next(ui + 1, nxt);
        const char* nA = has_next ? (const char*)g.A + (size_t)nxt.pm * tstep : cA; const char* nB = has_next ? (const char*)g.Bt + (size_t)nxt.pn * tstep : cB;
        for (int t = 0; t < nt; t += 2) {
            const bool last = (t == nt - 2);
            const char* a1 = cA + (size_t)(t + 1) * kstepA;
            const char* a2 = last ? nA : cA + (size_t)(t + 2) * kstepA; const char* b2 = last ? nB : cB + (size_t)(t + 2) * kstepB;
            const char* a3 = a2 + kstepA; const char* b3 = b2 + kstepB;
            if (last && has_next) S.a_ready(nxt);
            if constexpr (SP2) {
            PG8_LDB(B0, 0, 0); PG8_LDB(B1, 0, 1); PG8_SCHED; PG8_LDA(At, 0, 0); PG8_STAGE(PG8_SA(1, 1), a1 + hstepA, voffA);
            PG8_WAIT_V(8); PG8_WAIT_L(0); PG8_BAR; PG8_MMA(0, 0, At, B0); PG8_MMA(0, 1, At, B1); PG8_BAR; PG8_SCHED;
            PG8_LDA(At, 0, 1); PG8_STAGE(PG8_SB(0, 0), b2, voffB); PG8_STAGE(PG8_SB(0, 1), b2 + hstepB, voffB); PG8_STAGE(PG8_SA(0, 0), a2, voffA);
            PG8_WAIT_V(8); PG8_WAIT_L(0); PG8_BAR; PG8_MMA(1, 0, At, B0); PG8_MMA(1, 1, At, B1); PG8_BAR; PG8_SCHED;
            PG8_LDB(B0, 1, 0); PG8_LDB(B1, 1, 1); PG8_SCHED; PG8_LDA(At, 1, 0); PG8_STAGE(PG8_SA(0, 1), a2 + hstepA, voffA);
            PG8_WAIT_V(8); PG8_WAIT_L(0); PG8_BAR; PG8_MMA(0, 0, At, B0); PG8_MMA(0, 1, At, B1); PG8_BAR; PG8_SCHED;
            PG8_LDA(At, 1, 1); PG8_STAGE(PG8_SB(1, 0), b3, voffB); PG8_STAGE(PG8_SB(1, 1), b3 + hstepB, voffB); PG8_STAGE(PG8_SA(1, 0), a3, voffA);
            PG8_WAIT_V(8); PG8_WAIT_L(0); PG8_BAR; PG8_MMA(1, 0, At, B0); PG8_MMA(1, 1, At, B1); PG8_BAR; PG8_SCHED;
            } else {
            PG8_LDB(B0, 0, 0); PG8_SCHED; PG8_LDA(At, 0, 0); PG8_STAGE(PG8_SA(1, 1), a1 + hstepA, voffA);
            PG8_WAIT_L(8); PG8_BAR; PG8_WAIT_L(0); PG8_MMA(0, 0, At, B0); PG8_BAR; PG8_SCHED;
            PG8_LDB(B1, 0, 1); PG8_STAGE(PG8_SB(0, 0), b2, voffB);
            PG8_BAR; PG8_WAIT_L(0); PG8_MMA(0, 1, At, B1); PG8_BAR;
            PG8_LDA(At, 0, 1); PG8_STAGE(PG8_SA(0, 0), a2, voffA);
            PG8_BAR; PG8_WAIT_L(0); PG8_MMA(1, 0, At, B0); PG8_BAR; PG8_SCHED;
            PG8_STAGE(PG8_SB(0, 1), b2 + hstepB, voffB);
            PG8_WAIT_V(6); PG8_BAR; PG8_MMA(1, 1, At, B1); PG8_BAR;
            PG8_LDB(B0, 1, 0); PG8_SCHED; PG8_LDA(At, 1, 0); PG8_STAGE(PG8_SA(0, 1), a2 + hstepA, voffA);
            PG8_WAIT_L(8); PG8_BAR; PG8_WAIT_L(0); PG8_MMA(0, 0, At, B0); PG8_BAR; PG8_SCHED;
            PG8_LDB(B1, 1, 1); PG8_STAGE(PG8_SB(1, 0), b3, voffB);
            PG8_BAR; PG8_WAIT_L(0); PG8_MMA(0, 1, At, B1); PG8_BAR;
            PG8_LDA(At, 1, 1); PG8_STAGE(PG8_SA(1, 0), a3, voffA);
            PG8_BAR; PG8_WAIT_L(0); PG8_MMA(1, 0, At, B0); PG8_BAR; PG8_SCHED;
            PG8_STAGE(PG8_SB(1, 1), b3 + hstepB, voffB);
            PG8_WAIT_V(6); PG8_BAR; PG8_MMA(1, 1, At, B1); PG8_BAR;
            }
        }
        if constexpr (ALIGN_EPI) { if (wr == 0) PG8_BAR; }
        if constexpr (!Epi::AFTER_DRAIN) { E(acc, cur, wr, wc, fr, fq); S.done(cur); }
        if (!has_next) break;
#pragma unroll
        for (int a = 0; a < 2; ++a)
#pragma unroll
            for (int b = 0; b < 2; ++b)
#pragma unroll
                for (int m = 0; m < 4; ++m)
#pragma unroll
                    for (int n = 0; n < 2; ++n) acc[a][b][m][n] = (f32x4){0.f, 0.f, 0.f, 0.f};
        cur = nxt; cA = nA; cB = nB; ++ui;
        if constexpr (ALIGN_EPI) { if (wr == 1) PG8_BAR; }
    }
    PG8_WAIT_V(0);
    if constexpr (!ALIGN_EPI) { if (wr == 0) PG8_BAR; }
    PG8_BAR;
    if constexpr (Epi::AFTER_DRAIN) { E.fused(acc, cur, wr, wc, fr, fq, lds, wid, lane); S.done(cur); }
#undef PG8_SA
#undef PG8_SB
#undef PG8_STAGE
#undef PG8_LDA
#undef PG8_LDB
#undef PG8_MMA
#undef PG8_WAIT_V
#undef PG8_WAIT_L
#undef PG8_BAR
#undef PG8_SCHED
}
}
constexpr int D = 4096, MP = 16384, MS = 128, MR = MP + MS, MPAD = 16640;
constexpr int SEQ = 8192, NBP = 2, NBS = 8, LS = 16, NCH = SEQ / 64;
constexpr int DA = 2048, DB = 2048, NH = 16, DFF = 16384, QKV = 6144;
constexpr int NIN = 12320, NINP = 12544;
constexpr int C_Q = 0, C_K = 2048, C_V = 4096, C_Z = 6144, C_XL = 8192, C_YL = 10240, C_BL = 12288, C_AL = 12304;
constexpr float EPS = 1e-6f;
constexpr int NWAVES = 8, NTHR = 512;
constexpr int NUNIT_P = 4096, NUNIT = 4224;
constexpr size_t O_YP = 0, O_YS = O_YP + (size_t)MP * D, O_PD = O_YS + (size_t)MS * D, O_PCD = O_PD + (size_t)2 * NBP * NH * 128 * 128, O_PL = O_PCD + (size_t)2 * NBP * 3 * QKV,
    O_PCL = O_PL + (size_t)2 * NBP * DB, O_SD = O_PCL + (size_t)2 * NBP * 3 * DB, O_SCD = O_SD + (size_t)2 * NBS * NH * 128 * 128, O_SL = O_SCD + (size_t)2 * NBS * 3 * QKV,
    O_SCL = O_SL + (size_t)2 * NBS * DB, O_END = O_SCL + (size_t)2 * NBS * 3 * DB;
static_assert(O_END == 73408512, "d_out map");
constexpr size_t AL(size_t x) { return (x + 4095) & ~(size_t)4095; }
constexpr size_t WS_CTL = 0, CTL_ZERO_BYTES = 1u << 20;
constexpr size_t WS_WIN = CTL_ZERO_BYTES, WS_WOUT = WS_WIN + AL((size_t)NINP * D * 2), WS_WUP = WS_WOUT + AL((size_t)D * D * 2), WS_WDN = WS_WUP + AL((size_t)DFF * D * 2),
    WS_WG = WS_WDN + AL((size_t)D * DFF * 2), WS_XN = WS_WG + AL((size_t)2 * NH * 128 * 128 * 2), WS_PROJ = WS_XN + AL((size_t)MPAD * D * 2), WS_MIX = WS_PROJ + AL((size_t)MPAD * NINP * 2),
    WS_HIN = WS_MIX + AL((size_t)MPAD * D * 2), WS_OV = WS_HIN + AL((size_t)2 * NBP * NCH * DB * 4);
constexpr size_t DF_MP = 0, DF_BN = 32768, DF_QE = 65536, DF_OU = 81920, DF_GL = 98304, DF_STRIDE = 98560;
constexpr size_t WS_DF = WS_OV, WS_SST = WS_DF + AL((size_t)NUNIT * DF_STRIDE), WS_HLOC = WS_SST + AL((size_t)NUNIT * 32768), WS_CUM = WS_HLOC + AL((size_t)MR * DB * 2), WS_CHK = WS_CUM + AL((size_t)MR * DB * 2), WS_END1 = WS_CHK + AL((size_t)NUNIT * 1024);
constexpr size_t WS_HID = WS_OV, WS_END2 = WS_HID + AL((size_t)MPAD * DFF * 2);
constexpr size_t WS_END = WS_END1 > WS_END2 ? WS_END1 : WS_END2;
static_assert(WS_END <= 2147483648ull, "d_ws map");
constexpr int CW_BAR = 4096;
constexpr size_t WS_RSA = WS_CTL + 65536, WS_RSB = WS_RSA + 131072;
static_assert(WS_RSB + 131072 <= CTL_ZERO_BYTES && (size_t)MPAD * 4 <= 131072, "row-sum arrays");
constexpr int RING_BYTES = 131072, LDSCTL_OFF = 139264, MISC_OFF = LDSCTL_OFF + 320, LDS_BYTES = 147456;
constexpr int L_QN = 0, L_KN = 17408, L_KT = 34816, L_VT = 53248, L_KK = 71680, L_QKT = 89088, L_TU = 105472, L_TW = 114688, L_SC = 123904, L_QKF = 124928;
constexpr int L_XCB = 0, L_XCF = 17408, L_AS = L_XCF + 33792, L_BS = L_AS + 33792, L_SEG = L_BS + 33792;
constexpr int L_OL = 0;
constexpr int SQ_SLOT = 40960 + 256, L_SQ = 0;
static_assert(L_SEG + 8192 <= LDSCTL_OFF && L_QKF + 8192 <= LDSCTL_OFF && 2 * SQ_SLOT <= LDSCTL_OFF, "LDS map");

#define GAS __attribute__((address_space(1)))
#define LAS __attribute__((address_space(3)))
#define DI __device__ __forceinline__
typedef unsigned short bf16;
typedef unsigned v4u __attribute__((ext_vector_type(4)));
typedef unsigned v2u __attribute__((ext_vector_type(2)));
typedef float f32x4 __attribute__((ext_vector_type(4)));
typedef short bf16x8 __attribute__((ext_vector_type(8)));
typedef GAS unsigned gu32;
#define RLX_AGENT __ATOMIC_RELAXED, __HIP_MEMORY_SCOPE_AGENT
#define LDS_WAIT() asm volatile("s_waitcnt lgkmcnt(0)" ::: "memory")
#define VM_WAIT() asm volatile("s_waitcnt vmcnt(0)" ::: "memory")
#define LDS_BARRIER() do { asm volatile("s_waitcnt lgkmcnt(0)" ::: "memory"); __builtin_amdgcn_s_barrier(); asm volatile("" ::: "memory"); } while (0)
#define MFMA16(a, b, c) __builtin_amdgcn_mfma_f32_16x16x32_bf16((a), (b), (c), 0, 0, 0)
typedef float f32x2_t __attribute__((ext_vector_type(2)));
typedef __bf16 bf16x2_t __attribute__((ext_vector_type(2)));
DI unsigned pk2(float lo, float hi) { f32x2_t v = {lo, hi}; bf16x2_t b = __builtin_convertvector(v, bf16x2_t); return __builtin_bit_cast(unsigned, b); }
DI unsigned f2bf(float f) { return pk2(f, 0.f) & 0xffffu; }
DI float bflo(unsigned w) { return __builtin_bit_cast(float, w << 16); }
DI float bfhi(unsigned w) { return __builtin_bit_cast(float, w & 0xffff0000u); }
DI float bf2f(bf16 b) { return __builtin_bit_cast(float, (unsigned)b << 16); }
DI f32x4 bf4_to_f32(v2u w) { return (f32x4){bflo(w.x), bfhi(w.x), bflo(w.y), bfhi(w.y)}; }
DI float sigmoid_(float x) { return __builtin_amdgcn_rcpf(1.f + __builtin_amdgcn_exp2f(-1.4426950408889634f * x)); }
DI float silu_(float x) { return x * sigmoid_(x); }
DI float softplus_(float x) { return x > 20.f ? x : log1pf(__expf(x)); }
DI float gelu_tanh_(float x) { return x * sigmoid_(1.5957691216057308f * (x + 0.044715f * x * x * x)); }
DI float wave_sum(float v) {
#pragma unroll
    for (int o = 1; o < 64; o <<= 1) v += __shfl_xor(v, o);
    return v;
}
DI bf16x8 pack8(f32x4 a, f32x4 b) { v4u p; p.x = pk2(a[0], a[1]); p.y = pk2(a[2], a[3]); p.z = pk2(b[0], b[1]); p.w = pk2(b[2], b[3]); return __builtin_bit_cast(bf16x8, p); }
#define XB_TMO      128
#define XB_XCNT(j)  (256  + 64 * (j))
#define XB_XSUB(j)  (1280 + 64 * (j))
#define XB_XGEN(j)  (2304 + 64 * (j))
#define XB_TOP      3328
#define XB_TOPGEN   3392
#define XCD_BAR_WORDS 3456
#define XB_SPIN_CAP (1u << 18)

__device__ __forceinline__ unsigned xb_ld(unsigned* p)              { return __hip_atomic_load(p, __ATOMIC_RELAXED, __HIP_MEMORY_SCOPE_AGENT); }
__device__ __forceinline__ unsigned xb_add(unsigned* p, unsigned v) { return __hip_atomic_fetch_add(p, v, __ATOMIC_RELAXED, __HIP_MEMORY_SCOPE_AGENT); }
__device__ __forceinline__ unsigned xb_xcc_id() { return (unsigned)__builtin_amdgcn_s_getreg((3 << 11) | 20) & 0xFu; }
#define XB_SPIN(cond, bar) do { unsigned _sp = 0; while (cond) { __builtin_amdgcn_s_sleep(1); \
    if ((++_sp & 255u) == 0u) { if (xb_ld(&(bar)[XB_TMO])) break; if (_sp > XB_SPIN_CAP) { atomicAdd(&(bar)[XB_TMO], 1u); break; } } } } while (0)

struct XcdBarrier {
    unsigned* bar; unsigned x;
    volatile LAS unsigned* st;
};

__device__ __forceinline__ XcdBarrier xcd_barrier_post(unsigned* bar, volatile LAS unsigned* st) {
    XcdBarrier b; b.bar = bar; b.x = xb_xcc_id(); b.st = st;
    if (threadIdx.x == 0) (void)xb_add(&bar[XB_XCNT(b.x)], 1u);
    return b;
}
__device__ __forceinline__ void xcd_barrier_complete(unsigned* bar, unsigned x, unsigned& nloc, unsigned& nx) {
    const unsigned G = gridDim.x * gridDim.y * gridDim.z;
    unsigned sum, cnt, mine, sp = 0u;
    for (;;) {
        sum = 0u; cnt = 0u; mine = 0u;
#pragma unroll
        for (unsigned j = 0; j < 16; ++j) { const unsigned c = xb_ld(&bar[XB_XCNT(j)]); sum += c; cnt += (c > 0u) ? 1u : 0u; mine = (j == x) ? c : mine; }
        if (sum == G) break;
        __builtin_amdgcn_s_sleep(1);
        if ((++sp & 255u) == 0u) { if (xb_ld(&bar[XB_TMO])) break; if (sp > XB_SPIN_CAP) { atomicAdd(&bar[XB_TMO], 1u); break; } }
    }
    nloc = mine > 0u ? mine : 1u; nx = cnt > 0u ? cnt : 1u;
}

__device__ __forceinline__ void xcd_barrier(const XcdBarrier& b) {
    asm volatile("s_waitcnt vmcnt(0)" ::: "memory");
    __syncthreads();
    if (threadIdx.x == 0) {
        unsigned* bar = b.bar;
        __builtin_amdgcn_s_waitcnt(0);
        unsigned nloc = b.st[0], nx = b.st[1];
        if (nloc == 0u) { xcd_barrier_complete(bar, b.x, nloc, nx); b.st[0] = nloc; b.st[1] = nx; }
        const unsigned old = xb_add(&bar[XB_XSUB(b.x)], 1u);
        const unsigned gen = old / nloc;
        if (old + 1u == (gen + 1u) * nloc) {
            __builtin_amdgcn_fence(__ATOMIC_RELEASE, "agent");
            asm volatile("s_waitcnt vmcnt(0)" ::: "memory");
            const unsigned og = xb_add(&bar[XB_TOP], 1u);
            const unsigned tg = og / nx;
            if (og + 1u == (tg + 1u) * nx) xb_add(&bar[XB_TOPGEN], 1u);
            else XB_SPIN(xb_ld(&bar[XB_TOPGEN]) == tg, bar);
            __builtin_amdgcn_fence(__ATOMIC_ACQUIRE, "agent");
            xb_add(&bar[XB_XGEN(b.x)], 1u);
            asm volatile("s_waitcnt vmcnt(0)" ::: "memory");
        } else {
            XB_SPIN(xb_ld(&bar[XB_XGEN(b.x)]) == gen, bar);
            __builtin_amdgcn_fence(__ATOMIC_ACQUIRE, "agent");
            asm volatile("s_waitcnt vmcnt(0)" ::: "memory");
        }
    }
    __syncthreads();
}
struct Args { const float* in[25]; float* out; unsigned char* ws; int ph_lo, ph_hi; };

struct CvItem { const float* src; bf16* dst; int ldw, K; const float* kscale; };
DI void cv_load(const CvItem& d, float (&v)[32], f32x4 (&kg)[2], int lane) {
#pragma unroll
    for (int i = 0; i < 32; ++i) v[i] = __builtin_nontemporal_load((const GAS float*)(d.src + (size_t)(2 * i + (lane >> 5)) * d.ldw + (lane & 31)));
    const GAS f32x4* kp = (const GAS f32x4*)((d.kscale ? d.kscale : d.src) + 8 * (lane & 7));
    kg[0] = kp[0]; kg[1] = kp[1];
}
DI void cv_finish(const CvItem& d, const float (&v)[32], const f32x4 (&kg)[2], LAS float* scr, int lane) {
#pragma unroll
    for (int i = 0; i < 32; ++i) scr[(2 * i + (lane >> 5)) * 33 + (lane & 31)] = v[i];
    LDS_WAIT(); asm volatile("" ::: "memory");
    const int c = lane & 7; const bool ks = d.kscale != nullptr;
    const f32x4 g0 = ks ? kg[0] : (f32x4){1.f, 1.f, 1.f, 1.f}, g1 = ks ? kg[1] : (f32x4){1.f, 1.f, 1.f, 1.f};
#pragma unroll
    for (int j = 0; j < 4; ++j) { const int n = (lane >> 3) + 8 * j; const LAS float* s = scr + (8 * c) * 33 + n;
        v4u o; o.x = pk2(s[0 * 33] * g0.x, s[1 * 33] * g0.y); o.y = pk2(s[2 * 33] * g0.z, s[3 * 33] * g0.w); o.z = pk2(s[4 * 33] * g1.x, s[5 * 33] * g1.y); o.w = pk2(s[6 * 33] * g1.z, s[7 * 33] * g1.w);
        *(GAS v4u*)(d.dst + (size_t)n * d.K + 8 * c) = o; }
    LDS_WAIT(); asm volatile("" ::: "memory");
}
DI void norm_phase(const float* xp, const float* xs, const float* X, bool first, const float* w, bf16* XN, int gw, int NGW, int lane) {
    const GAS f32x4* wr = (const GAS f32x4*)w + lane;
    for (int mb = gw; mb < MR; mb += 2 * NGW) { f32x4 v[2][16];
#pragma unroll
        for (int r = 0; r < 2; ++r) { const int m = mb + r * NGW < MR ? mb + r * NGW : mb;
            const float* src = first ? (m < MP ? xp + (size_t)m * D : xs + (size_t)(m - MP) * D) : X + (size_t)m * D; const GAS f32x4* xr = (const GAS f32x4*)src + lane;
#pragma unroll
            for (int j = 0; j < 16; ++j) v[r][j] = xr[64 * j]; }
#pragma unroll
        for (int r = 0; r < 2; ++r) { const int m = mb + r * NGW; float s = 0.f;
#pragma unroll
            for (int j = 0; j < 16; ++j) s += (v[r][j].x * v[r][j].x + v[r][j].y * v[r][j].y) + (v[r][j].z * v[r][j].z + v[r][j].w * v[r][j].w);
            const float rstd = rsqrtf(wave_sum(s) * (1.f / D) + EPS);
            if (m < MR) { GAS v2u* o8 = (GAS v2u*)(XN + (size_t)m * D) + lane;
#pragma unroll
                for (int j = 0; j < 16; ++j) { const f32x4 g = wr[64 * j]; v2u o; o.x = pk2(v[r][j].x * rstd * g.x, v[r][j].y * rstd * g.y); o.y = pk2(v[r][j].z * rstd * g.z, v[r][j].w * rstd * g.w); o8[64 * j] = o; } } } }
    if (first) for (int m = MR + gw; m < MPAD; m += NGW) { GAS v4u* o = (GAS v4u*)(XN + (size_t)m * D) + lane;
#pragma unroll
        for (int j = 0; j < 8; ++j) o[64 * j] = (v4u){0u, 0u, 0u, 0u}; }
}
DI void rowss_phase(const bf16* XB, float* rss, int m0, int m1, int gw, int NGW, int lane) {
    for (int mb = m0 + gw; mb < m1; mb += 4 * NGW) { v4u w[4][8];
#pragma unroll
        for (int r = 0; r < 4; ++r) { const int m = mb + r * NGW < m1 ? mb + r * NGW : mb; const GAS v4u* xr = (const GAS v4u*)(XB + (size_t)m * D) + lane;
#pragma unroll
            for (int j = 0; j < 8; ++j) w[r][j] = xr[64 * j]; }
#pragma unroll
        for (int r = 0; r < 4; ++r) { float s = 0.f;
#pragma unroll
            for (int j = 0; j < 8; ++j) { const v4u q = w[r][j]; const float f[8] = {bflo(q.x), bfhi(q.x), bflo(q.y), bfhi(q.y), bflo(q.z), bfhi(q.z), bflo(q.w), bfhi(q.w)};
#pragma unroll
                for (int e = 0; e < 8; ++e) s += f[e] * f[e]; }
            s = wave_sum(s); if (lane == 0 && mb + r * NGW < m1) *(GAS float*)(rss + mb + r * NGW) = s; } }
}
constexpr int I_IN = 64 * 385, I_G = 2 * NH * 8, I_DN = 256 * 128, I_UP = 64 * 512, I_OUT = 64 * 128;
constexpr int CV_ITEMS = I_IN + I_G + I_DN + I_UP + I_OUT, CV_SPLIT = I_IN + I_G + I_DN + I_UP / 4;
DI CvItem cv_decode(const Args& a, int l, int it) {
    bf16* WIN = (bf16*)(a.ws + WS_WIN); bf16* WOUT = (bf16*)(a.ws + WS_WOUT); bf16* WUP = (bf16*)(a.ws + WS_WUP); bf16* WDN = (bf16*)(a.ws + WS_WDN); bf16* WG = (bf16*)(a.ws + WS_WG);
    int r = it; CvItem d;
    if (r < I_IN) { const int kb = r / 385, nb = r % 385; const int nsrc = nb < 256 ? nb : (nb < 384 ? nb + 1 : 256);
        d.src = a.in[7] + (size_t)l * D * NIN + (size_t)(64 * kb) * NIN + 32 * nsrc; d.ldw = NIN; d.dst = WIN + ((size_t)((32 * nb) >> 8) * (D / 64) + kb) * 16384 + (size_t)((32 * nb) & 255) * 64; d.K = 64; d.kscale = nullptr; return d; } r -= I_IN;
    if (r < I_G) { const int gm = r >> 3, sub = r & 7;
        d.src = (gm < NH ? a.in[14] : a.in[16]) + ((size_t)l * NH + (gm & 15)) * 128 * 128 + (size_t)(64 * (sub >> 2)) * 128 + 32 * (sub & 3); d.ldw = 128;
        d.dst = WG + (size_t)gm * 128 * 128 + (size_t)(32 * (sub & 3)) * 128 + 64 * (sub >> 2); d.K = 128; d.kscale = nullptr; return d; } r -= I_G;
    if (r < I_DN) { const int kb = r / 128, nb = r % 128, n0 = 32 * nb;
        d.src = a.in[23] + (size_t)l * DFF * D + (size_t)(64 * kb) * D + n0; d.ldw = D; d.dst = WDN + ((size_t)(n0 >> 8) * (DFF / 64) + kb) * 16384 + (size_t)(n0 & 255) * 64; d.K = 64; d.kscale = nullptr; return d; } r -= I_DN;
    if (r < I_UP) { d.src = a.in[22] + (size_t)l * D * DFF + (size_t)(64 * (r / 512)) * DFF + 32 * (r % 512); d.ldw = DFF; d.dst = WUP + ((size_t)((32 * (r % 512)) >> 8) * (D / 64) + r / 512) * 16384 + (size_t)((32 * (r % 512)) & 255) * 64; d.K = 64; d.kscale = a.in[21] + (size_t)l * D + 64 * (r / 512); return d; } r -= I_UP;
    d.src = a.in[20] + (size_t)l * D * D + (size_t)(64 * (r / 128)) * D + 32 * (r % 128); d.ldw = D; d.dst = WOUT + ((size_t)((32 * (r % 128)) >> 8) * (D / 64) + r / 128) * 16384 + (size_t)((32 * (r % 128)) & 255) * 64; d.K = 64; d.kscale = nullptr; return d;
}
DI void convert_range(const Args& a, int l, int it0, int itend, int stride, LAS float* scr, int lane) {
    for (int it = it0; it < itend; it += stride) { const CvItem d = cv_decode(a, l, it); float v[32]; f32x4 kg[2]; cv_load(d, v, kg, lane); cv_finish(d, v, kg, scr, lane); }
}
DI void convert_range2(const Args& a, int l, int it0, int itend, int stride, LAS float* scr, int lane) {
    if (it0 >= itend) return;
    float v0[32], v1[32]; f32x4 k0[2], k1[2];
    { const CvItem d = cv_decode(a, l, it0); cv_load(d, v0, k0, lane); }
    for (int it = it0; it < itend; it += 2 * stride) { const int i1 = it + stride, i2 = it + 2 * stride;
        { const CvItem d = cv_decode(a, l, i1 < itend ? i1 : it); cv_load(d, v1, k1, lane); }
        { const CvItem d = cv_decode(a, l, it); cv_finish(d, v0, k0, scr, lane); }
        { const CvItem d = cv_decode(a, l, i2 < itend ? i2 : it); cv_load(d, v0, k0, lane); }
        if (i1 < itend) { const CvItem d = cv_decode(a, l, i1); cv_finish(d, v1, k1, scr, lane); } }
}
DI void p0_weights(const Args& a, int l, LAS unsigned char* lds, int gw, int NGW, int wave, int lane) {
    LAS float* scr = (LAS float*)(lds + wave * 16384);
    bf16* WIN = (bf16*)(a.ws + WS_WIN);
    if (l == 0) convert_range(a, l, gw, I_IN + I_G, NGW, scr, lane);
    { const int gt = gw * 64 + lane, NT = NGW * 64; constexpr int PER = (NINP - NIN) * 64 / 8;
      for (int i = gt; i < (D / 64) * PER; i += NT) { const int kt = i / PER, o = i % PER; *(GAS v4u*)(WIN + ((size_t)(NIN >> 8) * (D / 64) + kt) * 16384 + (size_t)(NIN & 255) * 64 + 8 * o) = (v4u){0u, 0u, 0u, 0u}; } }
}

DI void unit_decode(int u, bool& samp, int& b, int& n, int& h, int& rowbase, int& L) {
    samp = u >= NUNIT_P;
    if (!samp) { b = u >> 11; n = (u >> 4) & 127; h = u & 15; rowbase = b * SEQ + n * 64; L = 64; }
    else { const int s = u - NUNIT_P; b = s >> 4; h = s & 15; n = 0; rowbase = MP + b * LS; L = LS; }
}
struct DInv { f32x4 w0, w1, w2, w3; float nalog, dtb; };
DI void delta_inv_load(const Args& a, int l, int h, int tid, DInv& v) {
    if (tid < 384) { const int p = tid >> 7, cq = tid & 31; const float* wc = a.in[8] + (size_t)l * 4 * QKV + p * 2048 + h * 128 + 4 * cq;
        v.w0 = *(const GAS f32x4*)(wc); v.w1 = *(const GAS f32x4*)(wc + QKV); v.w2 = *(const GAS f32x4*)(wc + 2 * QKV); v.w3 = *(const GAS f32x4*)(wc + 3 * QKV); }
    v.nalog = -__expf(a.in[9][l * NH + h]); v.dtb = a.in[10][l * NH + h];
}
DI void delta_issue(const Args& a, int u, int tid, v2u (&xraw)[19], unsigned& sraw) {
    asm volatile("" : "+v"(tid)); const int lane = tid & 63, wave = __builtin_amdgcn_readfirstlane(tid >> 6);
    bool samp; int b, n, h, rowbase, L; unit_decode(u, samp, b, n, h, rowbase, L);
    const bf16* PROJ = (const bf16*)(a.ws + WS_PROJ);
    if (tid < 384) { const int p = tid >> 7, cq = tid & 31, rs = (tid >> 5) & 3, t0 = rs * 16, col = p * 2048 + h * 128 + 4 * cq;
#pragma unroll
        for (int i = 0; i < 19; ++i) { int row = rowbase + t0 - 3 + i; row = row < 0 ? 0 : row; xraw[i] = *(const GAS v2u*)(PROJ + (size_t)row * NINP + col); } }
    else if (wave == 7) { const size_t row = (size_t)(rowbase + (lane < L ? lane : 0));
        sraw = (unsigned)*(const GAS bf16*)(PROJ + row * NINP + C_BL + h) | ((unsigned)*(const GAS bf16*)(PROJ + row * NINP + C_AL + h) << 16); }
}
DI void delta_prepass_unit(const Args& a, int l, int u, int u_next, LAS unsigned char* lds, int tid, v2u (&xraw)[19], unsigned& sraw, const DInv& inv) {
    const int tid_in = tid; asm volatile("" : "+v"(tid)); const int lane = tid & 63, wave = __builtin_amdgcn_readfirstlane(tid >> 6);
    bool samp; int b, n, h, rowbase, L; unit_decode(u, samp, b, n, h, rowbase, L);
    const bf16* PROJ = (const bf16*)(a.ws + WS_PROJ);
    unsigned char* rec = a.ws + WS_DF + (size_t)u * DF_STRIDE;
    LAS float* TS = (LAS float*)(lds + L_KN);
    LAS float* SCB = (LAS float*)(lds + L_SC); LAS float* SCG = SCB + 64; LAS float* RK2 = SCB + 128; LAS float* QQ2 = SCB + 192;
    const int fr = lane & 15, fq = lane >> 4;
    if (tid < 384) {
        const int p = tid >> 7, cq = tid & 31, rs = (tid >> 5) & 3, t0 = rs * 16;
        const int col = p * 2048 + h * 128 + 4 * cq;
        const f32x4 w0 = inv.w0, w1 = inv.w1, w2 = inv.w2, w3 = inv.w3;
        const float* cst = a.in[3] + ((size_t)(l * NBS + b) * 3) * QKV + col;
        f32x4 xr[19];
#pragma unroll
        for (int i = 0; i < 19; ++i) xr[i] = bf4_to_f32(xraw[i]);
        if (samp || n == 0) {
#pragma unroll
            for (int i = 0; i < 19; ++i) { const int tl = t0 - 3 + i; const bool use = (tl < L) && (tl >= 0); if (!use) xr[i] = (f32x4){0.f, 0.f, 0.f, 0.f}; }
            if (samp && t0 == 0) {
#pragma unroll
                for (int i = 0; i < 3; ++i) xr[i] = *(const GAS f32x4*)(cst + (size_t)i * QKV); } }
        unsigned tp[4][8];
#pragma unroll
        for (int rp = 0; rp < 8; ++rp) { const int r = 2 * rp;
            const f32x4 y0 = w0 * xr[r] + w1 * xr[r + 1] + w2 * xr[r + 2] + w3 * xr[r + 3], y1 = w0 * xr[r + 1] + w1 * xr[r + 2] + w2 * xr[r + 3] + w3 * xr[r + 4];
            f32x4 s0, s1; s0.x = silu_(y0.x); s0.y = silu_(y0.y); s0.z = silu_(y0.z); s0.w = silu_(y0.w); s1.x = silu_(y1.x); s1.y = silu_(y1.y); s1.z = silu_(y1.z); s1.w = silu_(y1.w);
            if (samp) { if (t0 + r >= L) s0 = (f32x4){0.f, 0.f, 0.f, 0.f}; if (t0 + r + 1 >= L) s1 = (f32x4){0.f, 0.f, 0.f, 0.f}; }
            if (p < 2) { LAS unsigned char* d = lds + (p == 0 ? L_QN : L_KN) + (t0 + r) * 272 + 8 * cq;
                *(LAS v2u*)d = (v2u){pk2(s0.x, s0.y), pk2(s0.z, s0.w)}; *(LAS v2u*)(d + 272) = (v2u){pk2(s1.x, s1.y), pk2(s1.z, s1.w)}; }
            if (p >= 1) { tp[0][rp] = pk2(s0.x, s1.x); tp[1][rp] = pk2(s0.y, s1.y); tp[2][rp] = pk2(s0.z, s1.z); tp[3][rp] = pk2(s0.w, s1.w); }
        }
        if (p >= 1) { const int base = (p == 1 ? L_KT : L_VT);
#pragma unroll
            for (int e = 0; e < 4; ++e) { LAS v4u* d = (LAS v4u*)(lds + base + (4 * cq + e) * 144 + t0 * 2);
                d[0] = (v4u){tp[e][0], tp[e][1], tp[e][2], tp[e][3]}; d[1] = (v4u){tp[e][4], tp[e][5], tp[e][6], tp[e][7]}; } }
        delta_issue(a, u_next, tid_in, xraw, sraw);
    } else if (wave == 7) {
        const bool valid = lane < L;
        const float bl = bflo(sraw), al = bfhi(sraw);
        delta_issue(a, u_next, tid_in, xraw, sraw);
        const float beta = valid ? sigmoid_(bl) : 0.f;
        float g = valid ? inv.nalog * softplus_(al + inv.dtb) : 0.f;
#pragma unroll
        for (int o = 1; o < 64; o <<= 1) { const float t = __shfl_up(g, o); if (lane >= o) g += t; }
        SCB[lane] = beta; SCG[lane] = g;
        if (lane == 63) *(GAS float*)(rec + DF_GL) = __expf(g);
    }
    LDS_BARRIER();
    {
        const int m = wave >> 1, n0 = 2 * (wave & 1);
        bf16x8 ak[4];
#pragma unroll
        for (int s = 0; s < 4; ++s) ak[s] = *(const LAS bf16x8*)(lds + L_KN + (16 * m + fr) * 272 + 16 * fq + 64 * s);
#pragma unroll
        for (int nn = 0; nn < 2; ++nn) { const int nt = n0 + nn;
            f32x4 kk = {0.f, 0.f, 0.f, 0.f}, qk = {0.f, 0.f, 0.f, 0.f};
#pragma unroll
            for (int s = 0; s < 4; ++s) { const bf16x8 bk = *(const LAS bf16x8*)(lds + L_KN + (16 * nt + fr) * 272 + 16 * fq + 64 * s), bq = *(const LAS bf16x8*)(lds + L_QN + (16 * nt + fr) * 272 + 16 * fq + 64 * s);
                kk = MFMA16(ak[s], bk, kk); qk = MFMA16(ak[s], bq, qk); }
#pragma unroll
            for (int r = 0; r < 4; ++r) { ((LAS float*)(lds + L_KK))[(16 * m + 4 * fq + r) * 68 + 16 * nt + fr] = kk[r]; ((LAS float*)(lds + L_QKT))[(16 * m + 4 * fq + r) * 64 + 16 * nt + fr] = qk[r];
                if (nt == m && 4 * fq + r == fr) RK2[16 * m + fr] = kk[r]; } }
        if (wave < 4) { f32x4 qq = {0.f, 0.f, 0.f, 0.f};
#pragma unroll
            for (int s = 0; s < 4; ++s) { const bf16x8 aq = *(const LAS bf16x8*)(lds + L_QN + (16 * wave + fr) * 272 + 16 * fq + 64 * s); qq = MFMA16(aq, aq, qq); }
#pragma unroll
            for (int r = 0; r < 4; ++r) if (4 * fq + r == fr) QQ2[16 * wave + fr] = qq[r]; }
    }
    LDS_BARRIER();
#pragma unroll
    for (int e = 0; e < 8; ++e) { const int idx = tid + 512 * e, i = idx >> 6, j = idx & 63; LAS float* p = (LAS float*)(lds + L_KK) + i * 68 + j;
        const float v = (i > j) ? SCB[i] * rsqrtf(RK2[i] + EPS) * rsqrtf(RK2[j] + EPS) * (*p) * __expf(SCG[i] - SCG[j]) : 0.f; *p = v; }
    LDS_BARRIER();
    if (wave == 0) {
        const LAS float* Ab = (const LAS float*)(lds + L_KK) + (16 * fq) * 68 + 16 * fq;
        float X[16]; X[0] = (fr == 0) ? 1.f : 0.f;
#pragma unroll
        for (int gi = 0; gi < 4; ++gi) { f32x4 ar[4][4];
#pragma unroll
            for (int ii = 0; ii < 4; ++ii)
#pragma unroll
                for (int qd = 0; qd <= gi; ++qd) ar[ii][qd] = *(const LAS f32x4*)(Ab + (4 * gi + ii) * 68 + 4 * qd);
#pragma unroll
            for (int ii = 0; ii < 4; ++ii) { const int i = 4 * gi + ii; if (i == 0) continue; float acc = (i == fr) ? 1.f : 0.f;
#pragma unroll
                for (int j = 0; j < i; ++j) acc -= ar[ii][j >> 2][j & 3] * X[j];
                X[i] = acc; } }
#pragma unroll
        for (int i = 0; i < 16; ++i) TS[(16 * fq + i) * 68 + 16 * fq + fr] = X[i];
    } else {
        for (int f = wave - 1; f < 8; f += 7) { const int mi = f >> 1, s2 = f & 1, i = 16 * mi + fr; const float si = rsqrtf(QQ2[i] + EPS) * 0.08838834764831845f, Gi = SCG[i];
            float v[8];
#pragma unroll
            for (int e = 0; e < 8; ++e) { const int j = 16 * (2 * s2 + (e >> 2)) + 4 * fq + (e & 3);
                v[e] = (i >= j) ? si * rsqrtf(RK2[j] + EPS) * ((const LAS float*)(lds + L_QKT))[j * 64 + i] * __expf(Gi - SCG[j]) : 0.f; }
            v4u o; o.x = pk2(v[0], v[1]); o.y = pk2(v[2], v[3]); o.z = pk2(v[4], v[5]); o.w = pk2(v[6], v[7]);
            *(LAS v4u*)(lds + L_QKF + (f * 64 + lane) * 16) = o; }
    }
    LDS_BARRIER();
#pragma unroll
    for (int d = 1; d < 4; ++d) {
        if (wave < 4 - d) { const int bi = wave + d, bj = wave; const LAS float* As = (const LAS float*)(lds + L_KK);
            f32x4 P = {0.f, 0.f, 0.f, 0.f};
            for (int k = bj; k < bi; ++k)
#pragma unroll
                for (int kk = 0; kk < 4; ++kk) P = __builtin_amdgcn_mfma_f32_16x16x4f32(As[(16 * bi + fr) * 68 + 16 * k + 4 * kk + fq], TS[(16 * k + 4 * kk + fq) * 68 + 16 * bj + fr], P, 0, 0, 0);
            f32x4 R = {0.f, 0.f, 0.f, 0.f};
#pragma unroll
            for (int kk = 0; kk < 4; ++kk) R = __builtin_amdgcn_mfma_f32_16x16x4f32(TS[(16 * bi + fr) * 68 + 16 * bi + 4 * fq + kk], P[kk], R, 0, 0, 0);
#pragma unroll
            for (int r = 0; r < 4; ++r) TS[(16 * bi + 4 * fq + r) * 68 + 16 * bj + fr] = -R[r]; }
        LDS_BARRIER();
    }
#pragma unroll
    for (int e = 0; e < 8; ++e) { const int idx = tid + 512 * e, i = idx >> 6, j = idx & 63; const float t = (i >= j) ? TS[i * 68 + j] : 0.f, bj = SCB[j];
        *(LAS bf16*)(lds + L_TU + i * 144 + 2 * j) = (bf16)f2bf(t * bj); *(LAS bf16*)(lds + L_TW + i * 144 + 2 * j) = (bf16)f2bf(t * bj * rsqrtf(RK2[j] + EPS) * __expf(SCG[j])); }
    LDS_BARRIER();
    {
        bf16x8 bk[2], bv[2];
#pragma unroll
        for (int s2 = 0; s2 < 2; ++s2) { bk[s2] = *(const LAS bf16x8*)(lds + L_KT + (16 * wave + fr) * 144 + 16 * fq + 64 * s2); bv[s2] = *(const LAS bf16x8*)(lds + L_VT + (16 * wave + fr) * 144 + 16 * fq + 64 * s2); }
        f32x4 wt[4], ut[4];
#pragma unroll
        for (int mi = 0; mi < 4; ++mi) { wt[mi] = (f32x4){0.f, 0.f, 0.f, 0.f}; ut[mi] = (f32x4){0.f, 0.f, 0.f, 0.f};
#pragma unroll
            for (int s2 = 0; s2 < 2; ++s2) { const bf16x8 aw = *(const LAS bf16x8*)(lds + L_TW + (16 * mi + fr) * 144 + 16 * fq + 64 * s2), au = *(const LAS bf16x8*)(lds + L_TU + (16 * mi + fr) * 144 + 16 * fq + 64 * s2);
                wt[mi] = MFMA16(aw, bk[s2], wt[mi]); ut[mi] = MFMA16(au, bv[s2], ut[mi]); } }
        const bf16x8 wA[2] = {pack8(wt[0], wt[1]), pack8(wt[2], wt[3])}, uB[2] = {pack8(ut[0], ut[1]), pack8(ut[2], ut[3])};
        const float glast = SCG[63];
        float ksc[2][2][4];
#pragma unroll
        for (int s2 = 0; s2 < 2; ++s2)
#pragma unroll
            for (int hh = 0; hh < 2; ++hh)
#pragma unroll
                for (int e = 0; e < 4; ++e) { const int j = 16 * (2 * s2 + hh) + 4 * fq + e; ksc[s2][hh][e] = rsqrtf(RK2[j] + EPS) * __expf(glast - SCG[j]); }
        const int half = 8 * (wave & 1), sw = wave >> 1;
#pragma unroll
        for (int m = 0; m < 8; ++m) { bf16x8 kdf[2];
#pragma unroll
            for (int s2 = 0; s2 < 2; ++s2) { f32x4 x[2];
#pragma unroll
                for (int hh = 0; hh < 2; ++hh) { x[hh] = bf4_to_f32(*(const LAS v2u*)(lds + L_KT + (16 * m + fr) * 144 + 2 * (16 * (2 * s2 + hh) + 4 * fq)));
#pragma unroll
                    for (int e = 0; e < 4; ++e) x[hh][e] *= ksc[s2][hh][e]; }
                kdf[s2] = pack8(x[0], x[1]); }
            f32x4 c0 = {0.f, 0.f, 0.f, 0.f}, c1 = {0.f, 0.f, 0.f, 0.f};
#pragma unroll
            for (int s2 = 0; s2 < 2; ++s2) { c0 = MFMA16(wA[s2], kdf[s2], c0); c1 = MFMA16(kdf[s2], uB[s2], c1); }
            v2u o; o.x = pk2(-c0[0], -c0[1]); o.y = pk2(-c0[2], -c0[3]); *(GAS v2u*)(rec + DF_MP + (size_t)((m * 4 + sw) * 64 + lane) * 16 + half) = o;
            v2u p; p.x = pk2(c1[0], c1[1]); p.y = pk2(c1[2], c1[3]); *(GAS v2u*)(rec + DF_BN + (size_t)((wave * 8 + m) * 64 + lane) * 8) = p; }
#pragma unroll
        for (int ni = 0; ni < 4; ++ni) { const int i = 16 * ni + fr; f32x4 c0 = {0.f, 0.f, 0.f, 0.f}, c1 = {0.f, 0.f, 0.f, 0.f};
#pragma unroll
            for (int s2 = 0; s2 < 2; ++s2) { const bf16x8 qf = *(const LAS bf16x8*)(lds + L_QKF + ((ni * 2 + s2) * 64 + lane) * 16); c0 = MFMA16(wA[s2], qf, c0); c1 = MFMA16(qf, uB[s2], c1); }
            const float sc = rsqrtf(QQ2[i] + EPS) * 0.08838834764831845f * __expf(SCG[i]);
            const f32x4 qv = bf4_to_f32(*(const LAS v2u*)(lds + L_QN + i * 272 + 2 * (16 * wave + 4 * fq)));
            v2u o; o.x = pk2(qv[0] * sc - c0[0], qv[1] * sc - c0[1]); o.y = pk2(qv[2] * sc - c0[2], qv[3] * sc - c0[3]); __builtin_nontemporal_store(o, (GAS v2u*)(rec + DF_QE + (size_t)((ni * 4 + sw) * 64 + lane) * 16 + half));
            v2u p; p.x = pk2(c1[0], c1[1]); p.y = pk2(c1[2], c1[3]); __builtin_nontemporal_store(p, (GAS v2u*)(rec + DF_OU + (size_t)((wave * 4 + ni) * 64 + lane) * 8)); }
    }
    LDS_BARRIER();
}
struct LInv { f32x4 w0, w1, w2, w3, bc; bf16x8 bw[2][4]; float ba, bx, c8; };
DI void lru_inv_load(const Args& a, int l, int g, int tid, LInv& v) {
    const int lane = tid & 63, wave = tid >> 6, fr = lane & 15, fq = lane >> 4, cq = tid & 31, ch = g * 128 + 4 * cq;
    const float* wc = a.in[12] + (size_t)l * 4 * DB + ch;
    v.w0 = *(const GAS f32x4*)(wc); v.w1 = *(const GAS f32x4*)(wc + DB); v.w2 = *(const GAS f32x4*)(wc + 2 * DB); v.w3 = *(const GAS f32x4*)(wc + 3 * DB); v.bc = *(const GAS f32x4*)(a.in[13] + (size_t)l * DB + ch);
    const bf16* WG = (const bf16*)(a.ws + WS_WG);
#pragma unroll
    for (int gt = 0; gt < 2; ++gt)
#pragma unroll
        for (int s = 0; s < 4; ++s) v.bw[gt][s] = *(const GAS bf16x8*)(WG + ((size_t)(gt * NH + g) * 128 + 16 * wave + fr) * 128 + 32 * s + 8 * fq);
    const int chj = g * 128 + 16 * wave + fr;
    v.ba = a.in[15][(size_t)l * DB + chj]; v.bx = a.in[17][(size_t)l * DB + chj]; v.c8 = -8.f * softplus_(-a.in[18][(size_t)l * DB + chj]);
}
DI void lru_issue(const Args& a, int u, int tid, v2u (&xraw)[7]) {
    asm volatile("" : "+v"(tid));
    bool samp; int b, n, g, rowbase, L; unit_decode(u, samp, b, n, g, rowbase, L);
    const bf16* PROJ = (const bf16*)(a.ws + WS_PROJ);
    const int cq = tid & 31, rs = tid >> 5, t0 = rs * 4, col = C_XL + g * 128 + 4 * cq;
#pragma unroll
    for (int i = 0; i < 7; ++i) { int row = rowbase + t0 - 3 + i; row = row < 0 ? 0 : row; xraw[i] = *(const GAS v2u*)(PROJ + (size_t)row * NINP + col); }
}
DI void lru_prepass_unit(const Args& a, int l, int u, int u_next, LAS unsigned char* lds, int tid, v2u (&xraw)[7], const LInv& inv) {
    const int tid_in = tid; asm volatile("" : "+v"(tid)); const int lane = tid & 63, wave = __builtin_amdgcn_readfirstlane(tid >> 6);
    bool samp; int b, n, g, rowbase, L; unit_decode(u, samp, b, n, g, rowbase, L);
    const bf16* PROJ = (const bf16*)(a.ws + WS_PROJ); const bf16* WG = (const bf16*)(a.ws + WS_WG);
    bf16* HLOC = (bf16*)(a.ws + WS_HLOC); bf16* CUM = (bf16*)(a.ws + WS_CUM);
    const int fr = lane & 15, fq = lane >> 4;
    LAS float* XCF = (LAS float*)(lds + L_XCF); LAS float* AS = (LAS float*)(lds + L_AS); LAS float* BS = (LAS float*)(lds + L_BS); LAS float* SEGA = (LAS float*)(lds + L_SEG); LAS float* SEGB = SEGA + 1024;
    {
        const int cq = tid & 31, rs = tid >> 5, t0 = rs * 4, ch = g * 128 + 4 * cq, col = C_XL + ch;
        const f32x4 w0 = inv.w0, w1 = inv.w1, w2 = inv.w2, w3 = inv.w3, bc = inv.bc;
        const float* cst = a.in[5] + ((size_t)(l * NBS + b) * 3) * DB + ch;
        f32x4 xr[7];
#pragma unroll
        for (int i = 0; i < 7; ++i) { const int tl = t0 - 3 + i;
            const bool use = (tl < L) && (tl >= 0 || (!samp && n > 0)); const f32x4 x = bf4_to_f32(xraw[i]);
            xr[i] = (f32x4){use ? x.x : 0.f, use ? x.y : 0.f, use ? x.z : 0.f, use ? x.w : 0.f}; }
        if (samp && t0 == 0) {
#pragma unroll
            for (int i = 0; i < 3; ++i) xr[i] = *(const GAS f32x4*)(cst + (size_t)i * DB); }
        lru_issue(a, u_next, tid_in, xraw);
#pragma unroll
        for (int r = 0; r < 4; ++r) { const f32x4 y = w0 * xr[r] + w1 * xr[r + 1] + w2 * xr[r + 2] + w3 * xr[r + 3] + bc;
            v2u o; o.x = pk2(y.x, y.y); o.y = pk2(y.z, y.w); *(LAS v2u*)(lds + L_XCB + (t0 + r) * 272 + 8 * cq) = o; *(LAS f32x4*)(XCF + (t0 + r) * 132 + 4 * cq) = y; }
    }
    LDS_BARRIER();
    {
        f32x4 acc[2][4];
#pragma unroll
        for (int gt = 0; gt < 2; ++gt) {
#pragma unroll
            for (int mi = 0; mi < 4; ++mi) { f32x4 c = {0.f, 0.f, 0.f, 0.f};
#pragma unroll
                for (int s = 0; s < 4; ++s) { const bf16x8 ax = *(const LAS bf16x8*)(lds + L_XCB + (16 * mi + fr) * 272 + 16 * fq + 64 * s); c = MFMA16(ax, inv.bw[gt][s], c); }
                acc[gt][mi] = c; } }
        const int j = 16 * wave + fr, ch = g * 128 + j;
        const float ba = inv.ba, bx = inv.bx, c8 = inv.c8;
#pragma unroll
        for (int mi = 0; mi < 4; ++mi)
#pragma unroll
            for (int r = 0; r < 4; ++r) { const int t = 16 * mi + 4 * fq + r; const float xc = XCF[t * 132 + j];
                const float gr = sigmoid_(acc[0][mi][r] + ba), gi = sigmoid_(acc[1][mi][r] + bx), la = c8 * gr;
                float av = __expf(la), bvv = __builtin_amdgcn_sqrtf(fmaxf(1.f - av * av, 0.f)) * gi * xc;
                if (t >= L) { av = 1.f; bvv = 0.f; }
                AS[t * 132 + j] = av; BS[t * 132 + j] = bvv; }
    }
    LDS_BARRIER();
    {
        const int j2 = tid & 63, seg = tid >> 6; float P0 = 1.f, H0 = 0.f, P1 = 1.f, H1 = 0.f;
#pragma unroll
        for (int r = 0; r < 8; ++r) { const int t = seg * 8 + r; LAS float* pa = AS + t * 132 + 2 * j2; LAS float* pb = BS + t * 132 + 2 * j2;
            const float a0 = pa[0], a1 = pa[1], b0 = pb[0], b1 = pb[1]; H0 = a0 * H0 + b0; P0 *= a0; H1 = a1 * H1 + b1; P1 *= a1; pa[0] = P0; pa[1] = P1; pb[0] = H0; pb[1] = H1; }
        SEGA[seg * 128 + 2 * j2] = P0; SEGA[seg * 128 + 2 * j2 + 1] = P1; SEGB[seg * 128 + 2 * j2] = H0; SEGB[seg * 128 + 2 * j2 + 1] = H1;
        LDS_BARRIER();
        float Pc0 = 1.f, Hc0 = 0.f, Pc1 = 1.f, Hc1 = 0.f;
        for (int s = 0; s < seg; ++s) { const float sa0 = SEGA[s * 128 + 2 * j2], sa1 = SEGA[s * 128 + 2 * j2 + 1]; Hc0 = sa0 * Hc0 + SEGB[s * 128 + 2 * j2]; Pc0 *= sa0; Hc1 = sa1 * Hc1 + SEGB[s * 128 + 2 * j2 + 1]; Pc1 *= sa1; }
        float* CHK = (float*)(a.ws + WS_CHK) + (size_t)u * 256;
#pragma unroll
        for (int r = 0; r < 8; ++r) { const int t = seg * 8 + r; if (t < L) { const float pa0 = AS[t * 132 + 2 * j2], pa1 = AS[t * 132 + 2 * j2 + 1], hb0 = BS[t * 132 + 2 * j2], hb1 = BS[t * 132 + 2 * j2 + 1];
                const float h0 = hb0 + pa0 * Hc0, h1 = hb1 + pa1 * Hc1, c0 = Pc0 * pa0, c1 = Pc1 * pa1; const size_t o = (size_t)(rowbase + t) * DB + g * 128 + 2 * j2;
                __builtin_nontemporal_store(pk2(h0, h1), (GAS unsigned*)(HLOC + o)); __builtin_nontemporal_store(pk2(c0, c1), (GAS unsigned*)(CUM + o));
                if (t == L - 1) { *(GAS f32x2_t*)(CHK + 2 * j2) = (f32x2_t){c0, c1}; *(GAS f32x2_t*)(CHK + 128 + 2 * j2) = (f32x2_t){h0, h1}; } } }
    }
    LDS_BARRIER();
}

DI void delta_sample_task(const Args& a, int l, int ts, int lane) {
    const int fr = lane & 15, fq = lane >> 4, b = ts >> 7, h = (ts >> 3) & 15, vs = ts & 7, u = NUNIT_P + b * NH + h;
    const unsigned char* rec = a.ws + WS_DF + (size_t)u * DF_STRIDE;
    const float* s0 = a.in[2] + ((size_t)(l * NBS + b) * NH + h) * 128 * 128;
    f32x4 S[8];
#pragma unroll
    for (int m = 0; m < 8; ++m)
#pragma unroll
        for (int r = 0; r < 4; ++r) S[m][r] = *(const GAS float*)(s0 + (size_t)(16 * m + 4 * fq + r) * 128 + 16 * vs + fr);
    bf16x8 Sb[4];
#pragma unroll
    for (int s = 0; s < 4; ++s) { Sb[s] = pack8(S[2 * s], S[2 * s + 1]); *(GAS bf16x8*)(a.ws + WS_SST + (size_t)u * 32768 + (size_t)((vs * 4 + s) * 64 + lane) * 16) = Sb[s]; }
    const float gl = *(const GAS float*)(rec + DF_GL);
    float* so = a.out + O_SD + ((size_t)(l * NBS + b) * NH + h) * 128 * 128;
#pragma unroll
    for (int m = 0; m < 8; ++m) { f32x4 acc = S[m] * gl + bf4_to_f32(*(const GAS v2u*)(rec + DF_BN + (size_t)((vs * 8 + m) * 64 + lane) * 8));
#pragma unroll
        for (int s = 0; s < 4; ++s) acc = MFMA16(*(const GAS bf16x8*)(rec + DF_MP + (size_t)((m * 4 + s) * 64 + lane) * 16), Sb[s], acc);
#pragma unroll
        for (int r = 0; r < 4; ++r) *(GAS float*)(so + (size_t)(16 * m + 4 * fq + r) * 128 + 16 * vs + fr) = acc[r]; }
}
DI void seq_phase(const Args& a, int l, int c, LAS unsigned char* lds, int wave, int lane) {
    const float* CHK = (const float*)(a.ws + WS_CHK); float* HIN = (float*)(a.ws + WS_HIN);
    if (c >= 128) { const int cc = c - 128;
        delta_sample_task(a, l, cc * 8 + wave, lane);
        if (wave < 2) { const int idx = (cc * 2 + wave) * 64 + lane, b = idx >> 11, ch = idx & 2047; const float* ck = CHK + (size_t)(NUNIT_P + b * NH + (ch >> 7)) * 256 + (ch & 127);
            *(GAS float*)(a.out + O_SL + (size_t)(l * NBS + b) * DB + ch) = *(const GAS float*)(ck) * a.in[4][(size_t)(l * NBS + b) * DB + ch] + *(const GAS float*)(ck + 128); }
        convert_range2(a, l, I_IN + I_G + cc * NWAVES + wave, CV_SPLIT, 128 * NWAVES, (LAS float*)(lds + wave * 16384), lane);
        return; }
    const int jj = c >> 3, bh = (c & 7) * 4 + (jj >> 2), vs = (jj & 3) * 2 + (wave & 1), b = bh >> 4, h = bh & 15, fr = lane & 15, fq = lane >> 4;
    const int u0 = (b << 11) + h;
    const unsigned char* rec0 = a.ws + WS_DF + (size_t)u0 * DF_STRIDE; constexpr size_t USTEP = 16 * DF_STRIDE;
    const int lw = wave - 2;
    unsigned soff[8], doff[8];
#pragma unroll
    for (int k = 0; k < 8; ++k) { const int p = lw * 8 + k; soff[k] = (unsigned)(p < 32 ? DF_MP + p * 1024 : DF_BN + (jj & 3) * 8192 + (p - 32) * 1024) + lane * 16; doff[k] = (unsigned)(p * 1024 + lane * 16); }
    const int lidx = (c & 63) * 64 + lane, lb = lidx >> 11, lch = lidx & 2047;
    const bool lru_on = (wave == 7) && (c < 64);
    float* hin_w = HIN + (c < 64 ? (size_t)0 : (size_t)NBP * NCH * DB);
    f32x4 S[8]; float H = 0.f;
#pragma unroll
    for (int m = 0; m < 8; ++m) S[m] = (f32x4){0.f, 0.f, 0.f, 0.f};
#define SQ_BAR() do { asm volatile("s_waitcnt lgkmcnt(0)" ::: "memory"); __builtin_amdgcn_s_barrier(); asm volatile("" ::: "memory"); } while (0)
    if (wave < 2) {
        SQ_BAR();
        for (int n = 0; n < NCH; ++n) { LAS unsigned char* sb = lds + L_SQ + (n & 1) * SQ_SLOT;
            bf16x8 Sb[4];
#pragma unroll
            for (int s = 0; s < 4; ++s) { Sb[s] = pack8(S[2 * s], S[2 * s + 1]); __builtin_nontemporal_store(Sb[s], (GAS bf16x8*)(a.ws + WS_SST + (size_t)(u0 + 16 * n) * 32768 + (size_t)((vs * 4 + s) * 64 + lane) * 16)); }
            bf16x8 mp[8][4]; v2u bn[8];
#pragma unroll
            for (int m = 0; m < 8; ++m) {
#pragma unroll
                for (int s = 0; s < 4; ++s) mp[m][s] = *(const LAS bf16x8*)(sb + ((m * 4 + s) * 64 + lane) * 16);
                bn[m] = *(const LAS v2u*)(sb + 32768 + wave * 4096 + (m * 64 + lane) * 8); }
            const float gl = *(const LAS float*)(sb + 40960);
            __builtin_amdgcn_sched_barrier(0);
#pragma unroll
            for (int m = 0; m < 8; ++m) S[m] = S[m] * gl + bf4_to_f32(bn[m]);
#pragma unroll
            for (int s = 0; s < 4; ++s)
#pragma unroll
                for (int m = 0; m < 8; ++m) S[m] = MFMA16(mp[m][s], Sb[s], S[m]);
            __builtin_amdgcn_sched_barrier(0);
            SQ_BAR(); }
    } else if (wave <= 6) {
        v4u buf[4][8]; float glb[4];
#define SQ_ISSUE(q, n) do { const int n_ = (n) < NCH ? (n) : NCH - 1; const unsigned char* r_ = rec0 + (size_t)n_ * USTEP; \
        _Pragma("unroll") for (int k = 0; k < 8; ++k) buf[q][k] = *(const GAS v4u*)(r_ + soff[k]); glb[q] = *(const GAS float*)(r_ + DF_GL); } while (0)
#define SQ_WRITE(q, slot) do { _Pragma("unroll") for (int k = 0; k < 8; ++k) *(LAS v4u*)(lds + L_SQ + (slot) * SQ_SLOT + doff[k]) = buf[q][k]; \
        *(LAS float*)(lds + L_SQ + (slot) * SQ_SLOT + 40960 + 4 * (4 - lw)) = glb[q]; } while (0)
        SQ_ISSUE(0, 0); SQ_ISSUE(1, 1); SQ_ISSUE(2, 2); SQ_ISSUE(3, 3);
        SQ_WRITE(0, 0);
        SQ_BAR();
        for (int t = 0; t < NCH; t += 4) {
#pragma unroll
            for (int q = 0; q < 4; ++q) {
                SQ_ISSUE(q, t + q + 4);
                SQ_WRITE((q + 1) & 3, (q + 1) & 1);
                SQ_BAR(); } }
#undef SQ_ISSUE
#undef SQ_WRITE
    } else {
        float la[4], lbv[4];
#define LR_ISSUE(q, n) do { const int n_ = (n) < NCH ? (n) : NCH - 1; const float* ck_ = CHK + (size_t)((lb << 11) + (n_ << 4) + (lch >> 7)) * 256 + (lch & 127); la[q] = *(const GAS float*)(ck_); lbv[q] = *(const GAS float*)(ck_ + 128); } while (0)
        LR_ISSUE(0, 0); LR_ISSUE(1, 1); LR_ISSUE(2, 2); LR_ISSUE(3, 3);
        SQ_BAR();
        for (int t = 0; t < NCH; t += 4) {
#pragma unroll
            for (int q = 0; q < 4; ++q) {
                *(GAS float*)(hin_w + (size_t)(lb * NCH + t + q) * DB + lch) = H; H = la[q] * H + lbv[q]; LR_ISSUE(q, t + q + 4);
                SQ_BAR(); } }
#undef LR_ISSUE
    }
#undef SQ_BAR
    if (wave < 2) { float* so = a.out + O_PD + ((size_t)(l * NBP + b) * NH + h) * 128 * 128;
#pragma unroll
        for (int m = 0; m < 8; ++m)
#pragma unroll
            for (int r = 0; r < 4; ++r) *(GAS float*)(so + (size_t)(16 * m + 4 * fq + r) * 128 + 16 * vs + fr) = S[m][r]; }
    else if (lru_on) *(GAS float*)(a.out + O_PL + (size_t)(l * NBP + lb) * DB + lch) = H;
}
struct PostRaw { bf16x8 sb[4]; bf16x8 qe[16]; v2u ou[4]; v4u z[2]; };
DI void delta_post_issue(const Args& a, int u, int tid, PostRaw& r) {
    asm volatile("" : "+v"(tid)); const int lane = tid & 63, wave = __builtin_amdgcn_readfirstlane(tid >> 6);
    bool samp; int b, n, h, rowbase, L; unit_decode(u, samp, b, n, h, rowbase, L);
    const unsigned char* rec = a.ws + WS_DF + (size_t)u * DF_STRIDE; const unsigned char* sst = a.ws + WS_SST + (size_t)u * 32768 + (size_t)wave * 4096;
#pragma unroll
    for (int s = 0; s < 4; ++s) r.sb[s] = *(const GAS bf16x8*)(sst + (size_t)(s * 64 + lane) * 16);
#pragma unroll
    for (int i = 0; i < 16; ++i) r.qe[i] = *(const GAS bf16x8*)(rec + DF_QE + (size_t)(i * 64 + lane) * 16);
#pragma unroll
    for (int mi = 0; mi < 4; ++mi) r.ou[mi] = *(const GAS v2u*)(rec + DF_OU + (size_t)((wave * 4 + mi) * 64 + lane) * 8);
    const int row = tid >> 3, seg = tid & 7; const size_t grow = (size_t)(rowbase + (row < L ? row : 0));
#pragma unroll
    for (int k2 = 0; k2 < 2; ++k2) r.z[k2] = *(const GAS v4u*)((const bf16*)(a.ws + WS_PROJ) + grow * NINP + C_Z + h * 128 + 16 * seg + 8 * k2);
}
DI void delta_post_unit(const Args& a, int l, int u, int u_next, LAS unsigned char* lds, int tid, PostRaw& raw, const f32x4 (&wnd)[4]) {
    const int tid_in = tid; asm volatile("" : "+v"(tid)); const int lane = tid & 63, wave = __builtin_amdgcn_readfirstlane(tid >> 6), fr = lane & 15, fq = lane >> 4;
    bool samp; int b, n, h, rowbase, L; unit_decode(u, samp, b, n, h, rowbase, L);
    LAS float* OL = (LAS float*)(lds + L_OL);
#pragma unroll
    for (int mi = 0; mi < 4; ++mi) { f32x4 acc = bf4_to_f32(raw.ou[mi]);
#pragma unroll
        for (int s = 0; s < 4; ++s) acc = MFMA16(raw.qe[mi * 4 + s], raw.sb[s], acc);
#pragma unroll
        for (int r = 0; r < 4; ++r) OL[(16 * mi + 4 * fq + r) * 132 + 16 * wave + fr] = acc[r]; }
    const v4u z0 = raw.z[0], z1 = raw.z[1];
    delta_post_issue(a, u_next, tid_in, raw);
    LDS_BARRIER();
    {   const int row = tid >> 3, seg = tid & 7; f32x4 o[4]; float ss = 0.f;
#pragma unroll
        for (int k = 0; k < 4; ++k) { o[k] = *(const LAS f32x4*)(OL + row * 132 + 16 * seg + 4 * k); ss += (o[k].x * o[k].x + o[k].y * o[k].y) + (o[k].z * o[k].z + o[k].w * o[k].w); }
        ss += __shfl_xor(ss, 1); ss += __shfl_xor(ss, 2); ss += __shfl_xor(ss, 4);
        const float rs = rsqrtf(ss * (1.f / 128.f) + EPS);
        if (row < L) { const size_t grow = (size_t)(rowbase + row);
#pragma unroll
            for (int k2 = 0; k2 < 2; ++k2) { const v4u zz = k2 ? z1 : z0;
                const f32x4 w0 = wnd[2 * k2], w1 = wnd[2 * k2 + 1]; const f32x4 a0 = o[2 * k2], a1 = o[2 * k2 + 1];
                v4u r; r.x = pk2(a0.x * rs * w0.x * silu_(bflo(zz.x)), a0.y * rs * w0.y * silu_(bfhi(zz.x))); r.y = pk2(a0.z * rs * w0.z * silu_(bflo(zz.y)), a0.w * rs * w0.w * silu_(bfhi(zz.y)));
                r.z = pk2(a1.x * rs * w1.x * silu_(bflo(zz.z)), a1.y * rs * w1.y * silu_(bfhi(zz.z))); r.w = pk2(a1.z * rs * w1.z * silu_(bflo(zz.w)), a1.w * rs * w1.w * silu_(bfhi(zz.w)));
                *(GAS v4u*)((bf16*)(a.ws + WS_MIX) + grow * D + h * 128 + 16 * seg + 8 * k2) = r; } }
    }
    LDS_BARRIER();
}
struct LruRowRaw { v4u yy[4], hl[4], cm[4]; f32x4 hi[8]; };
DI void post_row_load(const Args& a, int l, int row, int lane, LruRowRaw& r) {
    const bf16* PROJ = (const bf16*)(a.ws + WS_PROJ); const bf16* HLOC = (const bf16*)(a.ws + WS_HLOC); const bf16* CUM = (const bf16*)(a.ws + WS_CUM);
    const float* hin = row < MP ? (const float*)(a.ws + WS_HIN) + (size_t)((row >> 13) * NCH + ((row & (SEQ - 1)) >> 6)) * DB : a.in[4] + (size_t)(l * NBS + ((row - MP) >> 4)) * DB;
    const int c0 = 32 * lane;
#pragma unroll
    for (int k2 = 0; k2 < 4; ++k2) { r.yy[k2] = *(const GAS v4u*)(PROJ + (size_t)row * NINP + C_YL + c0 + 8 * k2); const size_t o = (size_t)row * DB + c0 + 8 * k2;
        r.hl[k2] = *(const GAS v4u*)(HLOC + o); r.cm[k2] = *(const GAS v4u*)(CUM + o); r.hi[2 * k2] = *(const GAS f32x4*)(hin + c0 + 8 * k2); r.hi[2 * k2 + 1] = *(const GAS f32x4*)(hin + c0 + 8 * k2 + 4); }
}
DI void post_row_finish(const Args& a, int row, int lane, const LruRowRaw& r, const f32x4 (&wn)[8]) {
    bf16* MIX = (bf16*)(a.ws + WS_MIX); const int c0 = 32 * lane;
    float y[32]; float ss = 0.f;
#pragma unroll
    for (int k2 = 0; k2 < 4; ++k2) { const v4u yy = r.yy[k2], hl8 = r.hl[k2], cm8 = r.cm[k2];
        const float gy[8] = {bflo(yy.x), bfhi(yy.x), bflo(yy.y), bfhi(yy.y), bflo(yy.z), bfhi(yy.z), bflo(yy.w), bfhi(yy.w)};
        const float hl[8] = {bflo(hl8.x), bfhi(hl8.x), bflo(hl8.y), bfhi(hl8.y), bflo(hl8.z), bfhi(hl8.z), bflo(hl8.w), bfhi(hl8.w)};
        const float cm[8] = {bflo(cm8.x), bfhi(cm8.x), bflo(cm8.y), bfhi(cm8.y), bflo(cm8.z), bfhi(cm8.z), bflo(cm8.w), bfhi(cm8.w)};
#pragma unroll
        for (int hh = 0; hh < 2; ++hh) { const f32x4 hi = r.hi[2 * k2 + hh];
#pragma unroll
            for (int e = 0; e < 4; ++e) { const float hv = hl[4 * hh + e] + cm[4 * hh + e] * hi[e]; const float v = gelu_tanh_(gy[4 * hh + e]) * hv; y[8 * k2 + 4 * hh + e] = v; ss += v * v; } } }
    const float rs = rsqrtf(wave_sum(ss) * (1.f / DB) + EPS);
#pragma unroll
    for (int k2 = 0; k2 < 4; ++k2) { const f32x4 w0 = wn[2 * k2], w1 = wn[2 * k2 + 1];
        v4u o; o.x = pk2(y[8 * k2] * rs * w0.x, y[8 * k2 + 1] * rs * w0.y); o.y = pk2(y[8 * k2 + 2] * rs * w0.z, y[8 * k2 + 3] * rs * w0.w);
        o.z = pk2(y[8 * k2 + 4] * rs * w1.x, y[8 * k2 + 5] * rs * w1.y); o.w = pk2(y[8 * k2 + 6] * rs * w1.z, y[8 * k2 + 7] * rs * w1.w);
        *(GAS v4u*)(MIX + (size_t)row * D + DA + c0 + 8 * k2) = o; }
}
DI void post_phase(const Args& a, int l, int gw, int NGW, int lane) {
    bf16* MIX = (bf16*)(a.ws + WS_MIX); const bf16* PROJ = (const bf16*)(a.ws + WS_PROJ);
    f32x4 wn[8];
#pragma unroll
    for (int k = 0; k < 8; ++k) wn[k] = *(const GAS f32x4*)(a.in[19] + (size_t)l * DB + 32 * lane + 4 * k);
    {
        LruRowRaw ra; int m = gw; if (m < MR) post_row_load(a, l, m, lane, ra);
        for (; m < MR; m += NGW) { const int mn = m + NGW < MR ? m + NGW : m; LruRowRaw rb; post_row_load(a, l, mn, lane, rb); post_row_finish(a, m, lane, ra, wn); ra = rb; } }
    for (int m = MR + gw; m < MPAD; m += NGW) { GAS v4u* o = (GAS v4u*)(MIX + (size_t)m * D) + lane;
#pragma unroll
        for (int j = 0; j < 8; ++j) o[64 * j] = (v4u){0u, 0u, 0u, 0u}; }
    const int gt = gw * 64 + lane, NT = NGW * 64;
    for (int i = gt; i < (NBP + NBS) * 3 * 8192; i += NT) { const int col = i & 8191, rr = (i >> 13) % 3, st = i / (3 * 8192);
        const int row = st < NBP ? st * SEQ + SEQ - 3 + rr : MP + (st - NBP) * LS + LS - 3 + rr;
        const float v = bf2f(*(const GAS bf16*)(PROJ + (size_t)row * NINP + (col < QKV ? col : C_XL + col - QKV)));
        if (col < QKV) { float* d = st < NBP ? a.out + O_PCD + ((size_t)(l * NBP + st) * 3 + rr) * QKV : a.out + O_SCD + ((size_t)(l * NBS + st - NBP) * 3 + rr) * QKV; *(GAS float*)(d + col) = v; }
        else { float* d = st < NBP ? a.out + O_PCL + ((size_t)(l * NBP + st) * 3 + rr) * DB : a.out + O_SCL + ((size_t)(l * NBS + st - NBP) * 3 + rr) * DB; *(GAS float*)(d + col - QKV) = v; } }
}
DI void final_norm_phase(const Args& a, int gw, int NGW, int lane) {
    const GAS f32x4* wr = (const GAS f32x4*)a.in[24] + lane;
    for (int mb = gw; mb < MR; mb += 2 * NGW) { f32x4 v[2][16];
#pragma unroll
        for (int r = 0; r < 2; ++r) { const int m = mb + r * NGW < MR ? mb + r * NGW : mb; const GAS f32x4* xr = (const GAS f32x4*)(a.out + (size_t)m * D) + lane;
#pragma unroll
            for (int j = 0; j < 16; ++j) v[r][j] = xr[64 * j]; }
#pragma unroll
        for (int r = 0; r < 2; ++r) { const int m = mb + r * NGW; float s = 0.f;
#pragma unroll
            for (int j = 0; j < 16; ++j) s += (v[r][j].x * v[r][j].x + v[r][j].y * v[r][j].y) + (v[r][j].z * v[r][j].z + v[r][j].w * v[r][j].w);
            const float rstd = rsqrtf(wave_sum(s) * (1.f / D) + EPS);
            if (m < MR) { GAS f32x4* xo = (GAS f32x4*)(a.out + (size_t)m * D) + lane;
#pragma unroll
                for (int j = 0; j < 16; ++j) xo[64 * j] = v[r][j] * rstd * wr[64 * j]; } } }
}
constexpr int TG_A = 0, TG_B = 34816, TG_BUF = 52224;
static_assert(2 * TG_BUF <= LDSCTL_OFF && 4 * 8704 * 4 <= LDSCTL_OFF, "thin GEMM LDS");
template <class F> DI void thin_gemm_unit(const bf16* A, int lda, int a_blk, int arow0, const bf16* Bt, int ldb, int b_blk, int brow0, int kslab, LAS unsigned char* lds, int tid, F&& epi) {
    asm volatile("" : "+v"(tid)); const int lane = tid & 63, wave = __builtin_amdgcn_readfirstlane(tid >> 6), fr = lane & 15, fq = lane >> 4, wm = wave >> 2, ks = wave & 3;
    const int nchunk = kslab >> 7, koff = (int)(blockIdx.x >> 3) & (nchunk - 1);
    const bf16* ga[4]; const bf16* gb[2]; unsigned da[4], db[2];
#pragma unroll
    for (int i = 0; i < 4; ++i) { const int row = 16 * wave + 4 * i + fq; ga[i] = a_blk ? A + (size_t)(fr >> 3) * 16384 + (size_t)(arow0 + row) * 64 + 8 * (fr & 7) : A + (size_t)row * lda + 8 * fr; da[i] = (unsigned)(TG_A + row * 272 + 16 * fr); }
#pragma unroll
    for (int i = 0; i < 2; ++i) { const int row = 8 * wave + 4 * i + fq; gb[i] = b_blk ? Bt + (size_t)(fr >> 3) * 16384 + (size_t)(brow0 + row) * 64 + 8 * (fr & 7) : Bt + (size_t)row * ldb + 8 * fr; db[i] = (unsigned)(TG_B + row * 272 + 16 * fr); }
    const size_t astep = a_blk ? 32768 : 128, bstep = b_blk ? 32768 : 128;
    v4u buf[4][6];
#define TG_ISSUE(q, ch) do { const int c_ = (((ch) < nchunk ? (ch) : nchunk - 1) + koff) & (nchunk - 1); \
        _Pragma("unroll") for (int i = 0; i < 4; ++i) buf[q][i] = *(const GAS v4u*)(ga[i] + c_ * astep); _Pragma("unroll") for (int i = 0; i < 2; ++i) buf[q][4 + i] = *(const GAS v4u*)(gb[i] + c_ * bstep); } while (0)
#define TG_WRITE(q, b) do { _Pragma("unroll") for (int i = 0; i < 4; ++i) *(LAS v4u*)(lds + (b) * TG_BUF + da[i]) = buf[q][i]; _Pragma("unroll") for (int i = 0; i < 2; ++i) *(LAS v4u*)(lds + (b) * TG_BUF + db[i]) = buf[q][4 + i]; } while (0)
    f32x4 acc[4][4];
#pragma unroll
    for (int mi = 0; mi < 4; ++mi)
#pragma unroll
        for (int ni = 0; ni < 4; ++ni) acc[mi][ni] = (f32x4){0.f, 0.f, 0.f, 0.f};
#define TG_FENCE() asm volatile("" ::: "memory")
#define TG_SYNC() do { asm volatile("s_waitcnt lgkmcnt(0)" ::: "memory"); __builtin_amdgcn_s_barrier(); asm volatile("" ::: "memory"); } while (0)
    TG_ISSUE(0, 0); TG_FENCE(); TG_ISSUE(1, 1); TG_FENCE(); TG_ISSUE(2, 2); TG_FENCE(); TG_ISSUE(3, 3); TG_FENCE();
    TG_WRITE(0, 0); TG_FENCE(); TG_ISSUE(0, 4); TG_FENCE(); TG_SYNC();
    for (int t = 0; t < nchunk; t += 4) {
#pragma unroll
        for (int q = 0; q < 4; ++q) {
            TG_WRITE((q + 1) & 3, (q + 1) & 1);
            TG_FENCE(); TG_ISSUE((q + 1) & 3, t + q + 5); TG_FENCE();
            const LAS unsigned char* sb = lds + (q & 1) * TG_BUF;
            bf16x8 af[4], bfr[4];
#pragma unroll
            for (int mi = 0; mi < 4; ++mi) af[mi] = *(const LAS bf16x8*)(sb + TG_A + (64 * wm + 16 * mi + fr) * 272 + 16 * fq + 64 * ks);
#pragma unroll
            for (int ni = 0; ni < 4; ++ni) bfr[ni] = *(const LAS bf16x8*)(sb + TG_B + (16 * ni + fr) * 272 + 16 * fq + 64 * ks);
#pragma unroll
            for (int mi = 0; mi < 4; ++mi)
#pragma unroll
                for (int ni = 0; ni < 4; ++ni) acc[mi][ni] = MFMA16(af[mi], bfr[ni], acc[mi][ni]);
            TG_SYNC();
        }
    }
#undef TG_ISSUE
#undef TG_FENCE
#undef TG_WRITE
#undef TG_SYNC
    asm volatile("s_waitcnt vmcnt(0) lgkmcnt(0)" ::: "memory"); __builtin_amdgcn_s_barrier(); asm volatile("" ::: "memory");
    LAS float* R = (LAS float*)lds;
#pragma unroll
    for (int mi = 0; mi < 4; ++mi)
#pragma unroll
        for (int ni = 0; ni < 4; ++ni)
#pragma unroll
            for (int r = 0; r < 4; ++r) R[ks * 8704 + (64 * wm + 16 * mi + 4 * fq + r) * 68 + 16 * ni + fr] = acc[mi][ni][r];
    __syncthreads();
    { const int row = tid >> 2, col0 = (tid & 3) * 16; f32x4 v[4];
#pragma unroll
      for (int k = 0; k < 4; ++k) { const LAS float* rp = R + row * 68 + col0 + 4 * k; v[k] = (*(const LAS f32x4*)(rp) + *(const LAS f32x4*)(rp + 8704)) + (*(const LAS f32x4*)(rp + 2 * 8704) + *(const LAS f32x4*)(rp + 3 * 8704)); }
      epi(row, col0, v); }
    __syncthreads();
}
constexpr int N_PHASES = 19;
__global__ void __launch_bounds__(NTHR, 2) fwd(Args a) {
    extern __shared__ __attribute__((aligned(16))) unsigned char lds_raw[];
    LAS unsigned char* lds = (LAS unsigned char*)lds_raw;
    const int tid0 = threadIdx.x;
    const int G = gridDim.x, c = blockIdx.x, NGW = G * NWAVES;
#define FRESH() int tid = tid0; asm volatile("" : "+v"(tid)); const int lane = tid & 63, wave = __builtin_amdgcn_readfirstlane(tid >> 6), gw = c * NWAVES + wave; (void)lane; (void)gw
    const int lo = a.ph_lo, hi = a.ph_hi;
    for (int u = tid0; u < (LDS_BYTES - LDSCTL_OFF) / 4; u += NTHR) ((LAS unsigned*)(lds + LDSCTL_OFF))[u] = 0u;
    __syncthreads();
    const bool use_bar = (hi - lo) > 1;
    XcdBarrier bar; bar.bar = (unsigned*)(a.ws + WS_CTL) + CW_BAR; bar.x = 0; bar.st = nullptr;
    if (use_bar) bar = xcd_barrier_post((unsigned*)(a.ws + WS_CTL) + CW_BAR, (volatile LAS unsigned*)(lds + MISC_OFF) + 8);
#define IN(k) (lo <= (k) && (k) < hi)
#define SEAM(k) do { if (IN(k) && IN((k) + 1)) xcd_barrier(bar); } while (0)
    float* X = a.out;
    float* RSA = (float*)(a.ws + WS_RSA); float* RSB = (float*)(a.ws + WS_RSB);
    bf16* XN = (bf16*)(a.ws + WS_XN); bf16* PROJ = (bf16*)(a.ws + WS_PROJ); bf16* MIX = (bf16*)(a.ws + WS_MIX); bf16* HID = (bf16*)(a.ws + WS_HID);
    bf16* WIN = (bf16*)(a.ws + WS_WIN); bf16* WOUT = (bf16*)(a.ws + WS_WOUT); bf16* WUP = (bf16*)(a.ws + WS_WUP); bf16* WDN = (bf16*)(a.ws + WS_WDN);
    { constexpr int l = 0; constexpr int ph = 9 * l;
        if (IN(ph + 0)) { FRESH(); p0_weights(a, l, lds, gw, NGW, wave, lane);
            norm_phase(a.in[0], a.in[1], X, l == 0, a.in[6] + (size_t)l * D, XN, gw, NGW, lane); }
        SEAM(ph + 0);
        if (IN(ph + 1)) { FRESH(); pg8::Gemm g{XN, WIN, MPAD, NINP, D, 0, 1}; pg8::StaticOrder S; S.init(MPAD, NINP, G, c); pg8::EpiBf16<0> E{PROJ, NINP, 0, 0};
            pg8::gemm_phase<pg8::EpiBf16<0>, pg8::StaticOrder, true, true>(lds, g, S, E, tid);
            if (c >= 113) { LAS float* scr = (LAS float*)(lds + wave * 16384);
                convert_range(a, l, CV_SPLIT + (c - 113) * NWAVES + wave, CV_ITEMS, (G - 113) * NWAVES, scr, lane); } }
        SEAM(ph + 1);
        if (IN(ph + 2)) {
            { v2u xraw[19]; unsigned sraw = 0u; DInv inv; delta_inv_load(a, l, c & 15, tid0, inv); delta_issue(a, c, tid0, xraw, sraw);
              for (int u = c; u < NUNIT; u += G) delta_prepass_unit(a, l, u, u + G < NUNIT ? u + G : u, lds, tid0, xraw, sraw, inv); }
            { v2u xraw[7]; LInv inv; lru_inv_load(a, l, (G - 1 - c) & 15, tid0, inv); lru_issue(a, G - 1 - c, tid0, xraw);
              for (int u = (G - 1 - c); u < NUNIT; u += G) lru_prepass_unit(a, l, u, u + G < NUNIT ? u + G : u, lds, tid0, xraw, inv); }
        }
        SEAM(ph + 2);
        if (IN(ph + 3)) { FRESH(); seq_phase(a, l, c, lds, wave, lane); }
        SEAM(ph + 3);
        if (IN(ph + 4)) { { PostRaw raw; f32x4 wnd[4]; for (int q = 0; q < 4; ++q) wnd[q] = *(const GAS f32x4*)(a.in[11] + (size_t)l * 128 + 16 * (tid0 & 7) + 4 * q);
            delta_post_issue(a, c, tid0, raw); for (int u = c; u < NUNIT; u += G) delta_post_unit(a, l, u, u + G < NUNIT ? u + G : u, lds, tid0, raw, wnd); } FRESH(); post_phase(a, l, gw, NGW, lane); }
        SEAM(ph + 4);
        if (IN(ph + 5)) { FRESH(); pg8::Gemm g{MIX, WOUT, MP, D, D, 0, 1}; pg8::StaticOrder S; S.init(MP, D, G, c); pg8::EpiResid<true> E{l == 0 ? a.in[0] : X, X, D, XN, nullptr, 0.f, 0.f};
            pg8::gemm_phase<pg8::EpiResid<true>, pg8::StaticOrder, true, true>(lds, g, S, E, tid);
            if (l == 0 && c >= 64) { LAS float* scr = (LAS float*)(lds + wave * 16384);
                convert_range(a, 1, (c - 64) * NWAVES + wave, I_IN + I_G, 192 * NWAVES, scr, lane); }
            if (c < 64) { const int j = c;
                thin_gemm_unit(MIX + (size_t)MP * D, D, 0, 0, WOUT + (size_t)(j >> 2) * (D / 64) * 16384, 0, 1, (j & 3) * 64, D, lds, tid0, [&](int row, int col0, const f32x4 (&v)[4]) {
                    GAS f32x4* d = (GAS f32x4*)(X + (size_t)(MP + row) * D + 64 * j + col0); const GAS f32x4* bs = l == 0 ? (const GAS f32x4*)(a.in[1] + (size_t)row * D + 64 * j + col0) : (const GAS f32x4*)d;
                    f32x4 x[4];
                    for (int q = 0; q < 4; ++q) { x[q] = bs[q] + v[q]; d[q] = x[q]; }
                    v4u o0, o1; o0.x = pk2(x[0].x, x[0].y); o0.y = pk2(x[0].z, x[0].w); o0.z = pk2(x[1].x, x[1].y); o0.w = pk2(x[1].z, x[1].w); o1.x = pk2(x[2].x, x[2].y); o1.y = pk2(x[2].z, x[2].w); o1.z = pk2(x[3].x, x[3].y); o1.w = pk2(x[3].z, x[3].w);
                    GAS v4u* xb = (GAS v4u*)(XN + (size_t)(MP + row) * D + 64 * j + col0); xb[0] = o0; xb[1] = o1; }); } }
        SEAM(ph + 5);
        if (IN(ph + 7)) { FRESH(); rowss_phase(XN, RSB, 0, MR, gw, NGW, lane);
            pg8::Gemm g{XN, WUP, MP, DFF, D, 0, 1}; pg8::StaticOrder S; S.init(MP, DFF, G, c); pg8::EpiBf16<1> E{HID, DFF, DFF / 64, 1};
            pg8::gemm_phase<pg8::EpiBf16<1>, pg8::StaticOrder, true, true>(lds, g, S, E, tid);
            for (int j = c; j < DFF / 64; j += G)
                thin_gemm_unit(XN + (size_t)MP * D, D, 0, 0, WUP + (size_t)(j >> 2) * (D / 64) * 16384, 0, 1, (j & 3) * 64, D, lds, tid0, [&](int row, int col0, const f32x4 (&v)[4]) {
                    float r[16];
                    for (int q = 0; q < 4; ++q) for (int e = 0; e < 4; ++e) { const float t = fmaxf(v[q][e], 0.f); r[4 * q + e] = t * t; }
                    v4u o0, o1; o0.x = pk2(r[0], r[1]); o0.y = pk2(r[2], r[3]); o0.z = pk2(r[4], r[5]); o0.w = pk2(r[6], r[7]); o1.x = pk2(r[8], r[9]); o1.y = pk2(r[10], r[11]); o1.z = pk2(r[12], r[13]); o1.w = pk2(r[14], r[15]);
                    GAS v4u* d = (GAS v4u*)(HID + ((size_t)(MP / 256) * (DFF / 64) + j) * 16384 + (size_t)row * 64 + col0); d[0] = o0; d[1] = o1; }); }
        SEAM(ph + 7);
        if (IN(ph + 8)) { FRESH(); pg8::Gemm g{HID, WDN, MP, D, DFF, 1, 1};     pg8::DownOrder S; S.init(c);
            { pg8::EpiResid<false> E{X, X, D, nullptr, RSB, 1.f / D, EPS}; pg8::gemm_phase<pg8::EpiResid<false>, pg8::DownOrder, true, true>(lds, g, S, E, tid); }
            for (int uu = c; uu < 256; uu += G) { const int j = uu >> 2, ks = uu & 3;
                thin_gemm_unit(HID + ((size_t)(MP / 256) * (DFF / 64) + ks * 64) * 16384, 0, 1, 0, WDN + ((size_t)(j >> 2) * (DFF / 64) + ks * 64) * 16384, 0, 1, (j & 3) * 64, 4096, lds, tid0, [&](int row, int col0, const f32x4 (&v)[4]) {
                    float* d = X + (size_t)(MP + row) * D + 64 * j + col0; const float sc = __builtin_amdgcn_rcpf(*(const GAS float*)(RSB + MP + row) * (1.f / D) + EPS);
                    for (int q = 0; q < 4; ++q) for (int e = 0; e < 4; ++e) (void)__hip_atomic_fetch_add(d + 4 * q + e, v[q][e] * sc, __ATOMIC_RELAXED, __HIP_MEMORY_SCOPE_AGENT); }); } }
        SEAM(ph + 8);
    }
    { constexpr int l = 1; constexpr int ph = 9 * l;
        if (IN(ph + 0)) { FRESH(); p0_weights(a, l, lds, gw, NGW, wave, lane);
            norm_phase(a.in[0], a.in[1], X, l == 0, a.in[6] + (size_t)l * D, XN, gw, NGW, lane); }
        SEAM(ph + 0);
        if (IN(ph + 1)) { FRESH(); pg8::Gemm g{XN, WIN, MPAD, NINP, D, 0, 1}; pg8::StaticOrder S; S.init(MPAD, NINP, G, c); pg8::EpiBf16<0> E{PROJ, NINP, 0, 0};
            pg8::gemm_phase<pg8::EpiBf16<0>, pg8::StaticOrder, true, true>(lds, g, S, E, tid);
            if (c >= 113) { LAS float* scr = (LAS float*)(lds + wave * 16384);
                convert_range(a, l, CV_SPLIT + (c - 113) * NWAVES + wave, CV_ITEMS, (G - 113) * NWAVES, scr, lane); } }
        SEAM(ph + 1);
        if (IN(ph + 2)) {
            { v2u xraw[19]; unsigned sraw = 0u; DInv inv; delta_inv_load(a, l, c & 15, tid0, inv); delta_issue(a, c, tid0, xraw, sraw);
              for (int u = c; u < NUNIT; u += G) delta_prepass_unit(a, l, u, u + G < NUNIT ? u + G : u, lds, tid0, xraw, sraw, inv); }
            { v2u xraw[7]; LInv inv; lru_inv_load(a, l, (G - 1 - c) & 15, tid0, inv); lru_issue(a, G - 1 - c, tid0, xraw);
              for (int u = (G - 1 - c); u < NUNIT; u += G) lru_prepass_unit(a, l, u, u + G < NUNIT ? u + G : u, lds, tid0, xraw, inv); }
        }
        SEAM(ph + 2);
        if (IN(ph + 3)) { FRESH(); seq_phase(a, l, c, lds, wave, lane); }
        SEAM(ph + 3);
        if (IN(ph + 4)) { { PostRaw raw; f32x4 wnd[4]; for (int q = 0; q < 4; ++q) wnd[q] = *(const GAS f32x4*)(a.in[11] + (size_t)l * 128 + 16 * (tid0 & 7) + 4 * q);
            delta_post_issue(a, c, tid0, raw); for (int u = c; u < NUNIT; u += G) delta_post_unit(a, l, u, u + G < NUNIT ? u + G : u, lds, tid0, raw, wnd); } FRESH(); post_phase(a, l, gw, NGW, lane); }
        SEAM(ph + 4);
        if (IN(ph + 5)) { FRESH(); pg8::Gemm g{MIX, WOUT, MP, D, D, 0, 1}; pg8::StaticOrder S; S.init(MP, D, G, c); pg8::EpiResid<true> E{l == 0 ? a.in[0] : X, X, D, XN, nullptr, 0.f, 0.f};
            pg8::gemm_phase<pg8::EpiResid<true>, pg8::StaticOrder, true, true>(lds, g, S, E, tid);
            if (c < 64) { const int j = c;
                thin_gemm_unit(MIX + (size_t)MP * D, D, 0, 0, WOUT + (size_t)(j >> 2) * (D / 64) * 16384, 0, 1, (j & 3) * 64, D, lds, tid0, [&](int row, int col0, const f32x4 (&v)[4]) {
                    GAS f32x4* d = (GAS f32x4*)(X + (size_t)(MP + row) * D + 64 * j + col0); const GAS f32x4* bs = l == 0 ? (const GAS f32x4*)(a.in[1] + (size_t)row * D + 64 * j + col0) : (const GAS f32x4*)d;
                    f32x4 x[4];
                    for (int q = 0; q < 4; ++q) { x[q] = bs[q] + v[q]; d[q] = x[q]; }
                    v4u o0, o1; o0.x = pk2(x[0].x, x[0].y); o0.y = pk2(x[0].z, x[0].w); o0.z = pk2(x[1].x, x[1].y); o0.w = pk2(x[1].z, x[1].w); o1.x = pk2(x[2].x, x[2].y); o1.y = pk2(x[2].z, x[2].w); o1.z = pk2(x[3].x, x[3].y); o1.w = pk2(x[3].z, x[3].w);
                    GAS v4u* xb = (GAS v4u*)(XN + (size_t)(MP + row) * D + 64 * j + col0); xb[0] = o0; xb[1] = o1; }); } }
        SEAM(ph + 5);
        if (IN(ph + 7)) { FRESH(); rowss_phase(XN, RSB, 0, MR, gw, NGW, lane);
            pg8::Gemm g{XN, WUP, MP, DFF, D, 0, 1}; pg8::StaticOrder S; S.init(MP, DFF, G, c); pg8::EpiBf16<1> E{HID, DFF, DFF / 64, 1};
            pg8::gemm_phase<pg8::EpiBf16<1>, pg8::StaticOrder, true, true>(lds, g, S, E, tid);
            for (int j = c; j < DFF / 64; j += G)
                thin_gemm_unit(XN + (size_t)MP * D, D, 0, 0, WUP + (size_t)(j >> 2) * (D / 64) * 16384, 0, 1, (j & 3) * 64, D, lds, tid0, [&](int row, int col0, const f32x4 (&v)[4]) {
                    float r[16];
                    for (int q = 0; q < 4; ++q) for (int e = 0; e < 4; ++e) { const float t = fmaxf(v[q][e], 0.f); r[4 * q + e] = t * t; }
                    v4u o0, o1; o0.x = pk2(r[0], r[1]); o0.y = pk2(r[2], r[3]); o0.z = pk2(r[4], r[5]); o0.w = pk2(r[6], r[7]); o1.x = pk2(r[8], r[9]); o1.y = pk2(r[10], r[11]); o1.z = pk2(r[12], r[13]); o1.w = pk2(r[14], r[15]);
                    GAS v4u* d = (GAS v4u*)(HID + ((size_t)(MP / 256) * (DFF / 64) + j) * 16384 + (size_t)row * 64 + col0); d[0] = o0; d[1] = o1; }); }
        SEAM(ph + 7);
        if (IN(ph + 8)) { FRESH(); pg8::Gemm g{HID, WDN, MP, D, DFF, 1, 1};     pg8::DownOrder S; S.init(c);
            { pg8::EpiResid<false> E{X, X, D, nullptr, RSB, 1.f / D, EPS}; pg8::gemm_phase<pg8::EpiResid<false>, pg8::DownOrder, true, true>(lds, g, S, E, tid); }
            for (int uu = c; uu < 256; uu += G) { const int j = uu >> 2, ks = uu & 3;
                thin_gemm_unit(HID + ((size_t)(MP / 256) * (DFF / 64) + ks * 64) * 16384, 0, 1, 0, WDN + ((size_t)(j >> 2) * (DFF / 64) + ks * 64) * 16384, 0, 1, (j & 3) * 64, 4096, lds, tid0, [&](int row, int col0, const f32x4 (&v)[4]) {
                    float* d = X + (size_t)(MP + row) * D + 64 * j + col0; const float sc = __builtin_amdgcn_rcpf(*(const GAS float*)(RSB + MP + row) * (1.f / D) + EPS);
                    for (int q = 0; q < 4; ++q) for (int e = 0; e < 4; ++e) (void)__hip_atomic_fetch_add(d + 4 * q + e, v[q][e] * sc, __ATOMIC_RELAXED, __HIP_MEMORY_SCOPE_AGENT); }); } }
        SEAM(ph + 8);
    }
    if (IN(18)) { FRESH(); final_norm_phase(a, gw, NGW, lane); }
#undef IN
#undef SEAM
}

#ifndef PROBE_PH
#define PROBE_PH -1
#endif
#ifndef MK_SPLIT
#define MK_SPLIT 0
#endif
extern "C" void kernel_launch(void* const* d_in, const int* in_sizes, int n_in, void* d_out, int out_size, void* d_ws, size_t ws_size, hipStream_t stream) {
    static int grid = 0;
    if (grid == 0) {
        if (n_in != 25 || (size_t)out_size != O_END || ws_size < WS_END) { fprintf(stderr, "kernel_launch: unexpected sizes n_in %d out %d ws %zu (need %zu)\n", n_in, out_size, ws_size, (size_t)WS_END); grid = -1; return; }
        int dev = 0, cus = 0, per_cu = 0;
        if (hipGetDevice(&dev) != hipSuccess || hipDeviceGetAttribute(&cus, hipDeviceAttributeMultiprocessorCount, dev) != hipSuccess) { grid = -1; return; }
        if (hipFuncSetAttribute((const void*)fwd, hipFuncAttributeMaxDynamicSharedMemorySize, LDS_BYTES) != hipSuccess) { fprintf(stderr, "kernel_launch: hipFuncSetAttribute failed\n"); grid = -1; return; }
        if (hipOccupancyMaxActiveBlocksPerMultiprocessor(&per_cu, (const void*)fwd, NTHR, LDS_BYTES) != hipSuccess || per_cu < 1) fprintf(stderr, "kernel_launch: occupancy query reports %d\n", per_cu);
        (void)hipGetLastError();
        if (cus != 256) { fprintf(stderr, "kernel_launch: built for a 256-CU device (one workgroup per CU), found %d\n", cus); grid = -1; return; }
        grid = cus;
    }
    if (grid < 0) return;
    if (hipMemsetAsync((char*)d_ws + WS_CTL, 0, CTL_ZERO_BYTES, stream) != hipSuccess) return;
    Args a{};
    for (int i = 0; i < 25; ++i) a.in[i] = (const float*)d_in[i];
    a.out = (float*)d_out; a.ws = (unsigned char*)d_ws;
#if MK_SPLIT
    for (int k = 0; k < N_PHASES; ++k) { a.ph_lo = k; a.ph_hi = k + 1; hipLaunchKernelGGL(fwd, dim3(grid), dim3(NTHR), LDS_BYTES, stream, a);
        if (k < 18 && (k % 9) == PROBE_PH) hipLaunchKernelGGL(fwd, dim3(grid), dim3(NTHR), LDS_BYTES, stream, a); }
#else
    a.ph_lo = 0; a.ph_hi = N_PHASES; hipLaunchKernelGGL(fwd, dim3(grid), dim3(NTHR), LDS_BYTES, stream, a);
#endif
}
```

```cpp
#include <hip/hip_runtime.h>
#include <cstdio>
#include <cstdint>
namespace pg8 {
#define PG8_LAS __attribute__((address_space(3)))
typedef unsigned short bf16_t;
typedef short bf16x8 __attribute__((ext_vector_type(8)));
typedef float f32x4 __attribute__((ext_vector_type(4)));
typedef unsigned u32x4 __attribute__((ext_vector_type(4)));
constexpr int BM = 256, BK = 64, HALF = 128, HTB = HALF * BK * 2  , STAGE_BYTES = 8 * HTB, NXCD = 8, WGM = 8;

__host__ __device__ __forceinline__ int lds_byte(int r, int c) { const int st = (r >> 4) * 2 + (c >> 5), rr = r & 15, cc = c & 31, ob = rr * 64 + cc * 2; return st * 1024 + (ob ^ (((ob >> 9) & 1) << 5)); }
__host__ __device__ __forceinline__ void stage_rc(int b, int& R, int& C) { const int st = b / 1024, sb = b % 1024, swz = sb ^ (((sb >> 9) & 1) << 5); R = (st >> 1) * 16 + swz / 64; C = (st & 1) * 32 + (swz % 64) / 2; }
__host__ __device__ __forceinline__ int perm32(int rho) { const int n = rho >> 4, i = rho & 15; return 8 * (i >> 2) + 4 * n + (i & 3); }

struct Unit { int pm, pn; };
struct Gemm { const bf16_t* A; const bf16_t* Bt; int M, N, K; int a_blk, b_blk; };
struct StaticOrder {
    int nM, nN, nwg, G, c;
    __host__ __device__ void init(int M, int N, int G_, int c_) { nM = M / BM; nN = N / BM; nwg = nM * nN; G = G_; c = c_; }
    __host__ __device__ bool next(int i, Unit& u) const {
        const long L = (long)i * G + c; if (L >= nwg) return false;
        int wgid = (int)L; { const int q = nwg / NXCD, r = nwg % NXCD, xcd = wgid % NXCD, off = wgid / NXCD; wgid = (xcd < r ? xcd * (q + 1) : r * (q + 1) + (xcd - r) * q) + off; }
        const int nig = WGM * nN, gid = wgid / nig, fm = gid * WGM, gsz = (nM - fm) < WGM ? (nM - fm) : WGM;
        u.pm = fm + ((wgid % nig) % gsz); u.pn = (wgid % nig) / gsz; return true;
    }
    __device__ __forceinline__ void a_ready(const Unit&) const {}
    __device__ __forceinline__ void done(const Unit&) const {}
};
struct DownOrder {
    int c;
    __host__ __device__ void init(int c_) { c = c_; }
    __host__ __device__ bool next(int i, Unit& u) const { if (i >= 4) return false; const int xcd = c & 7, slot = c >> 3; u.pm = (xcd >> 2) * 32 + 8 * i + (slot & 7); u.pn = 4 * (xcd & 3) + (slot >> 3); return true; }
    __device__ __forceinline__ void a_ready(const Unit&) const {}
    __device__ __forceinline__ void done(const Unit&) const {}
};
typedef float f32x2v_ __attribute__((ext_vector_type(2))); typedef __bf16 bf16x2v_ __attribute__((ext_vector_type(2)));
__device__ __forceinline__ unsigned cvt_pk_bf16(float lo, float hi) { f32x2v_ v = {lo, hi}; bf16x2v_ b = __builtin_convertvector(v, bf16x2v_); return __builtin_bit_cast(unsigned, b); }
template <int ACT  > struct EpiBf16 {
    static constexpr bool PERM = true, AFTER_DRAIN = false;
    bf16_t* O; int ldc; int nkt; int nt;
    __device__ __forceinline__ void operator()(const f32x4 (&acc)[2][2][4][2], const Unit& u, int wr, int wc, int fr, int fq) const {
        const int row0 = u.pm * BM + wr * 64 + fr; const int col0 = u.pn * BM + wc * 32 + 8 * fq;
#pragma unroll
        for (int ai = 0; ai < 2; ++ai)
#pragma unroll
            for (int m = 0; m < 4; ++m) { const int rloc = wr * 64 + fr + ai * HALF + m * 16;
                bf16_t* rowp = nkt ? O + ((size_t)u.pm * nkt + 4 * u.pn + (wc >> 1)) * (BM * BK) + rloc * BK + (wc & 1) * 32 + 8 * fq - (size_t)0 : O + (size_t)(row0 + ai * HALF + m * 16) * ldc + col0;
                const size_t bjstep = nkt ? (size_t)2 * BM * BK : (size_t)HALF;
#pragma unroll
                for (int bj = 0; bj < 2; ++bj) { f32x4 v0 = acc[ai][bj][m][0], v1 = acc[ai][bj][m][1];
                    if (ACT == 1) {
#pragma unroll
                        for (int j = 0; j < 4; ++j) { const float a = fmaxf(v0[j], 0.f), b = fmaxf(v1[j], 0.f); v0[j] = a * a; v1[j] = b * b; } }
                    u32x4 w; w.x = cvt_pk_bf16(v0[0], v0[1]); w.y = cvt_pk_bf16(v0[2], v0[3]); w.z = cvt_pk_bf16(v1[0], v1[1]); w.w = cvt_pk_bf16(v1[2], v1[3]);
                    if (nt) __builtin_nontemporal_store(w, (u32x4*)(rowp + bj * bjstep)); else *(u32x4*)(rowp + bj * bjstep) = w; } }
    }
};
template <bool FUSE> struct EpiResid {
    static constexpr bool PERM = true, AFTER_DRAIN = false;
    const float* B; float* X; int ldc; bf16_t* XB; const float* rss; float inv_n, eps;
    __device__ __forceinline__ void operator()(const f32x4 (&acc)[2][2][4][2], const Unit& u, int wr, int wc, int fr, int fq) const {
        const int row0 = u.pm * BM + wr * 64 + fr, col0 = u.pn * BM + wc * 32 + 8 * fq;
#pragma unroll
        for (int ai = 0; ai < 2; ++ai)
#pragma unroll
            for (int m = 0; m < 4; ++m) { const int row = row0 + ai * HALF + m * 16;
                const float* bp = B + (size_t)row * ldc + col0; float* rowp = X + (size_t)row * ldc + col0;
                const float sc = rss ? __builtin_amdgcn_rcpf(rss[row] * inv_n + eps) : 1.f;
                f32x4 v[2][2];
#pragma unroll
                for (int bj = 0; bj < 2; ++bj)
#pragma unroll
                    for (int n = 0; n < 2; ++n) v[bj][n] = *(const f32x4*)(bp + bj * HALF + n * 4);
#pragma unroll
                for (int bj = 0; bj < 2; ++bj) { const f32x4 x0 = v[bj][0] + acc[ai][bj][m][0] * sc, x1 = v[bj][1] + acc[ai][bj][m][1] * sc;
                    *(f32x4*)(rowp + bj * HALF) = x0; *(f32x4*)(rowp + bj * HALF + 4) = x1;
                    if (FUSE) { u32x4 w; w.x = cvt_pk_bf16(x0[0], x0[1]); w.y = cvt_pk_bf16(x0[2], x0[3]); w.z = cvt_pk_bf16(x1[0], x1[1]); w.w = cvt_pk_bf16(x1[2], x1[3]);
                        *(u32x4*)(XB + (size_t)row * ldc + col0 + bj * HALF) = w; } }
                asm volatile("" ::: "memory"); }
    }
};
template <class Epi, class Sched, bool ALIGN_EPI = false, bool SP2 = false>
__device__ __forceinline__ void gemm_phase(PG8_LAS unsigned char* lds, const Gemm g, const Sched& S, const Epi& E, const int tid) {
    const int wid = __builtin_amdgcn_readfirstlane(tid >> 6), lane = tid & 63, wr = wid >> 2, wc = wid & 3, fr = lane & 15, fq = lane >> 4;
    const int K = g.K, nt = K / BK;
    unsigned voffA[2], voffB[2];
#pragma unroll
    for (int i = 0; i < 2; ++i) { int R, C; stage_rc(tid * 16 + i * 8192, R, C); const int Rb = Epi::PERM ? ((R & ~31) + perm32(R & 31)) : R;
        voffA[i] = (unsigned)(R * (g.a_blk ? BK : K) + C) * 2u; voffB[i] = (unsigned)(Rb * (g.b_blk ? BK : K) + C) * 2u; }
    const size_t kstepA = g.a_blk ? (size_t)BM * BK * 2 : (size_t)(BK * 2), kstepB = g.b_blk ? (size_t)BM * BK * 2 : (size_t)(BK * 2);
    const size_t hstepA = g.a_blk ? (size_t)HALF * BK * 2 : (size_t)HALF * K * 2, hstepB = g.b_blk ? (size_t)HALF * BK * 2 : (size_t)HALF * K * 2;
    const size_t tstep = (size_t)BM * K * 2;
    const unsigned ldsw = (unsigned)wid * 1024u;
    const int aoff = lds_byte(wr * 64 + fr, fq * 8), boff = lds_byte(wc * 32 + fr, fq * 8);
#define PG8_SA(b, h) (((b) * 2 + (h)) * HTB)
#define PG8_SB(b, h) ((4 + (b) * 2 + (h)) * HTB)
#define PG8_STAGE(bufoff, gbase, voff) do { _Pragma("unroll") for (int _i = 0; _i < 2; ++_i) \
        __builtin_amdgcn_global_load_lds((const unsigned*)((const char*)(gbase) + (voff)[_i]), (PG8_LAS unsigned*)(lds + (bufoff) + ldsw + _i * 8192), 16, 0, 0); } while (0)
#define PG8_LDA(dst, b, h) do { _Pragma("unroll") for (int m = 0; m < 4; ++m) _Pragma("unroll") for (int k = 0; k < 2; ++k) dst[m][k] = *(const PG8_LAS bf16x8*)(lds + PG8_SA(b, h) + aoff + m * 2048 + k * 1024); } while (0)
#define PG8_LDB(dst, b, h) do { _Pragma("unroll") for (int n = 0; n < 2; ++n) _Pragma("unroll") for (int k = 0; k < 2; ++k) dst[n][k] = *(const PG8_LAS bf16x8*)(lds + PG8_SB(b, h) + boff + n * 2048 + k * 1024); } while (0)
#define PG8_MMA(ai, bj, At, Bt) do { __builtin_amdgcn_s_setprio(1); _Pragma("unroll") for (int m = 0; m < 4; ++m) _Pragma("unroll") for (int n = 0; n < 2; ++n) _Pragma("unroll") for (int k = 0; k < 2; ++k) \
        acc[ai][bj][m][n] = __builtin_amdgcn_mfma_f32_16x16x32_bf16(Bt[n][k], At[m][k], acc[ai][bj][m][n], 0, 0, 0); __builtin_amdgcn_s_setprio(0); } while (0)
#define PG8_WAIT_V(n) asm volatile("s_waitcnt vmcnt(" #n ")" ::: "memory")
#define PG8_WAIT_L(n) asm volatile("s_waitcnt lgkmcnt(" #n ")" ::: "memory")
#define PG8_BAR __builtin_amdgcn_s_barrier()
#define PG8_SCHED __builtin_amdgcn_sched_barrier(0)
    Unit cur, nxt; int ui = 0;
    if (!S.next(0, cur)) return;
    f32x4 acc[2][2][4][2];
#pragma unroll
    for (int a = 0; a < 2; ++a)
#pragma unroll
        for (int b = 0; b < 2; ++b)
#pragma unroll
            for (int m = 0; m < 4; ++m)
#pragma unroll
                for (int n = 0; n < 2; ++n) acc[a][b][m][n] = (f32x4){0.f, 0.f, 0.f, 0.f};
    bf16x8 At[4][2], B0[2][2], B1[2][2];
    const char* cA = (const char*)g.A + (size_t)cur.pm * tstep; const char* cB = (const char*)g.Bt + (size_t)cur.pn * tstep;
    S.a_ready(cur);
    if constexpr (SP2) {
        PG8_STAGE(PG8_SB(0, 0), cB, voffB); PG8_STAGE(PG8_SB(0, 1), cB + hstepB, voffB); PG8_STAGE(PG8_SA(0, 0), cA, voffA); PG8_STAGE(PG8_SA(0, 1), cA + hstepA, voffA);
        if (wr == 1) PG8_BAR;
        PG8_WAIT_V(2); PG8_BAR;
        PG8_STAGE(PG8_SB(1, 0), cB + kstepB, voffB); PG8_STAGE(PG8_SA(1, 0), cA + kstepA, voffA); PG8_STAGE(PG8_SB(1, 1), cB + hstepB + kstepB, voffB);
        PG8_WAIT_V(6); PG8_BAR;
    } else {
        PG8_STAGE(PG8_SB(0, 0), cB, voffB); PG8_STAGE(PG8_SA(0, 0), cA, voffA); PG8_STAGE(PG8_SB(0, 1), cB + hstepB, voffB); PG8_STAGE(PG8_SA(0, 1), cA + hstepA, voffA);
        if (wr == 1) PG8_BAR;
        PG8_WAIT_V(4); PG8_BAR;
        PG8_STAGE(PG8_SB(1, 0), cB + kstepB, voffB); PG8_STAGE(PG8_SA(1, 0), cA + kstepA, voffA); PG8_STAGE(PG8_SB(1, 1), cB + hstepB + kstepB, voffB);
        PG8_WAIT_V(6); PG8_BAR;
    }
    for (;;) {
        const bool has_next = S.next(ui + 1, nxt);
        const char* nA = has_next ? (const char*)g.A + (size_t)nxt.pm * tstep : cA; const char* nB = has_next ? (const char*)g.Bt + (size_t)nxt.pn * tstep : cB;
        for (int t = 0; t < nt; t += 2) {
            const bool last = (t == nt - 2);
            const char* a1 = cA + (size_t)(t + 1) * kstepA;
            const char* a2 = last ? nA : cA + (size_t)(t + 2) * kstepA; const char* b2 = last ? nB : cB + (size_t)(t + 2) * kstepB;
            const char* a3 = a2 + kstepA; const char* b3 = b2 + kstepB;
            if (last && has_next) S.a_ready(nxt);
            if constexpr (SP2) {
            PG8_LDB(B0, 0, 0); PG8_LDB(B1, 0, 1); PG8_SCHED; PG8_LDA(At, 0, 0); PG8_STAGE(PG8_SA(1, 1), a1 + hstepA, voffA);
            PG8_WAIT_V(8); PG8_WAIT_L(0); PG8_BAR; PG8_MMA(0, 0, At, B0); PG8_MMA(0, 1, At, B1); PG8_BAR; PG8_SCHED;
            PG8_LDA(At, 0, 1); PG8_STAGE(PG8_SB(0, 0), b2, voffB); PG8_STAGE(PG8_SB(0, 1), b2 + hstepB, voffB); PG8_STAGE(PG8_SA(0, 0), a2, voffA);
            PG8_WAIT_V(8); PG8_WAIT_L(0); PG8_BAR; PG8_MMA(1, 0, At, B0); PG8_MMA(1, 1, At, B1); PG8_BAR; PG8_SCHED;
            PG8_LDB(B0, 1, 0); PG8_LDB(B1, 1, 1); PG8_SCHED; PG8_LDA(At, 1, 0); PG8_STAGE(PG8_SA(0, 1), a2 + hstepA, voffA);
            PG8_WAIT_V(8); PG8_WAIT_L(0); PG8_BAR; PG8_MMA(0, 0, At, B0); PG8_MMA(0, 1, At, B1); PG8_BAR; PG8_SCHED;
            PG8_LDA(At, 1, 1); PG8_STAGE(PG8_SB(1, 0), b3, voffB); PG8_STAGE(PG8_SB(1, 1), b3 + hstepB, voffB); PG8_STAGE(PG8_SA(1, 0), a3, voffA);
            PG8_WAIT_V(8); PG8_WAIT_L(0); PG8_BAR; PG8_MMA(1, 0, At, B0); PG8_MMA(1, 1, At, B1); PG8_BAR; PG8_SCHED;
            } else {
            PG8_LDB(B0, 0, 0); PG8_SCHED; PG8_LDA(At, 0, 0); PG8_STAGE(PG8_SA(1, 1), a1 + hstepA, voffA);
            PG8_WAIT_L(8); PG8_BAR; PG8_WAIT_L(0); PG8_MMA(0, 0, At, B0); PG8_BAR; PG8_SCHED;
            PG8_LDB(B1, 0, 1); PG8_STAGE(PG8_SB(0, 0), b2, voffB);
            PG8_BAR; PG8_WAIT_L(0); PG8_MMA(0, 1, At, B1); PG8_BAR;
            PG8_LDA(At, 0, 1); PG8_STAGE(PG8_SA(0, 0), a2, voffA);
            PG8_BAR; PG8_WAIT_L(0); PG8_MMA(1, 0, At, B0); PG8_BAR; PG8_SCHED;
            PG8_STAGE(PG8_SB(0, 1), b2 + hstepB, voffB);
            PG8_WAIT_V(6); PG8_BAR; PG8_MMA(1, 1, At, B1); PG8_BAR;
            PG8_LDB(B0, 1, 0); PG8_SCHED; PG8_LDA(At, 1, 0); PG8_STAGE(PG8_SA(0, 1), a2 + hstepA, voffA);
            PG8_WAIT_L(8); PG8_BAR; PG8_WAIT_L(0); PG8_MMA(0, 0, At, B0); PG8_BAR; PG8_SCHED;
            PG8_LDB(B1, 1, 1); PG8_STAGE(PG8_SB(1, 0), b3, voffB);
            PG8_BAR; PG8_WAIT_L(0); PG8_MMA(0, 1, At, B1); PG8_BAR;
            PG8_LDA(At, 1, 1); PG8_STAGE(PG8_SA(1, 0), a3, voffA);
            PG8_BAR; PG8_WAIT_L(0); PG8_MMA(1, 0, At, B0); PG8_BAR; PG8_SCHED;
            PG8_STAGE(PG8_SB(1, 1), b3 + hstepB, voffB);
            PG8_WAIT_V(6); PG8_BAR; PG8_MMA(1, 1, At, B1); PG8_BAR;
            }
        }
        if constexpr (ALIGN_EPI) { if (wr == 0) PG8_BAR; }
        if constexpr (!Epi::AFTER_DRAIN) { E(acc, cur, wr, wc, fr, fq); S.done(cur); }
        if (!has_next) break;
#pragma unroll
        for (int a = 0; a < 2; ++a)
#pragma unroll
            for (int b = 0; b < 2; ++b)
#pragma unroll
                for (int m = 0; m < 4; ++m)
#pragma unroll
                    for (int n = 0; n < 2; ++n) acc[a][b][m][n] = (f32x4){0.f, 0.f, 0.f, 0.f};
        cur = nxt; cA = nA; cB = nB; ++ui;
        if constexpr (ALIGN_EPI) { if (wr == 1) PG8_BAR; }
    }
    PG8_WAIT_V(0);
    if constexpr (!ALIGN_EPI) { if (wr == 0) PG8_BAR; }
    PG8_BAR;
    if constexpr (Epi::AFTER_DRAIN) { E.fused(acc, cur, wr, wc, fr, fq, lds, wid, lane); S.done(cur); }
#undef PG8_SA
#undef PG8_SB
#undef PG8_STAGE
#undef PG8_LDA
#undef PG8_LDB
#undef PG8_MMA
#undef PG8_WAIT_V
#undef PG8_WAIT_L
#undef PG8_BAR
#undef PG8_SCHED
}
}
constexpr int D = 4096, MP = 16384, MS = 128, MR = MP + MS, MPAD = 16640;
constexpr int SEQ = 8192, NBP = 2, NBS = 8, LS = 16, NCH = SEQ / 64;
constexpr int DA = 2048, DB = 2048, NH = 16, DFF = 16384, QKV = 6144;
constexpr int NIN = 12320, NINP = 12544;
constexpr int C_Q = 0, C_K = 2048, C_V = 4096, C_Z = 6144, C_XL = 8192, C_YL = 10240, C_BL = 12288, C_AL = 12304;
constexpr float EPS = 1e-6f;
constexpr int NWAVES = 8, NTHR = 512;
constexpr int NUNIT_P = 4096, NUNIT = 4224;
constexpr size_t O_YP = 0, O_YS = O_YP + (size_t)MP * D, O_PD = O_YS + (size_t)MS * D, O_PCD = O_PD + (size_t)2 * NBP * NH * 128 * 128, O_PL = O_PCD + (size_t)2 * NBP * 3 * QKV,
    O_PCL = O_PL + (size_t)2 * NBP * DB, O_SD = O_PCL + (size_t)2 * NBP * 3 * DB, O_SCD = O_SD + (size_t)2 * NBS * NH * 128 * 128, O_SL = O_SCD + (size_t)2 * NBS * 3 * QKV,
    O_SCL = O_SL + (size_t)2 * NBS * DB, O_END = O_SCL + (size_t)2 * NBS * 3 * DB;
static_assert(O_END == 73408512, "d_out map");
constexpr size_t AL(size_t x) { return (x + 4095) & ~(size_t)4095; }
constexpr size_t WS_CTL = 0, CTL_ZERO_BYTES = 1u << 20;
constexpr size_t WS_WIN = CTL_ZERO_BYTES, WS_WOUT = WS_WIN + AL((size_t)NINP * D * 2), WS_WUP = WS_WOUT + AL((size_t)D * D * 2), WS_WDN = WS_WUP + AL((size_t)DFF * D * 2),
    WS_WG = WS_WDN + AL((size_t)D * DFF * 2), WS_XN = WS_WG + AL((size_t)2 * NH * 128 * 128 * 2), WS_PROJ = WS_XN + AL((size_t)MPAD * D * 2), WS_MIX = WS_PROJ + AL((size_t)MPAD * NINP * 2),
    WS_HIN = WS_MIX + AL((size_t)MPAD * D * 2), WS_OV = WS_HIN + AL((size_t)2 * NBP * NCH * DB * 4);
constexpr size_t DF_MP = 0, DF_BN = 32768, DF_QE = 65536, DF_OU = 81920, DF_GL = 98304, DF_STRIDE = 98560;
constexpr size_t WS_DF = WS_OV, WS_SST = WS_DF + AL((size_t)NUNIT * DF_STRIDE), WS_HLOC = WS_SST + AL((size_t)NUNIT * 32768), WS_CUM = WS_HLOC + AL((size_t)MR * DB * 2), WS_CHK = WS_CUM + AL((size_t)MR * DB * 2), WS_END1 = WS_CHK + AL((size_t)NUNIT * 1024);
constexpr size_t WS_HID = WS_OV, WS_END2 = WS_HID + AL((size_t)MPAD * DFF * 2);
constexpr size_t WS_END = WS_END1 > WS_END2 ? WS_END1 : WS_END2;
static_assert(WS_END <= 2147483648ull, "d_ws map");
constexpr int CW_BAR = 4096;
constexpr size_t WS_RSA = WS_CTL + 65536, WS_RSB = WS_RSA + 131072;
static_assert(WS_RSB + 131072 <= CTL_ZERO_BYTES && (size_t)MPAD * 4 <= 131072, "row-sum arrays");
constexpr int RING_BYTES = 131072, LDSCTL_OFF = 139264, MISC_OFF = LDSCTL_OFF + 320, LDS_BYTES = 147456;
constexpr int L_QN = 0, L_KN = 17408, L_KT = 34816, L_VT = 53248, L_KK = 71680, L_QKT = 89088, L_TU = 105472, L_TW = 114688, L_SC = 123904, L_QKF = 124928;
constexpr int L_XCB = 0, L_XCF = 17408, L_AS = L_XCF + 33792, L_BS = L_AS + 33792, L_SEG = L_BS + 33792;
constexpr int L_OL = 0;
constexpr int SQ_SLOT = 40960 + 256, L_SQ = 0;
static_assert(L_SEG + 8192 <= LDSCTL_OFF && L_QKF + 8192 <= LDSCTL_OFF && 2 * SQ_SLOT <= LDSCTL_OFF, "LDS map");

#define GAS __attribute__((address_space(1)))
#define LAS __attribute__((address_space(3)))
#define DI __device__ __forceinline__
typedef unsigned short bf16;
typedef unsigned v4u __attribute__((ext_vector_type(4)));
typedef unsigned v2u __attribute__((ext_vector_type(2)));
typedef float f32x4 __attribute__((ext_vector_type(4)));
typedef short bf16x8 __attribute__((ext_vector_type(8)));
typedef GAS unsigned gu32;
#define RLX_AGENT __ATOMIC_RELAXED, __HIP_MEMORY_SCOPE_AGENT
#define LDS_WAIT() asm volatile("s_waitcnt lgkmcnt(0)" ::: "memory")
#define VM_WAIT() asm volatile("s_waitcnt vmcnt(0)" ::: "memory")
#define LDS_BARRIER() do { asm volatile("s_waitcnt lgkmcnt(0)" ::: "memory"); __builtin_amdgcn_s_barrier(); asm volatile("" ::: "memory"); } while (0)
#define MFMA16(a, b, c) __builtin_amdgcn_mfma_f32_16x16x32_bf16((a), (b), (c), 0, 0, 0)
typedef float f32x2_t __attribute__((ext_vector_type(2)));
typedef __bf16 bf16x2_t __attribute__((ext_vector_type(2)));
DI unsigned pk2(float lo, float hi) { f32x2_t v = {lo, hi}; bf16x2_t b = __builtin_convertvector(v, bf16x2_t); return __builtin_bit_cast(unsigned, b); }
DI unsigned f2bf(float f) { return pk2(f, 0.f) & 0xffffu; }
DI float bflo(unsigned w) { return __builtin_bit_cast(float, w << 16); }
DI float bfhi(unsigned w) { return __builtin_bit_cast(float, w & 0xffff0000u); }
DI float bf2f(bf16 b) { return __builtin_bit_cast(float, (unsigned)b << 16); }
DI f32x4 bf4_to_f32(v2u w) { return (f32x4){bflo(w.x), bfhi(w.x), bflo(w.y), bfhi(w.y)}; }
DI float sigmoid_(float x) { return __builtin_amdgcn_rcpf(1.f + __builtin_amdgcn_exp2f(-1.4426950408889634f * x)); }
DI float silu_(float x) { return x * sigmoid_(x); }
DI float softplus_(float x) { return x > 20.f ? x : log1pf(__expf(x)); }
DI float gelu_tanh_(float x) { return x * sigmoid_(1.5957691216057308f * (x + 0.044715f * x * x * x)); }
DI float wave_sum(float v) {
#pragma unroll
    for (int o = 1; o < 64; o <<= 1) v += __shfl_xor(v, o);
    return v;
}
DI bf16x8 pack8(f32x4 a, f32x4 b) { v4u p; p.x = pk2(a[0], a[1]); p.y = pk2(a[2], a[3]); p.z = pk2(b[0], b[1]); p.w = pk2(b[2], b[3]); return __builtin_bit_cast(bf16x8, p); }
#define XB_TMO      128
#define XB_XCNT(j)  (256  + 64 * (j))
#define XB_XSUB(j)  (1280 + 64 * (j))
#define XB_XGEN(j)  (2304 + 64 * (j))
#define XB_TOP      3328
#define XB_TOPGEN   3392
#define XCD_BAR_WORDS 3456
#define XB_SPIN_CAP (1u << 18)

__device__ __forceinline__ unsigned xb_ld(unsigned* p)              { return __hip_atomic_load(p, __ATOMIC_RELAXED, __HIP_MEMORY_SCOPE_AGENT); }
__device__ __forceinline__ unsigned xb_add(unsigned* p, unsigned v) { return __hip_atomic_fetch_add(p, v, __ATOMIC_RELAXED, __HIP_MEMORY_SCOPE_AGENT); }
__device__ __forceinline__ unsigned xb_xcc_id() { return (unsigned)__builtin_amdgcn_s_getreg((3 << 11) | 20) & 0xFu; }
#define XB_SPIN(cond, bar) do { unsigned _sp = 0; while (cond) { __builtin_amdgcn_s_sleep(1); \
    if ((++_sp & 255u) == 0u) { if (xb_ld(&(bar)[XB_TMO])) break; if (_sp > XB_SPIN_CAP) { atomicAdd(&(bar)[XB_TMO], 1u); break; } } } } while (0)

struct XcdBarrier {
    unsigned* bar; unsigned x;
    volatile LAS unsigned* st;
};

__device__ __forceinline__ XcdBarrier xcd_barrier_post(unsigned* bar, volatile LAS unsigned* st) {
    XcdBarrier b; b.bar = bar; b.x = xb_xcc_id(); b.st = st;
    if (threadIdx.x == 0) (void)xb_add(&bar[XB_XCNT(b.x)], 1u);
    return b;
}
__device__ __forceinline__ void xcd_barrier_complete(unsigned* bar, unsigned x, unsigned& nloc, unsigned& nx) {
    const unsigned G = gridDim.x * gridDim.y * gridDim.z;
    unsigned sum, cnt, mine, sp = 0u;
    for (;;) {
        sum = 0u; cnt = 0u; mine = 0u;
#pragma unroll
        for (unsigned j = 0; j < 16; ++j) { const unsigned c = xb_ld(&bar[XB_XCNT(j)]); sum += c; cnt += (c > 0u) ? 1u : 0u; mine = (j == x) ? c : mine; }
        if (sum == G) break;
        __builtin_amdgcn_s_sleep(1);
        if ((++sp & 255u) == 0u) { if (xb_ld(&bar[XB_TMO])) break; if (sp > XB_SPIN_CAP) { atomicAdd(&bar[XB_TMO], 1u); break; } }
    }
    nloc = mine > 0u ? mine : 1u; nx = cnt > 0u ? cnt : 1u;
}

__device__ __forceinline__ void xcd_barrier(const XcdBarrier& b) {
    asm volatile("s_waitcnt vmcnt(0)" ::: "memory");
    __syncthreads();
    if (threadIdx.x == 0) {
        unsigned* bar = b.bar;
        __builtin_amdgcn_s_waitcnt(0);
        unsigned nloc = b.st[0], nx = b.st[1];
        if (nloc == 0u) { xcd_barrier_complete(bar, b.x, nloc, nx); b.st[0] = nloc; b.st[1] = nx; }
        const unsigned old = xb_add(&bar[XB_XSUB(b.x)], 1u);
        const unsigned gen = old / nloc;
        if (old + 1u == (gen + 1u) * nloc) {
            __builtin_amdgcn_fence(__ATOMIC_RELEASE, "agent");
            asm volatile("s_waitcnt vmcnt(0)" ::: "memory");
            const unsigned og = xb_add(&bar[XB_TOP], 1u);
            const unsigned tg = og / nx;
            if (og + 1u == (tg + 1u) * nx) xb_add(&bar[XB_TOPGEN], 1u);
            else XB_SPIN(xb_ld(&bar[XB_TOPGEN]) == tg, bar);
            __builtin_amdgcn_fence(__ATOMIC_ACQUIRE, "agent");
            xb_add(&bar[XB_XGEN(b.x)], 1u);
            asm volatile("s_waitcnt vmcnt(0)" ::: "memory");
        } else {
            XB_SPIN(xb_ld(&bar[XB_XGEN(b.x)]) == gen, bar);
            __builtin_amdgcn_fence(__ATOMIC_ACQUIRE, "agent");
            asm volatile("s_waitcnt vmcnt(0)" ::: "memory");
        }
    }
    __syncthreads();
}
struct Args { const float* in[25]; float* out; unsigned char* ws; int ph_lo, ph_hi; };

struct CvItem { const float* src; bf16* dst; int ldw, K; const float* kscale; };
DI void cv_load(const CvItem& d, float (&v)[32], f32x4 (&kg)[2], int lane) {
#pragma unroll
    for (int i = 0; i < 32; ++i) v[i] = __builtin_nontemporal_load((const GAS float*)(d.src + (size_t)(2 * i + (lane >> 5)) * d.ldw + (lane & 31)));
    const GAS f32x4* kp = (const GAS f32x4*)((d.kscale ? d.kscale : d.src) + 8 * (lane & 7));
    kg[0] = kp[0]; kg[1] = kp[1];
}
DI void cv_finish(const CvItem& d, const float (&v)[32], const f32x4 (&kg)[2], LAS float* scr, int lane) {
#pragma unroll
    for (int i = 0; i < 32; ++i) scr[(2 * i + (lane >> 5)) * 33 + (lane & 31)] = v[i];
    LDS_WAIT(); asm volatile("" ::: "memory");
    const int c = lane & 7; const bool ks = d.kscale != nullptr;
    const f32x4 g0 = ks ? kg[0] : (f32x4){1.f, 1.f, 1.f, 1.f}, g1 = ks ? kg[1] : (f32x4){1.f, 1.f, 1.f, 1.f};
#pragma unroll
    for (int j = 0; j < 4; ++j) { const int n = (lane >> 3) + 8 * j; const LAS float* s = scr + (8 * c) * 33 + n;
        v4u o; o.x = pk2(s[0 * 33] * g0.x, s[1 * 33] * g0.y); o.y = pk2(s[2 * 33] * g0.z, s[3 * 33] * g0.w); o.z = pk2(s[4 * 33] * g1.x, s[5 * 33] * g1.y); o.w = pk2(s[6 * 33] * g1.z, s[7 * 33] * g1.w);
        *(GAS v4u*)(d.dst + (size_t)n * d.K + 8 * c) = o; }
    LDS_WAIT(); asm volatile("" ::: "memory");
}
DI void norm_phase(const float* xp, const float* xs, const float* X, bool first, const float* w, bf16* XN, int gw, int NGW, int lane) {
    const GAS f32x4* wr = (const GAS f32x4*)w + lane;
    for (int mb = gw; mb < MR; mb += 2 * NGW) { f32x4 v[2][16];
#pragma unroll
        for (int r = 0; r < 2; ++r) { const int m = mb + r * NGW < MR ? mb + r * NGW : mb;
            const float* src = first ? (m < MP ? xp + (size_t)m * D : xs + (size_t)(m - MP) * D) : X + (size_t)m * D; const GAS f32x4* xr = (const GAS f32x4*)src + lane;
#pragma unroll
            for (int j = 0; j < 16; ++j) v[r][j] = xr[64 * j]; }
#pragma unroll
        for (int r = 0; r < 2; ++r) { const int m = mb + r * NGW; float s = 0.f;
#pragma unroll
            for (int j = 0; j < 16; ++j) s += (v[r][j].x * v[r][j].x + v[r][j].y * v[r][j].y) + (v[r][j].z * v[r][j].z + v[r][j].w * v[r][j].w);
            const float rstd = rsqrtf(wave_sum(s) * (1.f / D) + EPS);
            if (m < MR) { GAS v2u* o8 = (GAS v2u*)(XN + (size_t)m * D) + lane;
#pragma unroll
                for (int j = 0; j < 16; ++j) { const f32x4 g = wr[64 * j]; v2u o; o.x = pk2(v[r][j].x * rstd * g.x, v[r][j].y * rstd * g.y); o.y = pk2(v[r][j].z * rstd * g.z, v[r][j].w * rstd * g.w); o8[64 * j] = o; } } } }
    if (first) for (int m = MR + gw; m < MPAD; m += NGW) { GAS v4u* o = (GAS v4u*)(XN + (size_t)m * D) + lane;
#pragma unroll
        for (int j = 0; j < 8; ++j) o[64 * j] = (v4u){0u, 0u, 0u, 0u}; }
}
DI void rowss_phase(const bf16* XB, float* rss, int m0, int m1, int gw, int NGW, int lane) {
    for (int mb = m0 + gw; mb < m1; mb += 4 * NGW) { v4u w[4][8];
#pragma unroll
        for (int r = 0; r < 4; ++r) { const int m = mb + r * NGW < m1 ? mb + r * NGW : mb; const GAS v4u* xr = (const GAS v4u*)(XB + (size_t)m * D) + lane;
#pragma unroll
            for (int j = 0; j < 8; ++j) w[r][j] = xr[64 * j]; }
#pragma unroll
        for (int r = 0; r < 4; ++r) { float s = 0.f;
#pragma unroll
            for (int j = 0; j < 8; ++j) { const v4u q = w[r][j]; const float f[8] = {bflo(q.x), bfhi(q.x), bflo(q.y), bfhi(q.y), bflo(q.z), bfhi(q.z), bflo(q.w), bfhi(q.w)};
#pragma unroll
                for (int e = 0; e < 8; ++e) s += f[e] * f[e]; }
            s = wave_sum(s); if (lane == 0 && mb + r * NGW < m1) *(GAS float*)(rss + mb + r * NGW) = s; } }
}
constexpr int I_IN = 64 * 385, I_G = 2 * NH * 8, I_DN = 256 * 128, I_UP = 64 * 512, I_OUT = 64 * 128;
constexpr int CV_ITEMS = I_IN + I_G + I_DN + I_UP + I_OUT, CV_SPLIT = I_IN + I_G + I_DN + I_UP / 4;
DI CvItem cv_decode(const Args& a, int l, int it) {
    bf16* WIN = (bf16*)(a.ws + WS_WIN); bf16* WOUT = (bf16*)(a.ws + WS_WOUT); bf16* WUP = (bf16*)(a.ws + WS_WUP); bf16* WDN = (bf16*)(a.ws + WS_WDN); bf16* WG = (bf16*)(a.ws + WS_WG);
    int r = it; CvItem d;
    if (r < I_IN) { const int kb = r / 385, nb = r % 385; const int nsrc = nb < 256 ? nb : (nb < 384 ? nb + 1 : 256);
        d.src = a.in[7] + (size_t)l * D * NIN + (size_t)(64 * kb) * NIN + 32 * nsrc; d.ldw = NIN; d.dst = WIN + ((size_t)((32 * nb) >> 8) * (D / 64) + kb) * 16384 + (size_t)((32 * nb) & 255) * 64; d.K = 64; d.kscale = nullptr; return d; } r -= I_IN;
    if (r < I_G) { const int gm = r >> 3, sub = r & 7;
        d.src = (gm < NH ? a.in[14] : a.in[16]) + ((size_t)l * NH + (gm & 15)) * 128 * 128 + (size_t)(64 * (sub >> 2)) * 128 + 32 * (sub & 3); d.ldw = 128;
        d.dst = WG + (size_t)gm * 128 * 128 + (size_t)(32 * (sub & 3)) * 128 + 64 * (sub >> 2); d.K = 128; d.kscale = nullptr; return d; } r -= I_G;
    if (r < I_DN) { const int kb = r / 128, nb = r % 128, n0 = 32 * nb;
        d.src = a.in[23] + (size_t)l * DFF * D + (size_t)(64 * kb) * D + n0; d.ldw = D; d.dst = WDN + ((size_t)(n0 >> 8) * (DFF / 64) + kb) * 16384 + (size_t)(n0 & 255) * 64; d.K = 64; d.kscale = nullptr; return d; } r -= I_DN;
    if (r < I_UP) { d.src = a.in[22] + (size_t)l * D * DFF + (size_t)(64 * (r / 512)) * DFF + 32 * (r % 512); d.ldw = DFF; d.dst = WUP + ((size_t)((32 * (r % 512)) >> 8) * (D / 64) + r / 512) * 16384 + (size_t)((32 * (r % 512)) & 255) * 64; d.K = 64; d.kscale = a.in[21] + (size_t)l * D + 64 * (r / 512); return d; } r -= I_UP;
    d.src = a.in[20] + (size_t)l * D * D + (size_t)(64 * (r / 128)) * D + 32 * (r % 128); d.ldw = D; d.dst = WOUT + ((size_t)((32 * (r % 128)) >> 8) * (D / 64) + r / 128) * 16384 + (size_t)((32 * (r % 128)) & 255) * 64; d.K = 64; d.kscale = nullptr; return d;
}
DI void convert_range(const Args& a, int l, int it0, int itend, int stride, LAS float* scr, int lane) {
    for (int it = it0; it < itend; it += stride) { const CvItem d = cv_decode(a, l, it); float v[32]; f32x4 kg[2]; cv_load(d, v, kg, lane); cv_finish(d, v, kg, scr, lane); }
}
DI void convert_range2(const Args& a, int l, int it0, int itend, int stride, LAS float* scr, int lane) {
    if (it0 >= itend) return;
    float v0[32], v1[32]; f32x4 k0[2], k1[2];
    { const CvItem d = cv_decode(a, l, it0); cv_load(d, v0, k0, lane); }
    for (int it = it0; it < itend; it += 2 * stride) { const int i1 = it + stride, i2 = it + 2 * stride;
        { const CvItem d = cv_decode(a, l, i1 < itend ? i1 : it); cv_load(d, v1, k1, lane); }
        { const CvItem d = cv_decode(a, l, it); cv_finish(d, v0, k0, scr, lane); }
        { const CvItem d = cv_decode(a, l, i2 < itend ? i2 : it); cv_load(d, v0, k0, lane); }
        if (i1 < itend) { const CvItem d = cv_decode(a, l, i1); cv_finish(d, v1, k1, scr, lane); } }
}
DI void p0_weights(const Args& a, int l, LAS unsigned char* lds, int gw, int NGW, int wave, int lane) {
    LAS float* scr = (LAS float*)(lds + wave * 16384);
    bf16* WIN = (bf16*)(a.ws + WS_WIN);
    if (l == 0) convert_range(a, l, gw, I_IN + I_G, NGW, scr, lane);
    { const int gt = gw * 64 + lane, NT = NGW * 64; constexpr int PER = (NINP - NIN) * 64 / 8;
      for (int i = gt; i < (D / 64) * PER; i += NT) { const int kt = i / PER, o = i % PER; *(GAS v4u*)(WIN + ((size_t)(NIN >> 8) * (D / 64) + kt) * 16384 + (size_t)(NIN & 255) * 64 + 8 * o) = (v4u){0u, 0u, 0u, 0u}; } }
}

DI void unit_decode(int u, bool& samp, int& b, int& n, int& h, int& rowbase, int& L) {
    samp = u >= NUNIT_P;
    if (!samp) { b = u >> 11; n = (u >> 4) & 127; h = u & 15; rowbase = b * SEQ + n * 64; L = 64; }
    else { const int s = u - NUNIT_P; b = s >> 4; h = s & 15; n = 0; rowbase = MP + b * LS; L = LS; }
}
struct DInv { f32x4 w0, w1, w2, w3; float nalog, dtb; };
DI void delta_inv_load(const Args& a, int l, int h, int tid, DInv& v) {
    if (tid < 384) { const int p = tid >> 7, cq = tid & 31; const float* wc = a.in[8] + (size_t)l * 4 * QKV + p * 2048 + h * 128 + 4 * cq;
        v.w0 = *(const GAS f32x4*)(wc); v.w1 = *(const GAS f32x4*)(wc + QKV); v.w2 = *(const GAS f32x4*)(wc + 2 * QKV); v.w3 = *(const GAS f32x4*)(wc + 3 * QKV); }
    v.nalog = -__expf(a.in[9][l * NH + h]); v.dtb = a.in[10][l * NH + h];
}
DI void delta_issue(const Args& a, int u, int tid, v2u (&xraw)[19], unsigned& sraw) {
    asm volatile("" : "+v"(tid)); const int lane = tid & 63, wave = __builtin_amdgcn_readfirstlane(tid >> 6);
    bool samp; int b, n, h, rowbase, L; unit_decode(u, samp, b, n, h, rowbase, L);
    const bf16* PROJ = (const bf16*)(a.ws + WS_PROJ);
    if (tid < 384) { const int p = tid >> 7, cq = tid & 31, rs = (tid >> 5) & 3, t0 = rs * 16, col = p * 2048 + h * 128 + 4 * cq;
#pragma unroll
        for (int i = 0; i < 19; ++i) { int row = rowbase + t0 - 3 + i; row = row < 0 ? 0 : row; xraw[i] = *(const GAS v2u*)(PROJ + (size_t)row * NINP + col); } }
    else if (wave == 7) { const size_t row = (size_t)(rowbase + (lane < L ? lane : 0));
        sraw = (unsigned)*(const GAS bf16*)(PROJ + row * NINP + C_BL + h) | ((unsigned)*(const GAS bf16*)(PROJ + row * NINP + C_AL + h) << 16); }
}
DI void delta_prepass_unit(const Args& a, int l, int u, int u_next, LAS unsigned char* lds, int tid, v2u (&xraw)[19], unsigned& sraw, const DInv& inv) {
    const int tid_in = tid; asm volatile("" : "+v"(tid)); const int lane = tid & 63, wave = __builtin_amdgcn_readfirstlane(tid >> 6);
    bool samp; int b, n, h, rowbase, L; unit_decode(u, samp, b, n, h, rowbase, L);
    const bf16* PROJ = (const bf16*)(a.ws + WS_PROJ);
    unsigned char* rec = a.ws + WS_DF + (size_t)u * DF_STRIDE;
    LAS float* TS = (LAS float*)(lds + L_KN);
    LAS float* SCB = (LAS float*)(lds + L_SC); LAS float* SCG = SCB + 64; LAS float* RK2 = SCB + 128; LAS float* QQ2 = SCB + 192;
    const int fr = lane & 15, fq = lane >> 4;
    if (tid < 384) {
        const int p = tid >> 7, cq = tid & 31, rs = (tid >> 5) & 3, t0 = rs * 16;
        const int col = p * 2048 + h * 128 + 4 * cq;
        const f32x4 w0 = inv.w0, w1 = inv.w1, w2 = inv.w2, w3 = inv.w3;
        const float* cst = a.in[3] + ((size_t)(l * NBS + b) * 3) * QKV + col;
        f32x4 xr[19];
#pragma unroll
        for (int i = 0; i < 19; ++i) xr[i] = bf4_to_f32(xraw[i]);
        if (samp || n == 0) {
#pragma unroll
            for (int i = 0; i < 19; ++i) { const int tl = t0 - 3 + i; const bool use = (tl < L) && (tl >= 0); if (!use) xr[i] = (f32x4){0.f, 0.f, 0.f, 0.f}; }
            if (samp && t0 == 0) {
#pragma unroll
                for (int i = 0; i < 3; ++i) xr[i] = *(const GAS f32x4*)(cst + (size_t)i * QKV); } }
        unsigned tp[4][8];
#pragma unroll
        for (int rp = 0; rp < 8; ++rp) { const int r = 2 * rp;
            const f32x4 y0 = w0 * xr[r] + w1 * xr[r + 1] + w2 * xr[r + 2] + w3 * xr[r + 3], y1 = w0 * xr[r + 1] + w1 * xr[r + 2] + w2 * xr[r + 3] + w3 * xr[r + 4];
            f32x4 s0, s1; s0.x = silu_(y0.x); s0.y = silu_(y0.y); s0.z = silu_(y0.z); s0.w = silu_(y0.w); s1.x = silu_(y1.x); s1.y = silu_(y1.y); s1.z = silu_(y1.z); s1.w = silu_(y1.w);
            if (samp) { if (t0 + r >= L) s0 = (f32x4){0.f, 0.f, 0.f, 0.f}; if (t0 + r + 1 >= L) s1 = (f32x4){0.f, 0.f, 0.f, 0.f}; }
            if (p < 2) { LAS unsigned char* d = lds + (p == 0 ? L_QN : L_KN) + (t0 + r) * 272 + 8 * cq;
                *(LAS v2u*)d = (v2u){pk2(s0.x, s0.y), pk2(s0.z, s0.w)}; *(LAS v2u*)(d + 272) = (v2u){pk2(s1.x, s1.y), pk2(s1.z, s1.w)}; }
            if (p >= 1) { tp[0][rp] = pk2(s0.x, s1.x); tp[1][rp] = pk2(s0.y, s1.y); tp[2][rp] = pk2(s0.z, s1.z); tp[3][rp] = pk2(s0.w, s1.w); }
        }
        if (p >= 1) { const int base = (p == 1 ? L_KT : L_VT);
#pragma unroll
            for (int e = 0; e < 4; ++e) { LAS v4u* d = (LAS v4u*)(lds + base + (4 * cq + e) * 144 + t0 * 2);
                d[0] = (v4u){tp[e][0], tp[e][1], tp[e][2], tp[e][3]}; d[1] = (v4u){tp[e][4], tp[e][5], tp[e][6], tp[e][7]}; } }
        delta_issue(a, u_next, tid_in, xraw, sraw);
    } else if (wave == 7) {
        const bool valid = lane < L;
        const float bl = bflo(sraw), al = bfhi(sraw);
        delta_issue(a, u_next, tid_in, xraw, sraw);
        const float beta = valid ? sigmoid_(bl) : 0.f;
        float g = valid ? inv.nalog * softplus_(al + inv.dtb) : 0.f;
#pragma unroll
        for (int o = 1; o < 64; o <<= 1) { const float t = __shfl_up(g, o); if (lane >= o) g += t; }
        SCB[lane] = beta; SCG[lane] = g;
        if (lane == 63) *(GAS float*)(rec + DF_GL) = __expf(g);
    }
    LDS_BARRIER();
    {
        const int m = wave >> 1, n0 = 2 * (wave & 1);
        bf16x8 ak[4];
#pragma unroll
        for (int s = 0; s < 4; ++s) ak[s] = *(const LAS bf16x8*)(lds + L_KN + (16 * m + fr) * 272 + 16 * fq + 64 * s);
#pragma unroll
        for (int nn = 0; nn < 2; ++nn) { const int nt = n0 + nn;
            f32x4 kk = {0.f, 0.f, 0.f, 0.f}, qk = {0.f, 0.f, 0.f, 0.f};
#pragma unroll
            for (int s = 0; s < 4; ++s) { const bf16x8 bk = *(const LAS bf16x8*)(lds + L_KN + (16 * nt + fr) * 272 + 16 * fq + 64 * s), bq = *(const LAS bf16x8*)(lds + L_QN + (16 * nt + fr) * 272 + 16 * fq + 64 * s);
                kk = MFMA16(ak[s], bk, kk); qk = MFMA16(ak[s], bq, qk); }
#pragma unroll
            for (int r = 0; r < 4; ++r) { ((LAS float*)(lds + L_KK))[(16 * m + 4 * fq + r) * 68 + 16 * nt + fr] = kk[r]; ((LAS float*)(lds + L_QKT))[(16 * m + 4 * fq + r) * 64 + 16 * nt + fr] = qk[r];
                if (nt == m && 4 * fq + r == fr) RK2[16 * m + fr] = kk[r]; } }
        if (wave < 4) { f32x4 qq = {0.f, 0.f, 0.f, 0.f};
#pragma unroll
            for (int s = 0; s < 4; ++s) { const bf16x8 aq = *(const LAS bf16x8*)(lds + L_QN + (16 * wave + fr) * 272 + 16 * fq + 64 * s); qq = MFMA16(aq, aq, qq); }
#pragma unroll
            for (int r = 0; r < 4; ++r) if (4 * fq + r == fr) QQ2[16 * wave + fr] = qq[r]; }
    }
    LDS_BARRIER();
#pragma unroll
    for (int e = 0; e < 8; ++e) { const int idx = tid + 512 * e, i = idx >> 6, j = idx & 63; LAS float* p = (LAS float*)(lds + L_KK) + i * 68 + j;
        const float v = (i > j) ? SCB[i] * rsqrtf(RK2[i] + EPS) * rsqrtf(RK2[j] + EPS) * (*p) * __expf(SCG[i] - SCG[j]) : 0.f; *p = v; }
    LDS_BARRIER();
    if (wave == 0) {
        const LAS float* Ab = (const LAS float*)(lds + L_KK) + (16 * fq) * 68 + 16 * fq;
        float X[16]; X[0] = (fr == 0) ? 1.f : 0.f;
#pragma unroll
        for (int gi = 0; gi < 4; ++gi) { f32x4 ar[4][4];
#pragma unroll
            for (int ii = 0; ii < 4; ++ii)
#pragma unroll
                for (int qd = 0; qd <= gi; ++qd) ar[ii][qd] = *(const LAS f32x4*)(Ab + (4 * gi + ii) * 68 + 4 * qd);
#pragma unroll
            for (int ii = 0; ii < 4; ++ii) { const int i = 4 * gi + ii; if (i == 0) continue; float acc = (i == fr) ? 1.f : 0.f;
#pragma unroll
                for (int j = 0; j < i; ++j) acc -= ar[ii][j >> 2][j & 3] * X[j];
                X[i] = acc; } }
#pragma unroll
        for (int i = 0; i < 16; ++i) TS[(16 * fq + i) * 68 + 16 * fq + fr] = X[i];
    } else {
        for (int f = wave - 1; f < 8; f += 7) { const int mi = f >> 1, s2 = f & 1, i = 16 * mi + fr; const float si = rsqrtf(QQ2[i] + EPS) * 0.08838834764831845f, Gi = SCG[i];
            float v[8];
#pragma unroll
            for (int e = 0; e < 8; ++e) { const int j = 16 * (2 * s2 + (e >> 2)) + 4 * fq + (e & 3);
                v[e] = (i >= j) ? si * rsqrtf(RK2[j] + EPS) * ((const LAS float*)(lds + L_QKT))[j * 64 + i] * __expf(Gi - SCG[j]) : 0.f; }
            v4u o; o.x = pk2(v[0], v[1]); o.y = pk2(v[2], v[3]); o.z = pk2(v[4], v[5]); o.w = pk2(v[6], v[7]);
            *(LAS v4u*)(lds + L_QKF + (f * 64 + lane) * 16) = o; }
    }
    LDS_BARRIER();
#pragma unroll
    for (int d = 1; d < 4; ++d) {
        if (wave < 4 - d) { const int bi = wave + d, bj = wave; const LAS float* As = (const LAS float*)(lds + L_KK);
            f32x4 P = {0.f, 0.f, 0.f, 0.f};
            for (int k = bj; k < bi; ++k)
#pragma unroll
                for (int kk = 0; kk < 4; ++kk) P = __builtin_amdgcn_mfma_f32_16x16x4f32(As[(16 * bi + fr) * 68 + 16 * k + 4 * kk + fq], TS[(16 * k + 4 * kk + fq) * 68 + 16 * bj + fr], P, 0, 0, 0);
            f32x4 R = {0.f, 0.f, 0.f, 0.f};
#pragma unroll
            for (int kk = 0; kk < 4; ++kk) R = __builtin_amdgcn_mfma_f32_16x16x4f32(TS[(16 * bi + fr) * 68 + 16 * bi + 4 * fq + kk], P[kk], R, 0, 0, 0);
#pragma unroll
            for (int r = 0; r < 4; ++r) TS[(16 * bi + 4 * fq + r) * 68 + 16 * bj + fr] = -R[r]; }
        LDS_BARRIER();
    }
#pragma unroll
    for (int e = 0; e < 8; ++e) { const int idx = tid + 512 * e, i = idx >> 6, j = idx & 63; const float t = (i >= j) ? TS[i * 68 + j] : 0.f, bj = SCB[j];
        *(LAS bf16*)(lds + L_TU + i * 144 + 2 * j) = (bf16)f2bf(t * bj); *(LAS bf16*)(lds + L_TW + i * 144 + 2 * j) = (bf16)f2bf(t * bj * rsqrtf(RK2[j] + EPS) * __expf(SCG[j])); }
    LDS_BARRIER();
    {
        bf16x8 bk[2], bv[2];
#pragma unroll
        for (int s2 = 0; s2 < 2; ++s2) { bk[s2] = *(const LAS bf16x8*)(lds + L_KT + (16 * wave + fr) * 144 + 16 * fq + 64 * s2); bv[s2] = *(const LAS bf16x8*)(lds + L_VT + (16 * wave + fr) * 144 + 16 * fq + 64 * s2); }
        f32x4 wt[4], ut[4];
#pragma unroll
        for (int mi = 0; mi < 4; ++mi) { wt[mi] = (f32x4){0.f, 0.f, 0.f, 0.f}; ut[mi] = (f32x4){0.f, 0.f, 0.f, 0.f};
#pragma unroll
            for (int s2 = 0; s2 < 2; ++s2) { const bf16x8 aw = *(const LAS bf16x8*)(lds + L_TW + (16 * mi + fr) * 144 + 16 * fq + 64 * s2), au = *(const LAS bf16x8*)(lds + L_TU + (16 * mi + fr) * 144 + 16 * fq + 64 * s2);
                wt[mi] = MFMA16(aw, bk[s2], wt[mi]); ut[mi] = MFMA16(au, bv[s2], ut[mi]); } }
        const bf16x8 wA[2] = {pack8(wt[0], wt[1]), pack8(wt[2], wt[3])}, uB[2] = {pack8(ut[0], ut[1]), pack8(ut[2], ut[3])};
        const float glast = SCG[63];
        float ksc[2][2][4];
#pragma unroll
        for (int s2 = 0; s2 < 2; ++s2)
#pragma unroll
            for (int hh = 0; hh < 2; ++hh)
#pragma unroll
                for (int e = 0; e < 4; ++e) { const int j = 16 * (2 * s2 + hh) + 4 * fq + e; ksc[s2][hh][e] = rsqrtf(RK2[j] + EPS) * __expf(glast - SCG[j]); }
        const int half = 8 * (wave & 1), sw = wave >> 1;
#pragma unroll
        for (int m = 0; m < 8; ++m) { bf16x8 kdf[2];
#pragma unroll
            for (int s2 = 0; s2 < 2; ++s2) { f32x4 x[2];
#pragma unroll
                for (int hh = 0; hh < 2; ++hh) { x[hh] = bf4_to_f32(*(const LAS v2u*)(lds + L_KT + (16 * m + fr) * 144 + 2 * (16 * (2 * s2 + hh) + 4 * fq)));
#pragma unroll
                    for (int e = 0; e < 4; ++e) x[hh][e] *= ksc[s2][hh][e]; }
                kdf[s2] = pack8(x[0], x[1]); }
            f32x4 c0 = {0.f, 0.f, 0.f, 0.f}, c1 = {0.f, 0.f, 0.f, 0.f};
#pragma unroll
            for (int s2 = 0; s2 < 2; ++s2) { c0 = MFMA16(wA[s2], kdf[s2], c0); c1 = MFMA16(kdf[s2], uB[s2], c1); }
            v2u o; o.x = pk2(-c0[0], -c0[1]); o.y = pk2(-c0[2], -c0[3]); *(GAS v2u*)(rec + DF_MP + (size_t)((m * 4 + sw) * 64 + lane) * 16 + half) = o;
            v2u p; p.x = pk2(c1[0], c1[1]); p.y = pk2(c1[2], c1[3]); *(GAS v2u*)(rec + DF_BN + (size_t)((wave * 8 + m) * 64 + lane) * 8) = p; }
#pragma unroll
        for (int ni = 0; ni < 4; ++ni) { const int i = 16 * ni + fr; f32x4 c0 = {0.f, 0.f, 0.f, 0.f}, c1 = {0.f, 0.f, 0.f, 0.f};
#pragma unroll
            for (int s2 = 0; s2 < 2; ++s2) { const bf16x8 qf = *(const LAS bf16x8*)(lds + L_QKF + ((ni * 2 + s2) * 64 + lane) * 16); c0 = MFMA16(wA[s2], qf, c0); c1 = MFMA16(qf, uB[s2], c1); }
            const float sc = rsqrtf(QQ2[i] + EPS) * 0.08838834764831845f * __expf(SCG[i]);
            const f32x4 qv = bf4_to_f32(*(const LAS v2u*)(lds + L_QN + i * 272 + 2 * (16 * wave + 4 * fq)));
            v2u o; o.x = pk2(qv[0] * sc - c0[0], qv[1] * sc - c0[1]); o.y = pk2(qv[2] * sc - c0[2], qv[3] * sc - c0[3]); __builtin_nontemporal_store(o, (GAS v2u*)(rec + DF_QE + (size_t)((ni * 4 + sw) * 64 + lane) * 16 + half));
            v2u p; p.x = pk2(c1[0], c1[1]); p.y = pk2(c1[2], c1[3]); __builtin_nontemporal_store(p, (GAS v2u*)(rec + DF_OU + (size_t)((wave * 4 + ni) * 64 + lane) * 8)); }
    }
    LDS_BARRIER();
}
struct LInv { f32x4 w0, w1, w2, w3, bc; bf16x8 bw[2][4]; float ba, bx, c8; };
DI void lru_inv_load(const Args& a, int l, int g, int tid, LInv& v) {
    const int lane = tid & 63, wave = tid >> 6, fr = lane & 15, fq = lane >> 4, cq = tid & 31, ch = g * 128 + 4 * cq;
    const float* wc = a.in[12] + (size_t)l * 4 * DB + ch;
    v.w0 = *(const GAS f32x4*)(wc); v.w1 = *(const GAS f32x4*)(wc + DB); v.w2 = *(const GAS f32x4*)(wc + 2 * DB); v.w3 = *(const GAS f32x4*)(wc + 3 * DB); v.bc = *(const GAS f32x4*)(a.in[13] + (size_t)l * DB + ch);
    const bf16* WG = (const bf16*)(a.ws + WS_WG);
#pragma unroll
    for (int gt = 0; gt < 2; ++gt)
#pragma unroll
        for (int s = 0; s < 4; ++s) v.bw[gt][s] = *(const GAS bf16x8*)(WG + ((size_t)(gt * NH + g) * 128 + 16 * wave + fr) * 128 + 32 * s + 8 * fq);
    const int chj = g * 128 + 16 * wave + fr;
    v.ba = a.in[15][(size_t)l * DB + chj]; v.bx = a.in[17][(size_t)l * DB + chj]; v.c8 = -8.f * softplus_(-a.in[18][(size_t)l * DB + chj]);
}
DI void lru_issue(const Args& a, int u, int tid, v2u (&xraw)[7]) {
    asm volatile("" : "+v"(tid));
    bool samp; int b, n, g, rowbase, L; unit_decode(u, samp, b, n, g, rowbase, L);
    const bf16* PROJ = (const bf16*)(a.ws + WS_PROJ);
    const int cq = tid & 31, rs = tid >> 5, t0 = rs * 4, col = C_XL + g * 128 + 4 * cq;
#pragma unroll
    for (int i = 0; i < 7; ++i) { int row = rowbase + t0 - 3 + i; row = row < 0 ? 0 : row; xraw[i] = *(const GAS v2u*)(PROJ + (size_t)row * NINP + col); }
}
DI void lru_prepass_unit(const Args& a, int l, int u, int u_next, LAS unsigned char* lds, int tid, v2u (&xraw)[7], const LInv& inv) {
    const int tid_in = tid; asm volatile("" : "+v"(tid)); const int lane = tid & 63, wave = __builtin_amdgcn_readfirstlane(tid >> 6);
    bool samp; int b, n, g, rowbase, L; unit_decode(u, samp, b, n, g, rowbase, L);
    const bf16* PROJ = (const bf16*)(a.ws + WS_PROJ); const bf16* WG = (const bf16*)(a.ws + WS_WG);
    bf16* HLOC = (bf16*)(a.ws + WS_HLOC); bf16* CUM = (bf16*)(a.ws + WS_CUM);
    const int fr = lane & 15, fq = lane >> 4;
    LAS float* XCF = (LAS float*)(lds + L_XCF); LAS float* AS = (LAS float*)(lds + L_AS); LAS float* BS = (LAS float*)(lds + L_BS); LAS float* SEGA = (LAS float*)(lds + L_SEG); LAS float* SEGB = SEGA + 1024;
    {
        const int cq = tid & 31, rs = tid >> 5, t0 = rs * 4, ch = g * 128 + 4 * cq, col = C_XL + ch;
        const f32x4 w0 = inv.w0, w1 = inv.w1, w2 = inv.w2, w3 = inv.w3, bc = inv.bc;
        const float* cst = a.in[5] + ((size_t)(l * NBS + b) * 3) * DB + ch;
        f32x4 xr[7];
#pragma unroll
        for (int i = 0; i < 7; ++i) { const int tl = t0 - 3 + i;
            const bool use = (tl < L) && (tl >= 0 || (!samp && n > 0)); const f32x4 x = bf4_to_f32(xraw[i]);
            xr[i] = (f32x4){use ? x.x : 0.f, use ? x.y : 0.f, use ? x.z : 0.f, use ? x.w : 0.f}; }
        if (samp && t0 == 0) {
#pragma unroll
            for (int i = 0; i < 3; ++i) xr[i] = *(const GAS f32x4*)(cst + (size_t)i * DB); }
        lru_issue(a, u_next, tid_in, xraw);
#pragma unroll
        for (int r = 0; r < 4; ++r) { const f32x4 y = w0 * xr[r] + w1 * xr[r + 1] + w2 * xr[r + 2] + w3 * xr[r + 3] + bc;
            v2u o; o.x = pk2(y.x, y.y); o.y = pk2(y.z, y.w); *(LAS v2u*)(lds + L_XCB + (t0 + r) * 272 + 8 * cq) = o; *(LAS f32x4*)(XCF + (t0 + r) * 132 + 4 * cq) = y; }
    }
    LDS_BARRIER();
    {
        f32x4 acc[2][4];
#pragma unroll
        for (int gt = 0; gt < 2; ++gt) {
#pragma unroll
            for (int mi = 0; mi < 4; ++mi) { f32x4 c = {0.f, 0.f, 0.f, 0.f};
#pragma unroll
                for (int s = 0; s < 4; ++s) { const bf16x8 ax = *(const LAS bf16x8*)(lds + L_XCB + (16 * mi + fr) * 272 + 16 * fq + 64 * s); c = MFMA16(ax, inv.bw[gt][s], c); }
                acc[gt][mi] = c; } }
        const int j = 16 * wave + fr, ch = g * 128 + j;
        const float ba = inv.ba, bx = inv.bx, c8 = inv.c8;
#pragma unroll
        for (int mi = 0; mi < 4; ++mi)
#pragma unroll
            for (int r = 0; r < 4; ++r) { const int t = 16 * mi + 4 * fq + r; const float xc = XCF[t * 132 + j];
                const float gr = sigmoid_(acc[0][mi][r] + ba), gi = sigmoid_(acc[1][mi][r] + bx), la = c8 * gr;
                float av = __expf(la), bvv = __builtin_amdgcn_sqrtf(fmaxf(1.f - av * av, 0.f)) * gi * xc;
                if (t >= L) { av = 1.f; bvv = 0.f; }
                AS[t * 132 + j] = av; BS[t * 132 + j] = bvv; }
    }
    LDS_BARRIER();
    {
        const int j2 = tid & 63, seg = tid >> 6; float P0 = 1.f, H0 = 0.f, P1 = 1.f, H1 = 0.f;
#pragma unroll
        for (int r = 0; r < 8; ++r) { const int t = seg * 8 + r; LAS float* pa = AS + t * 132 + 2 * j2; LAS float* pb = BS + t * 132 + 2 * j2;
            const float a0 = pa[0], a1 = pa[1], b0 = pb[0], b1 = pb[1]; H0 = a0 * H0 + b0; P0 *= a0; H1 = a1 * H1 + b1; P1 *= a1; pa[0] = P0; pa[1] = P1; pb[0] = H0; pb[1] = H1; }
        SEGA[seg * 128 + 2 * j2] = P0; SEGA[seg * 128 + 2 * j2 + 1] = P1; SEGB[seg * 128 + 2 * j2] = H0; SEGB[seg * 128 + 2 * j2 + 1] = H1;
        LDS_BARRIER();
        float Pc0 = 1.f, Hc0 = 0.f, Pc1 = 1.f, Hc1 = 0.f;
        for (int s = 0; s < seg; ++s) { const float sa0 = SEGA[s * 128 + 2 * j2], sa1 = SEGA[s * 128 + 2 * j2 + 1]; Hc0 = sa0 * Hc0 + SEGB[s * 128 + 2 * j2]; Pc0 *= sa0; Hc1 = sa1 * Hc1 + SEGB[s * 128 + 2 * j2 + 1]; Pc1 *= sa1; }
        float* CHK = (float*)(a.ws + WS_CHK) + (size_t)u * 256;
#pragma unroll
        for (int r = 0; r < 8; ++r) { const int t = seg * 8 + r; if (t < L) { const float pa0 = AS[t * 132 + 2 * j2], pa1 = AS[t * 132 + 2 * j2 + 1], hb0 = BS[t * 132 + 2 * j2], hb1 = BS[t * 132 + 2 * j2 + 1];
                const float h0 = hb0 + pa0 * Hc0, h1 = hb1 + pa1 * Hc1, c0 = Pc0 * pa0, c1 = Pc1 * pa1; const size_t o = (size_t)(rowbase + t) * DB + g * 128 + 2 * j2;
                __builtin_nontemporal_store(pk2(h0, h1), (GAS unsigned*)(HLOC + o)); __builtin_nontemporal_store(pk2(c0, c1), (GAS unsigned*)(CUM + o));
                if (t == L - 1) { *(GAS f32x2_t*)(CHK + 2 * j2) = (f32x2_t){c0, c1}; *(GAS f32x2_t*)(CHK + 128 + 2 * j2) = (f32x2_t){h0, h1}; } } }
    }
    LDS_BARRIER();
}

DI void delta_sample_task(const Args& a, int l, int ts, int lane) {
    const int fr = lane & 15, fq = lane >> 4, b = ts >> 7, h = (ts >> 3) & 15, vs = ts & 7, u = NUNIT_P + b * NH + h;
    const unsigned char* rec = a.ws + WS_DF + (size_t)u * DF_STRIDE;
    const float* s0 = a.in[2] + ((size_t)(l * NBS + b) * NH + h) * 128 * 128;
    f32x4 S[8];
#pragma unroll
    for (int m = 0; m < 8; ++m)
#pragma unroll
        for (int r = 0; r < 4; ++r) S[m][r] = *(const GAS float*)(s0 + (size_t)(16 * m + 4 * fq + r) * 128 + 16 * vs + fr);
    bf16x8 Sb[4];
#pragma unroll
    for (int s = 0; s < 4; ++s) { Sb[s] = pack8(S[2 * s], S[2 * s + 1]); *(GAS bf16x8*)(a.ws + WS_SST + (size_t)u * 32768 + (size_t)((vs * 4 + s) * 64 + lane) * 16) = Sb[s]; }
    const float gl = *(const GAS float*)(rec + DF_GL);
    float* so = a.out + O_SD + ((size_t)(l * NBS + b) * NH + h) * 128 * 128;
#pragma unroll
    for (int m = 0; m < 8; ++m) { f32x4 acc = S[m] * gl + bf4_to_f32(*(const GAS v2u*)(rec + DF_BN + (size_t)((vs * 8 + m) * 64 + lane) * 8));
#pragma unroll
        for (int s = 0; s < 4; ++s) acc = MFMA16(*(const GAS bf16x8*)(rec + DF_MP + (size_t)((m * 4 + s) * 64 + lane) * 16), Sb[s], acc);
#pragma unroll
        for (int r = 0; r < 4; ++r) *(GAS float*)(so + (size_t)(16 * m + 4 * fq + r) * 128 + 16 * vs + fr) = acc[r]; }
}
DI void seq_phase(const Args& a, int l, int c, LAS unsigned char* lds, int wave, int lane) {
    const float* CHK = (const float*)(a.ws + WS_CHK); float* HIN = (float*)(a.ws + WS_HIN);
    if (c >= 128) { const int cc = c - 128;
        delta_sample_task(a, l, cc * 8 + wave, lane);
        if (wave < 2) { const int idx = (cc * 2 + wave) * 64 + lane, b = idx >> 11, ch = idx & 2047; const float* ck = CHK + (size_t)(NUNIT_P + b * NH + (ch >> 7)) * 256 + (ch & 127);
            *(GAS float*)(a.out + O_SL + (size_t)(l * NBS + b) * DB + ch) = *(const GAS float*)(ck) * a.in[4][(size_t)(l * NBS + b) * DB + ch] + *(const GAS float*)(ck + 128); }
        convert_range2(a, l, I_IN + I_G + cc * NWAVES + wave, CV_SPLIT, 128 * NWAVES, (LAS float*)(lds + wave * 16384), lane);
        return; }
    const int jj = c >> 3, bh = (c & 7) * 4 + (jj >> 2), vs = (jj & 3) * 2 + (wave & 1), b = bh >> 4, h = bh & 15, fr = lane & 15, fq = lane >> 4;
    const int u0 = (b << 11) + h;
    const unsigned char* rec0 = a.ws + WS_DF + (size_t)u0 * DF_STRIDE; constexpr size_t USTEP = 16 * DF_STRIDE;
    const int lw = wave - 2;
    unsigned soff[8], doff[8];
#pragma unroll
    for (int k = 0; k < 8; ++k) { const int p = lw * 8 + k; soff[k] = (unsigned)(p < 32 ? DF_MP + p * 1024 : DF_BN + (jj & 3) * 8192 + (p - 32) * 1024) + lane * 16; doff[k] = (unsigned)(p * 1024 + lane * 16); }
    const int lidx = (c & 63) * 64 + lane, lb = lidx >> 11, lch = lidx & 2047;
    const bool lru_on = (wave == 7) && (c < 64);
    float* hin_w = HIN + (c < 64 ? (size_t)0 : (size_t)NBP * NCH * DB);
    f32x4 S[8]; float H = 0.f;
#pragma unroll
    for (int m = 0; m < 8; ++m) S[m] = (f32x4){0.f, 0.f, 0.f, 0.f};
#define SQ_BAR() do { asm volatile("s_waitcnt lgkmcnt(0)" ::: "memory"); __builtin_amdgcn_s_barrier(); asm volatile("" ::: "memory"); } while (0)
    if (wave < 2) {
        SQ_BAR();
        for (int n = 0; n < NCH; ++n) { LAS unsigned char* sb = lds + L_SQ + (n & 1) * SQ_SLOT;
            bf16x8 Sb[4];
#pragma unroll
            for (int s = 0; s < 4; ++s) { Sb[s] = pack8(S[2 * s], S[2 * s + 1]); __builtin_nontemporal_store(Sb[s], (GAS bf16x8*)(a.ws + WS_SST + (size_t)(u0 + 16 * n) * 32768 + (size_t)((vs * 4 + s) * 64 + lane) * 16)); }
            bf16x8 mp[8][4]; v2u bn[8];
#pragma unroll
            for (int m = 0; m < 8; ++m) {
#pragma unroll
                for (int s = 0; s < 4; ++s) mp[m][s] = *(const LAS bf16x8*)(sb + ((m * 4 + s) * 64 + lane) * 16);
                bn[m] = *(const LAS v2u*)(sb + 32768 + wave * 4096 + (m * 64 + lane) * 8); }
            const float gl = *(const LAS float*)(sb + 40960);
            __builtin_amdgcn_sched_barrier(0);
#pragma unroll
            for (int m = 0; m < 8; ++m) S[m] = S[m] * gl + bf4_to_f32(bn[m]);
#pragma unroll
            for (int s = 0; s < 4; ++s)
#pragma unroll
                for (int m = 0; m < 8; ++m) S[m] = MFMA16(mp[m][s], Sb[s], S[m]);
            __builtin_amdgcn_sched_barrier(0);
            SQ_BAR(); }
    } else if (wave <= 6) {
        v4u buf[4][8]; float glb[4];
#define SQ_ISSUE(q, n) do { const int n_ = (n) < NCH ? (n) : NCH - 1; const unsigned char* r_ = rec0 + (size_t)n_ * USTEP; \
        _Pragma("unroll") for (int k = 0; k < 8; ++k) buf[q][k] = *(const GAS v4u*)(r_ + soff[k]); glb[q] = *(const GAS float*)(r_ + DF_GL); } while (0)
#define SQ_WRITE(q, slot) do { _Pragma("unroll") for (int k = 0; k < 8; ++k) *(LAS v4u*)(lds + L_SQ + (slot) * SQ_SLOT + doff[k]) = buf[q][k]; \
        *(LAS float*)(lds + L_SQ + (slot) * SQ_SLOT + 40960 + 4 * (4 - lw)) = glb[q]; } while (0)
        SQ_ISSUE(0, 0); SQ_ISSUE(1, 1); SQ_ISSUE(2, 2); SQ_ISSUE(3, 3);
        SQ_WRITE(0, 0);
        SQ_BAR();
        for (int t = 0; t < NCH; t += 4) {
#pragma unroll
            for (int q = 0; q < 4; ++q) {
                SQ_ISSUE(q, t + q + 4);
                SQ_WRITE((q + 1) & 3, (q + 1) & 1);
                SQ_BAR(); } }
#undef SQ_ISSUE
#undef SQ_WRITE
    } else {
        float la[4], lbv[4];
#define LR_ISSUE(q, n) do { const int n_ = (n) < NCH ? (n) : NCH - 1; const float* ck_ = CHK + (size_t)((lb << 11) + (n_ << 4) + (lch >> 7)) * 256 + (lch & 127); la[q] = *(const GAS float*)(ck_); lbv[q] = *(const GAS float*)(ck_ + 128); } while (0)
        LR_ISSUE(0, 0); LR_ISSUE(1, 1); LR_ISSUE(2, 2); LR_ISSUE(3, 3);
        SQ_BAR();
        for (int t = 0; t < NCH; t += 4) {
#pragma unroll
            for (int q = 0; q < 4; ++q) {
                *(GAS float*)(hin_w + (size_t)(lb * NCH + t + q) * DB + lch) = H; H = la[q] * H + lbv[q]; LR_ISSUE(q, t + q + 4);
                SQ_BAR(); } }
#undef LR_ISSUE
    }
#undef SQ_BAR
    if (wave < 2) { float* so = a.out + O_PD + ((size_t)(l * NBP + b) * NH + h) * 128 * 128;
#pragma unroll
        for (int m = 0; m < 8; ++m)
#pragma unroll
            for (int r = 0; r < 4; ++r) *(GAS float*)(so + (size_t)(16 * m + 4 * fq + r) * 128 + 16 * vs + fr) = S[m][r]; }
    else if (lru_on) *(GAS float*)(a.out + O_PL + (size_t)(l * NBP + lb) * DB + lch) = H;
}
struct PostRaw { bf16x8 sb[4]; bf16x8 qe[16]; v2u ou[4]; v4u z[2]; };
DI void delta_post_issue(const Args& a, int u, int tid, PostRaw& r) {
    asm volatile("" : "+v"(tid)); const int lane = tid & 63, wave = __builtin_amdgcn_readfirstlane(tid >> 6);
    bool samp; int b, n, h, rowbase, L; unit_decode(u, samp, b, n, h, rowbase, L);
    const unsigned char* rec = a.ws + WS_DF + (size_t)u * DF_STRIDE; const unsigned char* sst = a.ws + WS_SST + (size_t)u * 32768 + (size_t)wave * 4096;
#pragma unroll
    for (int s = 0; s < 4; ++s) r.sb[s] = *(const GAS bf16x8*)(sst + (size_t)(s * 64 + lane) * 16);
#pragma unroll
    for (int i = 0; i < 16; ++i) r.qe[i] = *(const GAS bf16x8*)(rec + DF_QE + (size_t)(i * 64 + lane) * 16);
#pragma unroll
    for (int mi = 0; mi < 4; ++mi) r.ou[mi] = *(const GAS v2u*)(rec + DF_OU + (size_t)((wave * 4 + mi) * 64 + lane) * 8);
    const int row = tid >> 3, seg = tid & 7; const size_t grow = (size_t)(rowbase + (row < L ? row : 0));
#pragma unroll
    for (int k2 = 0; k2 < 2; ++k2) r.z[k2] = *(const GAS v4u*)((const bf16*)(a.ws + WS_PROJ) + grow * NINP + C_Z + h * 128 + 16 * seg + 8 * k2);
}
DI void delta_post_unit(const Args& a, int l, int u, int u_next, LAS unsigned char* lds, int tid, PostRaw& raw, const f32x4 (&wnd)[4]) {
    const int tid_in = tid; asm volatile("" : "+v"(tid)); const int lane = tid & 63, wave = __builtin_amdgcn_readfirstlane(tid >> 6), fr = lane & 15, fq = lane >> 4;
    bool samp; int b, n, h, rowbase, L; unit_decode(u, samp, b, n, h, rowbase, L);
    LAS float* OL = (LAS float*)(lds + L_OL);
#pragma unroll
    for (int mi = 0; mi < 4; ++mi) { f32x4 acc = bf4_to_f32(raw.ou[mi]);
#pragma unroll
        for (int s = 0; s < 4; ++s) acc = MFMA16(raw.qe[mi * 4 + s], raw.sb[s], acc);
#pragma unroll
        for (int r = 0; r < 4; ++r) OL[(16 * mi + 4 * fq + r) * 132 + 16 * wave + fr] = acc[r]; }
    const v4u z0 = raw.z[0], z1 = raw.z[1];
    delta_post_issue(a, u_next, tid_in, raw);
    LDS_BARRIER();
    {   const int row = tid >> 3, seg = tid & 7; f32x4 o[4]; float ss = 0.f;
#pragma unroll
        for (int k = 0; k < 4; ++k) { o[k] = *(const LAS f32x4*)(OL + row * 132 + 16 * seg + 4 * k); ss += (o[k].x * o[k].x + o[k].y * o[k].y) + (o[k].z * o[k].z + o[k].w * o[k].w); }
        ss += __shfl_xor(ss, 1); ss += __shfl_xor(ss, 2); ss += __shfl_xor(ss, 4);
        const float rs = rsqrtf(ss * (1.f / 128.f) + EPS);
        if (row < L) { const size_t grow = (size_t)(rowbase + row);
#pragma unroll
            for (int k2 = 0; k2 < 2; ++k2) { const v4u zz = k2 ? z1 : z0;
                const f32x4 w0 = wnd[2 * k2], w1 = wnd[2 * k2 + 1]; const f32x4 a0 = o[2 * k2], a1 = o[2 * k2 + 1];
                v4u r; r.x = pk2(a0.x * rs * w0.x * silu_(bflo(zz.x)), a0.y * rs * w0.y * silu_(bfhi(zz.x))); r.y = pk2(a0.z * rs * w0.z * silu_(bflo(zz.y)), a0.w * rs * w0.w * silu_(bfhi(zz.y)));
                r.z = pk2(a1.x * rs * w1.x * silu_(bflo(zz.z)), a1.y * rs * w1.y * silu_(bfhi(zz.z))); r.w = pk2(a1.z * rs * w1.z * silu_(bflo(zz.w)), a1.w * rs * w1.w * silu_(bfhi(zz.w)));
                *(GAS v4u*)((bf16*)(a.ws + WS_MIX) + grow * D + h * 128 + 16 * seg + 8 * k2) = r; } }
    }
    LDS_BARRIER();
}
struct LruRowRaw { v4u yy[4], hl[4], cm[4]; f32x4 hi[8]; };
DI void post_row_load(const Args& a, int l, int row, int lane, LruRowRaw& r) {
    const bf16* PROJ = (const bf16*)(a.ws + WS_PROJ); const bf16* HLOC = (const bf16*)(a.ws + WS_HLOC); const bf16* CUM = (const bf16*)(a.ws + WS_CUM);
    const float* hin = row < MP ? (const float*)(a.ws + WS_HIN) + (size_t)((row >> 13) * NCH + ((row & (SEQ - 1)) >> 6)) * DB : a.in[4] + (size_t)(l * NBS + ((row - MP) >> 4)) * DB;
    const int c0 = 32 * lane;
#pragma unroll
    for (int k2 = 0; k2 < 4; ++k2) { r.yy[k2] = *(const GAS v4u*)(PROJ + (size_t)row * NINP + C_YL + c0 + 8 * k2); const size_t o = (size_t)row * DB + c0 + 8 * k2;
        r.hl[k2] = *(const GAS v4u*)(HLOC + o); r.cm[k2] = *(const GAS v4u*)(CUM + o); r.hi[2 * k2] = *(const GAS f32x4*)(hin + c0 + 8 * k2); r.hi[2 * k2 + 1] = *(const GAS f32x4*)(hin + c0 + 8 * k2 + 4); }
}
DI void post_row_finish(const Args& a, int row, int lane, const LruRowRaw& r, const f32x4 (&wn)[8]) {
    bf16* MIX = (bf16*)(a.ws + WS_MIX); const int c0 = 32 * lane;
    float y[32]; float ss = 0.f;
#pragma unroll
    for (int k2 = 0; k2 < 4; ++k2) { const v4u yy = r.yy[k2], hl8 = r.hl[k2], cm8 = r.cm[k2];
        const float gy[8] = {bflo(yy.x), bfhi(yy.x), bflo(yy.y), bfhi(yy.y), bflo(yy.z), bfhi(yy.z), bflo(yy.w), bfhi(yy.w)};
        const float hl[8] = {bflo(hl8.x), bfhi(hl8.x), bflo(hl8.y), bfhi(hl8.y), bflo(hl8.z), bfhi(hl8.z), bflo(hl8.w), bfhi(hl8.w)};
        const float cm[8] = {bflo(cm8.x), bfhi(cm8.x), bflo(cm8.y), bfhi(cm8.y), bflo(cm8.z), bfhi(cm8.z), bflo(cm8.w), bfhi(cm8.w)};
#pragma unroll
        for (int hh = 0; hh < 2; ++hh) { const f32x4 hi = r.hi[2 * k2 + hh];
#pragma unroll
            for (int e = 0; e < 4; ++e) { const float hv = hl[4 * hh + e] + cm[4 * hh + e] * hi[e]; const float v = gelu_tanh_(gy[4 * hh + e]) * hv; y[8 * k2 + 4 * hh + e] = v; ss += v * v; } } }
    const float rs = rsqrtf(wave_sum(ss) * (1.f / DB) + EPS);
#pragma unroll
    for (int k2 = 0; k2 < 4; ++k2) { const f32x4 w0 = wn[2 * k2], w1 = wn[2 * k2 + 1];
        v4u o; o.x = pk2(y[8 * k2] * rs * w0.x, y[8 * k2 + 1] * rs * w0.y); o.y = pk2(y[8 * k2 + 2] * rs * w0.z, y[8 * k2 + 3] * rs * w0.w);
        o.z = pk2(y[8 * k2 + 4] * rs * w1.x, y[8 * k2 + 5] * rs * w1.y); o.w = pk2(y[8 * k2 + 6] * rs * w1.z, y[8 * k2 + 7] * rs * w1.w);
        *(GAS v4u*)(MIX + (size_t)row * D + DA + c0 + 8 * k2) = o; }
}
DI void post_phase(const Args& a, int l, int gw, int NGW, int lane) {
    bf16* MIX = (bf16*)(a.ws + WS_MIX); const bf16* PROJ = (const bf16*)(a.ws + WS_PROJ);
    f32x4 wn[8];
#pragma unroll
    for (int k = 0; k < 8; ++k) wn[k] = *(const GAS f32x4*)(a.in[19] + (size_t)l * DB + 32 * lane + 4 * k);
    {
        LruRowRaw ra; int m = gw; if (m < MR) post_row_load(a, l, m, lane, ra);
        for (; m < MR; m += NGW) { const int mn = m + NGW < MR ? m + NGW : m; LruRowRaw rb; post_row_load(a, l, mn, lane, rb); post_row_finish(a, m, lane, ra, wn); ra = rb; } }
    for (int m = MR + gw; m < MPAD; m += NGW) { GAS v4u* o = (GAS v4u*)(MIX + (size_t)m * D) + lane;
#pragma unroll
        for (int j = 0; j < 8; ++j) o[64 * j] = (v4u){0u, 0u, 0u, 0u}; }
    const int gt = gw * 64 + lane, NT = NGW * 64;
    for (int i = gt; i < (NBP + NBS) * 3 * 8192; i += NT) { const int col = i & 8191, rr = (i >> 13) % 3, st = i / (3 * 8192);
        const int row = st < NBP ? st * SEQ + SEQ - 3 + rr : MP + (st - NBP) * LS + LS - 3 + rr;
        const float v = bf2f(*(const GAS bf16*)(PROJ + (size_t)row * NINP + (col < QKV ? col : C_XL + col - QKV)));
        if (col < QKV) { float* d = st < NBP ? a.out + O_PCD + ((size_t)(l * NBP + st) * 3 + rr) * QKV : a.out + O_SCD + ((size_t)(l * NBS + st - NBP) * 3 + rr) * QKV; *(GAS float*)(d + col) = v; }
        else { float* d = st < NBP ? a.out + O_PCL + ((size_t)(l * NBP + st) * 3 + rr) * DB : a.out + O_SCL + ((size_t)(l * NBS + st - NBP) * 3 + rr) * DB; *(GAS float*)(d + col - QKV) = v; } }
}
DI void final_norm_phase(const Args& a, int gw, int NGW, int lane) {
    const GAS f32x4* wr = (const GAS f32x4*)a.in[24] + lane;
    for (int mb = gw; mb < MR; mb += 2 * NGW) { f32x4 v[2][16];
#pragma unroll
        for (int r = 0; r < 2; ++r) { const int m = mb + r * NGW < MR ? mb + r * NGW : mb; const GAS f32x4* xr = (const GAS f32x4*)(a.out + (size_t)m * D) + lane;
#pragma unroll
            for (int j = 0; j < 16; ++j) v[r][j] = xr[64 * j]; }
#pragma unroll
        for (int r = 0; r < 2; ++r) { const int m = mb + r * NGW; float s = 0.f;
#pragma unroll
            for (int j = 0; j < 16; ++j) s += (v[r][j].x * v[r][j].x + v[r][j].y * v[r][j].y) + (v[r][j].z * v[r][j].z + v[r][j].w * v[r][j].w);
            const float rstd = rsqrtf(wave_sum(s) * (1.f / D) + EPS);
            if (m < MR) { GAS f32x4* xo = (GAS f32x4*)(a.out + (size_t)m * D) + lane;
#pragma unroll
                for (int j = 0; j < 16; ++j) xo[64 * j] = v[r][j] * rstd * wr[64 * j]; } } }
}
constexpr int TG_A = 0, TG_B = 34816, TG_BUF = 52224;
static_assert(2 * TG_BUF <= LDSCTL_OFF && 4 * 8704 * 4 <= LDSCTL_OFF, "thin GEMM LDS");
template <class F> DI void thin_gemm_unit(const bf16* A, int lda, int a_blk, int arow0, const bf16* Bt, int ldb, int b_blk, int brow0, int kslab, LAS unsigned char* lds, int tid, F&& epi) {
    asm volatile("" : "+v"(tid)); const int lane = tid & 63, wave = __builtin_amdgcn_readfirstlane(tid >> 6), fr = lane & 15, fq = lane >> 4, wm = wave >> 2, ks = wave & 3;
    const int nchunk = kslab >> 7, koff = (int)(blockIdx.x >> 3) & (nchunk - 1);
    const bf16* ga[4]; const bf16* gb[2]; unsigned da[4], db[2];
#pragma unroll
    for (int i = 0; i < 4; ++i) { const int row = 16 * wave + 4 * i + fq; ga[i] = a_blk ? A + (size_t)(fr >> 3) * 16384 + (size_t)(arow0 + row) * 64 + 8 * (fr & 7) : A + (size_t)row * lda + 8 * fr; da[i] = (unsigned)(TG_A + row * 272 + 16 * fr); }
#pragma unroll
    for (int i = 0; i < 2; ++i) { const int row = 8 * wave + 4 * i + fq; gb[i] = b_blk ? Bt + (size_t)(fr >> 3) * 16384 + (size_t)(brow0 + row) * 64 + 8 * (fr & 7) : Bt + (size_t)row * ldb + 8 * fr; db[i] = (unsigned)(TG_B + row * 272 + 16 * fr); }
    const size_t astep = a_blk ? 32768 : 128, bstep = b_blk ? 32768 : 128;
    v4u buf[4][6];
#define TG_ISSUE(q, ch) do { const int c_ = (((ch) < nchunk ? (ch) : nchunk - 1) + koff) & (nchunk - 1); \
        _Pragma("unroll") for (int i = 0; i < 4; ++i) buf[q][i] = *(const GAS v4u*)(ga[i] + c_ * astep); _Pragma("unroll") for (int i = 0; i < 2; ++i) buf[q][4 + i] = *(const GAS v4u*)(gb[i] + c_ * bstep); } while (0)
#define TG_WRITE(q, b) do { _Pragma("unroll") for (int i = 0; i < 4; ++i) *(LAS v4u*)(lds + (b) * TG_BUF + da[i]) = buf[q][i]; _Pragma("unroll") for (int i = 0; i < 2; ++i) *(LAS v4u*)(lds + (b) * TG_BUF + db[i]) = buf[q][4 + i]; } while (0)
    f32x4 acc[4][4];
#pragma unroll
    for (int mi = 0; mi < 4; ++mi)
#pragma unroll
        for (int ni = 0; ni < 4; ++ni) acc[mi][ni] = (f32x4){0.f, 0.f, 0.f, 0.f};
#define TG_FENCE() asm volatile("" ::: "memory")
#define TG_SYNC() do { asm volatile("s_waitcnt lgkmcnt(0)" ::: "memory"); __builtin_amdgcn_s_barrier(); asm volatile("" ::: "memory"); } while (0)
    TG_ISSUE(0, 0); TG_FENCE(); TG_ISSUE(1, 1); TG_FENCE(); TG_ISSUE(2, 2); TG_FENCE(); TG_ISSUE(3, 3); TG_FENCE();
    TG_WRITE(0, 0); TG_FENCE(); TG_ISSUE(0, 4); TG_FENCE(); TG_SYNC();
    for (int t = 0; t < nchunk; t += 4) {
#pragma unroll
        for (int q = 0; q < 4; ++q) {
            TG_WRITE((q + 1) & 3, (q + 1) & 1);
            TG_FENCE(); TG_ISSUE((q + 1) & 3, t + q + 5); TG_FENCE();
            const LAS unsigned char* sb = lds + (q & 1) * TG_BUF;
            bf16x8 af[4], bfr[4];
#pragma unroll
            for (int mi = 0; mi < 4; ++mi) af[mi] = *(const LAS bf16x8*)(sb + TG_A + (64 * wm + 16 * mi + fr) * 272 + 16 * fq + 64 * ks);
#pragma unroll
            for (int ni = 0; ni < 4; ++ni) bfr[ni] = *(const LAS bf16x8*)(sb + TG_B + (16 * ni + fr) * 272 + 16 * fq + 64 * ks);
#pragma unroll
            for (int mi = 0; mi < 4; ++mi)
#pragma unroll
                for (int ni = 0; ni < 4; ++ni) acc[mi][ni] = MFMA16(af[mi], bfr[ni], acc[mi][ni]);
            TG_SYNC();
        }
    }
#undef TG_ISSUE
#undef TG_FENCE
#undef TG_WRITE
#undef TG_SYNC
    asm volatile("s_waitcnt vmcnt(0) lgkmcnt(0)" ::: "memory"); __builtin_amdgcn_s_barrier(); asm volatile("" ::: "memory");
    LAS float* R = (LAS float*)lds;
#pragma unroll
    for (int mi = 0; mi < 4; ++mi)
#pragma unroll
        for (int ni = 0; ni < 4; ++ni)
#pragma unroll
            for (int r = 0; r < 4; ++r) R[ks * 8704 + (64 * wm + 16 * mi + 4 * fq + r) * 68 + 16 * ni + fr] = acc[mi][ni][r];
    __syncthreads();
    { const int row = tid >> 2, col0 = (tid & 3) * 16; f32x4 v[4];
#pragma unroll
      for (int k = 0; k < 4; ++k) { const LAS float* rp = R + row * 68 + col0 + 4 * k; v[k] = (*(const LAS f32x4*)(rp) + *(const LAS f32x4*)(rp + 8704)) + (*(const LAS f32x4*)(rp + 2 * 8704) + *(const LAS f32x4*)(rp + 3 * 8704)); }
      epi(row, col0, v); }
    __syncthreads();
}
constexpr int N_PHASES = 19;
__global__ void __launch_bounds__(NTHR, 2) fwd(Args a) {
    extern __shared__ __attribute__((aligned(16))) unsigned char lds_raw[];
    LAS unsigned char* lds = (LAS unsigned char*)lds_raw;
    const int tid0 = threadIdx.x;
    const int G = gridDim.x, c = blockIdx.x, NGW = G * NWAVES;
#define FRESH() int tid = tid0; asm volatile("" : "+v"(tid)); const int lane = tid & 63, wave = __builtin_amdgcn_readfirstlane(tid >> 6), gw = c * NWAVES + wave; (void)lane; (void)gw
    const int lo = a.ph_lo, hi = a.ph_hi;
    for (int u = tid0; u < (LDS_BYTES - LDSCTL_OFF) / 4; u += NTHR) ((LAS unsigned*)(lds + LDSCTL_OFF))[u] = 0u;
    __syncthreads();
    const bool use_bar = (hi - lo) > 1;
    XcdBarrier bar; bar.bar = (unsigned*)(a.ws + WS_CTL) + CW_BAR; bar.x = 0; bar.st = nullptr;
    if (use_bar) bar = xcd_barrier_post((unsigned*)(a.ws + WS_CTL) + CW_BAR, (volatile LAS unsigned*)(lds + MISC_OFF) + 8);
#define IN(k) (lo <= (k) && (k) < hi)
#define SEAM(k) do { if (IN(k) && IN((k) + 1)) xcd_barrier(bar); } while (0)
    float* X = a.out;
    float* RSA = (float*)(a.ws + WS_RSA); float* RSB = (float*)(a.ws + WS_RSB);
    bf16* XN = (bf16*)(a.ws + WS_XN); bf16* PROJ = (bf16*)(a.ws + WS_PROJ); bf16* MIX = (bf16*)(a.ws + WS_MIX); bf16* HID = (bf16*)(a.ws + WS_HID);
    float* PART = (float*)(a.ws + WS_PROJ);
    bf16* WIN = (bf16*)(a.ws + WS_WIN); bf16* WOUT = (bf16*)(a.ws + WS_WOUT); bf16* WUP = (bf16*)(a.ws + WS_WUP); bf16* WDN = (bf16*)(a.ws + WS_WDN);
    { constexpr int l = 0; constexpr int ph = 9 * l;
        if (IN(ph + 0)) { FRESH(); p0_weights(a, l, lds, gw, NGW, wave, lane);
            norm_phase(a.in[0], a.in[1], X, l == 0, a.in[6] + (size_t)l * D, XN, gw, NGW, lane); }
        SEAM(ph + 0);
        if (IN(ph + 1)) { FRESH(); pg8::Gemm g{XN, WIN, MPAD, NINP, D, 0, 1}; pg8::StaticOrder S; S.init(MPAD, NINP, G, c); pg8::EpiBf16<0> E{PROJ, NINP, 0, 0};
            pg8::gemm_phase<pg8::EpiBf16<0>, pg8::StaticOrder, true, true>(lds, g, S, E, tid);
            if (c >= 113) { LAS float* scr = (LAS float*)(lds + wave * 16384);
                convert_range(a, l, CV_SPLIT + (c - 113) * NWAVES + wave, CV_ITEMS, (G - 113) * NWAVES, scr, lane); } }
        SEAM(ph + 1);
        if (IN(ph + 2)) {
            { v2u xraw[19]; unsigned sraw = 0u; DInv inv; delta_inv_load(a, l, c & 15, tid0, inv); delta_issue(a, c, tid0, xraw, sraw);
              for (int u = c; u < NUNIT; u += G) delta_prepass_unit(a, l, u, u + G < NUNIT ? u + G : u, lds, tid0, xraw, sraw, inv); }
            { v2u xraw[7]; LInv inv; lru_inv_load(a, l, (G - 1 - c) & 15, tid0, inv); lru_issue(a, G - 1 - c, tid0, xraw);
              for (int u = (G - 1 - c); u < NUNIT; u += G) lru_prepass_unit(a, l, u, u + G < NUNIT ? u + G : u, lds, tid0, xraw, inv); }
        }
        SEAM(ph + 2);
        if (IN(ph + 3)) { FRESH(); seq_phase(a, l, c, lds, wave, lane); }
        SEAM(ph + 3);
        if (IN(ph + 4)) { { PostRaw raw; f32x4 wnd[4]; for (int q = 0; q < 4; ++q) wnd[q] = *(const GAS f32x4*)(a.in[11] + (size_t)l * 128 + 16 * (tid0 & 7) + 4 * q);
            delta_post_issue(a, c, tid0, raw); for (int u = c; u < NUNIT; u += G) delta_post_unit(a, l, u, u + G < NUNIT ? u + G : u, lds, tid0, raw, wnd); } FRESH(); post_phase(a, l, gw, NGW, lane); }
        SEAM(ph + 4);
        if (IN(ph + 5)) { FRESH(); pg8::Gemm g{MIX, WOUT, MP, D, D, 0, 1}; pg8::StaticOrder S; S.init(MP, D, G, c); pg8::EpiResid<true> E{l == 0 ? a.in[0] : X, X, D, XN, nullptr, 0.f, 0.f};
            pg8::gemm_phase<pg8::EpiResid<true>, pg8::StaticOrder, true, true>(lds, g, S, E, tid);
            if (l == 0 && (c & 3) != 0) { LAS float* scr = (LAS float*)(lds + wave * 16384);
                convert_range(a, 1, ((c >> 2) * 3 + (c & 3) - 1) * NWAVES + wave, I_IN + I_G, 192 * NWAVES, scr, lane); }
            if ((c & 3) == 0) { const int j = c >> 2;
                thin_gemm_unit(MIX + (size_t)MP * D, D, 0, 0, WOUT + (size_t)(j >> 2) * (D / 64) * 16384, 0, 1, (j & 3) * 64, D, lds, tid0, [&](int row, int col0, const f32x4 (&v)[4]) {
                    GAS f32x4* d = (GAS f32x4*)(X + (size_t)(MP + row) * D + 64 * j + col0); const GAS f32x4* bs = l == 0 ? (const GAS f32x4*)(a.in[1] + (size_t)row * D + 64 * j + col0) : (const GAS f32x4*)d;
                    f32x4 x[4];
                    for (int q = 0; q < 4; ++q) { x[q] = bs[q] + v[q]; d[q] = x[q]; }
                    v4u o0, o1; o0.x = pk2(x[0].x, x[0].y); o0.y = pk2(x[0].z, x[0].w); o0.z = pk2(x[1].x, x[1].y); o0.w = pk2(x[1].z, x[1].w); o1.x = pk2(x[2].x, x[2].y); o1.y = pk2(x[2].z, x[2].w); o1.z = pk2(x[3].x, x[3].y); o1.w = pk2(x[3].z, x[3].w);
                    GAS v4u* xb = (GAS v4u*)(XN + (size_t)(MP + row) * D + 64 * j + col0); xb[0] = o0; xb[1] = o1; }); } }
        SEAM(ph + 5);
        if (IN(ph + 7)) { FRESH(); rowss_phase(XN, RSB, 0, MR, gw, NGW, lane);
            pg8::Gemm g{XN, WUP, MP, DFF, D, 0, 1}; pg8::StaticOrder S; S.init(MP, DFF, G, c); pg8::EpiBf16<1> E{HID, DFF, DFF / 64, 1};
            pg8::gemm_phase<pg8::EpiBf16<1>, pg8::StaticOrder, true, true>(lds, g, S, E, tid);
            for (int j = c; j < DFF / 64; j += G)
                thin_gemm_unit(XN + (size_t)MP * D, D, 0, 0, WUP + (size_t)(j >> 2) * (D / 64) * 16384, 0, 1, (j & 3) * 64, D, lds, tid0, [&](int row, int col0, const f32x4 (&v)[4]) {
                    float r[16];
                    for (int q = 0; q < 4; ++q) for (int e = 0; e < 4; ++e) { const float t = fmaxf(v[q][e], 0.f); r[4 * q + e] = t * t; }
                    v4u o0, o1; o0.x = pk2(r[0], r[1]); o0.y = pk2(r[2], r[3]); o0.z = pk2(r[4], r[5]); o0.w = pk2(r[6], r[7]); o1.x = pk2(r[8], r[9]); o1.y = pk2(r[10], r[11]); o1.z = pk2(r[12], r[13]); o1.w = pk2(r[14], r[15]);
                    GAS v4u* d = (GAS v4u*)(HID + ((size_t)(MP / 256) * (DFF / 64) + j) * 16384 + (size_t)row * 64 + col0); d[0] = o0; d[1] = o1; }); }
        SEAM(ph + 7);
        if (IN(ph + 8)) { FRESH(); pg8::Gemm g{HID, WDN, MP, D, DFF, 1, 1};     pg8::DownOrder S; S.init(c);
            { pg8::EpiResid<false> E{X, X, D, nullptr, RSB, 1.f / D, EPS}; pg8::gemm_phase<pg8::EpiResid<false>, pg8::DownOrder, true, true>(lds, g, S, E, tid); }
            for (int uu = c; uu < 256; uu += G) { const int j = uu >> 2, ks = uu & 3;
                thin_gemm_unit(HID + ((size_t)(MP / 256) * (DFF / 64) + ks * 64) * 16384, 0, 1, 0, WDN + ((size_t)(j >> 2) * (DFF / 64) + ks * 64) * 16384, 0, 1, (j & 3) * 64, 4096, lds, tid0, [&](int row, int col0, const f32x4 (&v)[4]) {
                    GAS f32x4* d = (GAS f32x4*)(PART + ((size_t)ks * MS + row) * D + 64 * j + col0);
                    for (int q = 0; q < 4; ++q) d[q] = v[q]; }); }
            if (use_bar) xcd_barrier(bar);
            if (gw < MS) { const int row = gw; const float sc = __builtin_amdgcn_rcpf(*(const GAS float*)(RSB + MP + row) * (1.f / D) + EPS);
                GAS f32x4* xr = (GAS f32x4*)(X + (size_t)(MP + row) * D) + lane;
                for (int jb = 0; jb < 16; jb += 4) { f32x4 x[4], pp[4][4];
#pragma unroll
                    for (int jj = 0; jj < 4; ++jj) { x[jj] = xr[64 * (jb + jj)];
#pragma unroll
                        for (int k4 = 0; k4 < 4; ++k4) pp[k4][jj] = ((const GAS f32x4*)(PART + ((size_t)k4 * MS + row) * D) + lane)[64 * (jb + jj)]; }
#pragma unroll
                    for (int jj = 0; jj < 4; ++jj) xr[64 * (jb + jj)] = x[jj] + ((pp[0][jj] + pp[1][jj]) + (pp[2][jj] + pp[3][jj])) * sc; } } }
        SEAM(ph + 8);
    }
    { constexpr int l = 1; constexpr int ph = 9 * l;
        if (IN(ph + 0)) { FRESH(); p0_weights(a, l, lds, gw, NGW, wave, lane);
            norm_phase(a.in[0], a.in[1], X, l == 0, a.in[6] + (size_t)l * D, XN, gw, NGW, lane); }
        SEAM(ph + 0);
        if (IN(ph + 1)) { FRESH(); pg8::Gemm g{XN, WIN, MPAD, NINP, D, 0, 1}; pg8::StaticOrder S; S.init(MPAD, NINP, G, c); pg8::EpiBf16<0> E{PROJ, NINP, 0, 0};
            pg8::gemm_phase<pg8::EpiBf16<0>, pg8::StaticOrder, true, true>(lds, g, S, E, tid);
            if (c >= 113) { LAS float* scr = (LAS float*)(lds + wave * 16384);
                convert_range(a, l, CV_SPLIT + (c - 113) * NWAVES + wave, CV_ITEMS, (G - 113) * NWAVES, scr, lane); } }
        SEAM(ph + 1);
        if (IN(ph + 2)) {
            { v2u xraw[19]; unsigned sraw = 0u; DInv inv; delta_inv_load(a, l, c & 15, tid0, inv); delta_issue(a, c, tid0, xraw, sraw);
              for (int u = c; u < NUNIT; u += G) delta_prepass_unit(a, l, u, u + G < NUNIT ? u + G : u, lds, tid0, xraw, sraw, inv); }
            { v2u xraw[7]; LInv inv; lru_inv_load(a, l, (G - 1 - c) & 15, tid0, inv); lru_issue(a, G - 1 - c, tid0, xraw);
              for (int u = (G - 1 - c); u < NUNIT; u += G) lru_prepass_unit(a, l, u, u + G < NUNIT ? u + G : u, lds, tid0, xraw, inv); }
        }
        SEAM(ph + 2);
        if (IN(ph + 3)) { FRESH(); seq_phase(a, l, c, lds, wave, lane); }
        SEAM(ph + 3);
        if (IN(ph + 4)) { { PostRaw raw; f32x4 wnd[4]; for (int q = 0; q < 4; ++q) wnd[q] = *(const GAS f32x4*)(a.in[11] + (size_t)l * 128 + 16 * (tid0 & 7) + 4 * q);
            delta_post_issue(a, c, tid0, raw); for (int u = c; u < NUNIT; u += G) delta_post_unit(a, l, u, u + G < NUNIT ? u + G : u, lds, tid0, raw, wnd); } FRESH(); post_phase(a, l, gw, NGW, lane); }
        SEAM(ph + 4);
        if (IN(ph + 5)) { FRESH(); pg8::Gemm g{MIX, WOUT, MP, D, D, 0, 1}; pg8::StaticOrder S; S.init(MP, D, G, c); pg8::EpiResid<true> E{l == 0 ? a.in[0] : X, X, D, XN, nullptr, 0.f, 0.f};
            pg8::gemm_phase<pg8::EpiResid<true>, pg8::StaticOrder, true, true>(lds, g, S, E, tid);
            if ((c & 3) == 0) { const int j = c >> 2;
                thin_gemm_unit(MIX + (size_t)MP * D, D, 0, 0, WOUT + (size_t)(j >> 2) * (D / 64) * 16384, 0, 1, (j & 3) * 64, D, lds, tid0, [&](int row, int col0, const f32x4 (&v)[4]) {
                    GAS f32x4* d = (GAS f32x4*)(X + (size_t)(MP + row) * D + 64 * j + col0); const GAS f32x4* bs = l == 0 ? (const GAS f32x4*)(a.in[1] + (size_t)row * D + 64 * j + col0) : (const GAS f32x4*)d;
                    f32x4 x[4];
                    for (int q = 0; q < 4; ++q) { x[q] = bs[q] + v[q]; d[q] = x[q]; }
                    v4u o0, o1; o0.x = pk2(x[0].x, x[0].y); o0.y = pk2(x[0].z, x[0].w); o0.z = pk2(x[1].x, x[1].y); o0.w = pk2(x[1].z, x[1].w); o1.x = pk2(x[2].x, x[2].y); o1.y = pk2(x[2].z, x[2].w); o1.z = pk2(x[3].x, x[3].y); o1.w = pk2(x[3].z, x[3].w);
                    GAS v4u* xb = (GAS v4u*)(XN + (size_t)(MP + row) * D + 64 * j + col0); xb[0] = o0; xb[1] = o1; }); } }
        SEAM(ph + 5);
        if (IN(ph + 7)) { FRESH(); rowss_phase(XN, RSB, 0, MR, gw, NGW, lane);
            pg8::Gemm g{XN, WUP, MP, DFF, D, 0, 1}; pg8::StaticOrder S; S.init(MP, DFF, G, c); pg8::EpiBf16<1> E{HID, DFF, DFF / 64, 1};
            pg8::gemm_phase<pg8::EpiBf16<1>, pg8::StaticOrder, true, true>(lds, g, S, E, tid);
            for (int j = c; j < DFF / 64; j += G)
                thin_gemm_unit(XN + (size_t)MP * D, D, 0, 0, WUP + (size_t)(j >> 2) * (D / 64) * 16384, 0, 1, (j & 3) * 64, D, lds, tid0, [&](int row, int col0, const f32x4 (&v)[4]) {
                    float r[16];
                    for (int q = 0; q < 4; ++q) for (int e = 0; e < 4; ++e) { const float t = fmaxf(v[q][e], 0.f); r[4 * q + e] = t * t; }
                    v4u o0, o1; o0.x = pk2(r[0], r[1]); o0.y = pk2(r[2], r[3]); o0.z = pk2(r[4], r[5]); o0.w = pk2(r[6], r[7]); o1.x = pk2(r[8], r[9]); o1.y = pk2(r[10], r[11]); o1.z = pk2(r[12], r[13]); o1.w = pk2(r[14], r[15]);
                    GAS v4u* d = (GAS v4u*)(HID + ((size_t)(MP / 256) * (DFF / 64) + j) * 16384 + (size_t)row * 64 + col0); d[0] = o0; d[1] = o1; }); }
        SEAM(ph + 7);
        if (IN(ph + 8)) { FRESH(); pg8::Gemm g{HID, WDN, MP, D, DFF, 1, 1};     pg8::DownOrder S; S.init(c);
            { pg8::EpiResid<false> E{X, X, D, nullptr, RSB, 1.f / D, EPS}; pg8::gemm_phase<pg8::EpiResid<false>, pg8::DownOrder, true, true>(lds, g, S, E, tid); }
            for (int uu = c; uu < 256; uu += G) { const int j = uu >> 2, ks = uu & 3;
                thin_gemm_unit(HID + ((size_t)(MP / 256) * (DFF / 64) + ks * 64) * 16384, 0, 1, 0, WDN + ((size_t)(j >> 2) * (DFF / 64) + ks * 64) * 16384, 0, 1, (j & 3) * 64, 4096, lds, tid0, [&](int row, int col0, const f32x4 (&v)[4]) {
                    GAS f32x4* d = (GAS f32x4*)(PART + ((size_t)ks * MS + row) * D + 64 * j + col0);
                    for (int q = 0; q < 4; ++q) d[q] = v[q]; }); }
            if (use_bar) xcd_barrier(bar);
            if (gw < MS) { const int row = gw; const float sc = __builtin_amdgcn_rcpf(*(const GAS float*)(RSB + MP + row) * (1.f / D) + EPS);
                GAS f32x4* xr = (GAS f32x4*)(X + (size_t)(MP + row) * D) + lane;
                for (int jb = 0; jb < 16; jb += 4) { f32x4 x[4], pp[4][4];
#pragma unroll
                    for (int jj = 0; jj < 4; ++jj) { x[jj] = xr[64 * (jb + jj)];
#pragma unroll
                        for (int k4 = 0; k4 < 4; ++k4) pp[k4][jj] = ((const GAS f32x4*)(PART + ((size_t)k4 * MS + row) * D) + lane)[64 * (jb + jj)]; }
#pragma unroll
                    for (int jj = 0; jj < 4; ++jj) xr[64 * (jb + jj)] = x[jj] + ((pp[0][jj] + pp[1][jj]) + (pp[2][jj] + pp[3][jj])) * sc; } } }
        SEAM(ph + 8);
    }
    if (IN(18)) { FRESH(); final_norm_phase(a, gw, NGW, lane); }
#undef IN
#undef SEAM
}

#ifndef PROBE_PH
#define PROBE_PH -1
#endif
#ifndef MK_SPLIT
#define MK_SPLIT 0
#endif
extern "C" void kernel_launch(void* const* d_in, const int* in_sizes, int n_in, void* d_out, int out_size, void* d_ws, size_t ws_size, hipStream_t stream) {
    static int grid = 0;
    if (grid == 0) {
        if (n_in != 25 || (size_t)out_size != O_END || ws_size < WS_END) { fprintf(stderr, "kernel_launch: unexpected sizes n_in %d out %d ws %zu (need %zu)\n", n_in, out_size, ws_size, (size_t)WS_END); grid = -1; return; }
        int dev = 0, cus = 0, per_cu = 0;
        if (hipGetDevice(&dev) != hipSuccess || hipDeviceGetAttribute(&cus, hipDeviceAttributeMultiprocessorCount, dev) != hipSuccess) { grid = -1; return; }
        if (hipFuncSetAttribute((const void*)fwd, hipFuncAttributeMaxDynamicSharedMemorySize, LDS_BYTES) != hipSuccess) { fprintf(stderr, "kernel_launch: hipFuncSetAttribute failed\n"); grid = -1; return; }
        if (hipOccupancyMaxActiveBlocksPerMultiprocessor(&per_cu, (const void*)fwd, NTHR, LDS_BYTES) != hipSuccess || per_cu < 1) fprintf(stderr, "kernel_launch: occupancy query reports %d\n", per_cu);
        (void)hipGetLastError();
        if (cus != 256) { fprintf(stderr, "kernel_launch: built for a 256-CU device (one workgroup per CU), found %d\n", cus); grid = -1; return; }
        grid = cus;
    }
    if (grid < 0) return;
    if (hipMemsetAsync((char*)d_ws + WS_CTL, 0, CTL_ZERO_BYTES, stream) != hipSuccess) return;
    Args a{};
    for (int i = 0; i < 25; ++i) a.in[i] = (const float*)d_in[i];
    a.out = (float*)d_out; a.ws = (unsigned char*)d_ws;
#if MK_SPLIT
    for (int k = 0; k < N_PHASES; ++k) { a.ph_lo = k; a.ph_hi = k + 1; hipLaunchKernelGGL(fwd, dim3(grid), dim3(NTHR), LDS_BYTES, stream, a);
        if (k < 18 && (k % 9) == PROBE_PH) hipLaunchKernelGGL(fwd, dim3(grid), dim3(NTHR), LDS_BYTES, stream, a); }
#else
    a.ph_lo = 0; a.ph_hi = N_PHASES; hipLaunchKernelGGL(fwd, dim3(grid), dim3(NTHR), LDS_BYTES, stream, a);
#endif
}
```

```cpp
#include <hip/hip_runtime.h>
#include <cstdio>
#include <cstdint>
namespace pg8 {
#define PG8_LAS __attribute__((address_space(3)))
typedef unsigned short bf16_t;
typedef short bf16x8 __attribute__((ext_vector_type(8)));
typedef float f32x4 __attribute__((ext_vector_type(4)));
typedef unsigned u32x4 __attribute__((ext_vector_type(4)));
constexpr int BM = 256, BK = 64, HALF = 128, HTB = HALF * BK * 2  , STAGE_BYTES = 8 * HTB, NXCD = 8, WGM = 8;

__host__ __device__ __forceinline__ int lds_byte(int r, int c) { const int st = (r >> 4) * 2 + (c >> 5), rr = r & 15, cc = c & 31, ob = rr * 64 + cc * 2; return st * 1024 + (ob ^ (((ob >> 9) & 1) << 5)); }
__host__ __device__ __forceinline__ void stage_rc(int b, int& R, int& C) { const int st = b / 1024, sb = b % 1024, swz = sb ^ (((sb >> 9) & 1) << 5); R = (st >> 1) * 16 + swz / 64; C = (st & 1) * 32 + (swz % 64) / 2; }
__host__ __device__ __forceinline__ int perm32(int rho) { const int n = rho >> 4, i = rho & 15; return 8 * (i >> 2) + 4 * n + (i & 3); }

struct Unit { int pm, pn; };
struct Gemm { const bf16_t* A; const bf16_t* Bt; int M, N, K; int a_blk, b_blk; };
struct StaticOrder {
    int nM, nN, nwg, G, c;
    __host__ __device__ void init(int M, int N, int G_, int c_) { nM = M / BM; nN = N / BM; nwg = nM * nN; G = G_; c = c_; }
    __host__ __device__ bool next(int i, Unit& u) const {
        const long L = (long)i * G + c; if (L >= nwg) return false;
        int wgid = (int)L; { const int q = nwg / NXCD, r = nwg % NXCD, xcd = wgid % NXCD, off = wgid / NXCD; wgid = (xcd < r ? xcd * (q + 1) : r * (q + 1) + (xcd - r) * q) + off; }
        const int nig = WGM * nN, gid = wgid / nig, fm = gid * WGM, gsz = (nM - fm) < WGM ? (nM - fm) : WGM;
        u.pm = fm + ((wgid % nig) % gsz); u.pn = (wgid % nig) / gsz; return true;
    }
    __device__ __forceinline__ void a_ready(const Unit&) const {}
    __device__ __forceinline__ void done(const Unit&) const {}
};
struct DownOrder {
    int c;
    __host__ __device__ void init(int c_) { c = c_; }
    __host__ __device__ bool next(int i, Unit& u) const { if (i >= 4) return false; const int xcd = c & 7, slot = c >> 3; u.pm = (xcd >> 2) * 32 + 8 * i + (slot & 7); u.pn = 4 * (xcd & 3) + (slot >> 3); return true; }
    __device__ __forceinline__ void a_ready(const Unit&) const {}
    __device__ __forceinline__ void done(const Unit&) const {}
};
typedef float f32x2v_ __attribute__((ext_vector_type(2))); typedef __bf16 bf16x2v_ __attribute__((ext_vector_type(2)));
__device__ __forceinline__ unsigned cvt_pk_bf16(float lo, float hi) { f32x2v_ v = {lo, hi}; bf16x2v_ b = __builtin_convertvector(v, bf16x2v_); return __builtin_bit_cast(unsigned, b); }
template <int ACT  > struct EpiBf16 {
    static constexpr bool PERM = true, AFTER_DRAIN = false;
    bf16_t* O; int ldc; int nkt; int nt;
    __device__ __forceinline__ void operator()(const f32x4 (&acc)[2][2][4][2], const Unit& u, int wr, int wc, int fr, int fq) const {
        const int row0 = u.pm * BM + wr * 64 + fr; const int col0 = u.pn * BM + wc * 32 + 8 * fq;
#pragma unroll
        for (int ai = 0; ai < 2; ++ai)
#pragma unroll
            for (int m = 0; m < 4; ++m) { const int rloc = wr * 64 + fr + ai * HALF + m * 16;
                bf16_t* rowp = nkt ? O + ((size_t)u.pm * nkt + 4 * u.pn + (wc >> 1)) * (BM * BK) + rloc * BK + (wc & 1) * 32 + 8 * fq - (size_t)0 : O + (size_t)(row0 + ai * HALF + m * 16) * ldc + col0;
                const size_t bjstep = nkt ? (size_t)2 * BM * BK : (size_t)HALF;
#pragma unroll
                for (int bj = 0; bj < 2; ++bj) { f32x4 v0 = acc[ai][bj][m][0], v1 = acc[ai][bj][m][1];
                    if (ACT == 1) {
#pragma unroll
                        for (int j = 0; j < 4; ++j) { const float a = fmaxf(v0[j], 0.f), b = fmaxf(v1[j], 0.f); v0[j] = a * a; v1[j] = b * b; } }
                    u32x4 w; w.x = cvt_pk_bf16(v0[0], v0[1]); w.y = cvt_pk_bf16(v0[2], v0[3]); w.z = cvt_pk_bf16(v1[0], v1[1]); w.w = cvt_pk_bf16(v1[2], v1[3]);
                    if (nt) __builtin_nontemporal_store(w, (u32x4*)(rowp + bj * bjstep)); else *(u32x4*)(rowp + bj * bjstep) = w; } }
    }
};
template <bool FUSE> struct EpiResid {
    static constexpr bool PERM = true, AFTER_DRAIN = false;
    const float* B; float* X; int ldc; bf16_t* XB; const float* rss; float inv_n, eps;
    __device__ __forceinline__ void operator()(const f32x4 (&acc)[2][2][4][2], const Unit& u, int wr, int wc, int fr, int fq) const {
        const int row0 = u.pm * BM + wr * 64 + fr, col0 = u.pn * BM + wc * 32 + 8 * fq;
#pragma unroll
        for (int ai = 0; ai < 2; ++ai)
#pragma unroll
            for (int m = 0; m < 4; ++m) { const int row = row0 + ai * HALF + m * 16;
                const float* bp = B + (size_t)row * ldc + col0; float* rowp = X + (size_t)row * ldc + col0;
                const float sc = rss ? __builtin_amdgcn_rcpf(rss[row] * inv_n + eps) : 1.f;
                f32x4 v[2][2];
#pragma unroll
                for (int bj = 0; bj < 2; ++bj)
#pragma unroll
                    for (int n = 0; n < 2; ++n) v[bj][n] = *(const f32x4*)(bp + bj * HALF + n * 4);
#pragma unroll
                for (int bj = 0; bj < 2; ++bj) { const f32x4 x0 = v[bj][0] + acc[ai][bj][m][0] * sc, x1 = v[bj][1] + acc[ai][bj][m][1] * sc;
                    *(f32x4*)(rowp + bj * HALF) = x0; *(f32x4*)(rowp + bj * HALF + 4) = x1;
                    if (FUSE) { u32x4 w; w.x = cvt_pk_bf16(x0[0], x0[1]); w.y = cvt_pk_bf16(x0[2], x0[3]); w.z = cvt_pk_bf16(x1[0], x1[1]); w.w = cvt_pk_bf16(x1[2], x1[3]);
                        *(u32x4*)(XB + (size_t)row * ldc + col0 + bj * HALF) = w; } }
                asm volatile("" ::: "memory"); }
    }
};
template <class Epi, class Sched, bool ALIGN_EPI = false, bool SP2 = false>
__device__ __forceinline__ void gemm_phase(PG8_LAS unsigned char* lds, const Gemm g, const Sched& S, const Epi& E, const int tid) {
    const int wid = __builtin_amdgcn_readfirstlane(tid >> 6), lane = tid & 63, wr = wid >> 2, wc = wid & 3, fr = lane & 15, fq = lane >> 4;
    const int K = g.K, nt = K / BK;
    unsigned voffA[2], voffB[2];
#pragma unroll
    for (int i = 0; i < 2; ++i) { int R, C; stage_rc(tid * 16 + i * 8192, R, C); const int Rb = Epi::PERM ? ((R & ~31) + perm32(R & 31)) : R;
        voffA[i] = (unsigned)(R * (g.a_blk ? BK : K) + C) * 2u; voffB[i] = (unsigned)(Rb * (g.b_blk ? BK : K) + C) * 2u; }
    const size_t kstepA = g.a_blk ? (size_t)BM * BK * 2 : (size_t)(BK * 2), kstepB = g.b_blk ? (size_t)BM * BK * 2 : (size_t)(BK * 2);
    const size_t hstepA = g.a_blk ? (size_t)HALF * BK * 2 : (size_t)HALF * K * 2, hstepB = g.b_blk ? (size_t)HALF * BK * 2 : (size_t)HALF * K * 2;
    const size_t tstep = (size_t)BM * K * 2;
    const unsigned ldsw = (unsigned)wid * 1024u;
    const int aoff = lds_byte(wr * 64 + fr, fq * 8), boff = lds_byte(wc * 32 + fr, fq * 8);
#define PG8_SA(b, h) (((b) * 2 + (h)) * HTB)
#define PG8_SB(b, h) ((4 + (b) * 2 + (h)) * HTB)
#define PG8_STAGE(bufoff, gbase, voff) do { _Pragma("unroll") for (int _i = 0; _i < 2; ++_i) \
        __builtin_amdgcn_global_load_lds((const unsigned*)((const char*)(gbase) + (voff)[_i]), (PG8_LAS unsigned*)(lds + (bufoff) + ldsw + _i * 8192), 16, 0, 0); } while (0)
#define PG8_LDA(dst, b, h) do { _Pragma("unroll") for (int m = 0; m < 4; ++m) _Pragma("unroll") for (int k = 0; k < 2; ++k) dst[m][k] = *(const PG8_LAS bf16x8*)(lds + PG8_SA(b, h) + aoff + m * 2048 + k * 1024); } while (0)
#define PG8_LDB(dst, b, h) do { _Pragma("unroll") for (int n = 0; n < 2; ++n) _Pragma("unroll") for (int k = 0; k < 2; ++k) dst[n][k] = *(const PG8_LAS bf16x8*)(lds + PG8_SB(b, h) + boff + n * 2048 + k * 1024); } while (0)
#define PG8_MMA(ai, bj, At, Bt) do { __builtin_amdgcn_s_setprio(1); _Pragma("unroll") for (int m = 0; m < 4; ++m) _Pragma("unroll") for (int n = 0; n < 2; ++n) _Pragma("unroll") for (int k = 0; k < 2; ++k) \
        acc[ai][bj][m][n] = __builtin_amdgcn_mfma_f32_16x16x32_bf16(Bt[n][k], At[m][k], acc[ai][bj][m][n], 0, 0, 0); __builtin_amdgcn_s_setprio(0); } while (0)
#define PG8_WAIT_V(n) asm volatile("s_waitcnt vmcnt(" #n ")" ::: "memory")
#define PG8_WAIT_L(n) asm volatile("s_waitcnt lgkmcnt(" #n ")" ::: "memory")
#define PG8_BAR __builtin_amdgcn_s_barrier()
#define PG8_SCHED __builtin_amdgcn_sched_barrier(0)
    Unit cur, nxt; int ui = 0;
    if (!S.next(0, cur)) return;
    f32x4 acc[2][2][4][2];
#pragma unroll
    for (int a = 0; a < 2; ++a)
#pragma unroll
        for (int b = 0; b < 2; ++b)
#pragma unroll
            for (int m = 0; m < 4; ++m)
#pragma unroll
                for (int n = 0; n < 2; ++n) acc[a][b][m][n] = (f32x4){0.f, 0.f, 0.f, 0.f};
    bf16x8 At[4][2], B0[2][2], B1[2][2];
    const char* cA = (const char*)g.A + (size_t)cur.pm * tstep; const char* cB = (const char*)g.Bt + (size_t)cur.pn * tstep;
    S.a_ready(cur);
    if constexpr (SP2) {
        PG8_STAGE(PG8_SB(0, 0), cB, voffB); PG8_STAGE(PG8_SB(0, 1), cB + hstepB, voffB); PG8_STAGE(PG8_SA(0, 0), cA, voffA); PG8_STAGE(PG8_SA(0, 1), cA + hstepA, voffA);
        if (wr == 1) PG8_BAR;
        PG8_WAIT_V(2); PG8_BAR;
        PG8_STAGE(PG8_SB(1, 0), cB + kstepB, voffB); PG8_STAGE(PG8_SA(1, 0), cA + kstepA, voffA); PG8_STAGE(PG8_SB(1, 1), cB + hstepB + kstepB, voffB);
        PG8_WAIT_V(6); PG8_BAR;
    } else {
        PG8_STAGE(PG8_SB(0, 0), cB, voffB); PG8_STAGE(PG8_SA(0, 0), cA, voffA); PG8_STAGE(PG8_SB(0, 1), cB + hstepB, voffB); PG8_STAGE(PG8_SA(0, 1), cA + hstepA, voffA);
        if (wr == 1) PG8_BAR;
        PG8_WAIT_V(4); PG8_BAR;
        PG8_STAGE(PG8_SB(1, 0), cB + kstepB, voffB); PG8_STAGE(PG8_SA(1, 0), cA + kstepA, voffA); PG8_STAGE(PG8_SB(1, 1), cB + hstepB + kstepB, voffB);
        PG8_WAIT_V(6); PG8_BAR;
    }
    for (;;) {
        const bool has_next = S.next(ui + 1, nxt);
        const char* nA = has_next ? (const char*)g.A + (size_t)nxt.pm * tstep : cA; const char* nB = has_next ? (const char*)g.Bt + (size_t)nxt.pn * tstep : cB;
        for (int t = 0; t < nt; t += 2) {
            const bool last = (t == nt - 2);
            const char* a1 = cA + (size_t)(t + 1) * kstepA;
            const char* a2 = last ? nA : cA + (size_t)(t + 2) * kstepA; const char* b2 = last ? nB : cB + (size_t)(t + 2) * kstepB;
            const char* a3 = a2 + kstepA; const char* b3 = b2 + kstepB;
            if (last && has_next) S.a_ready(nxt);
            if constexpr (SP2) {
            PG8_LDB(B0, 0, 0); PG8_LDB(B1, 0, 1); PG8_SCHED; PG8_LDA(At, 0, 0); PG8_STAGE(PG8_SA(1, 1), a1 + hstepA, voffA);
            PG8_WAIT_V(8); PG8_WAIT_L(0); PG8_BAR; PG8_MMA(0, 0, At, B0); PG8_MMA(0, 1, At, B1); PG8_BAR; PG8_SCHED;
            PG8_LDA(At, 0, 1); PG8_STAGE(PG8_SB(0, 0), b2, voffB); PG8_STAGE(PG8_SB(0, 1), b2 + hstepB, voffB); PG8_STAGE(PG8_SA(0, 0), a2, voffA);
            PG8_WAIT_V(8); PG8_WAIT_L(0); PG8_BAR; PG8_MMA(1, 0, At, B0); PG8_MMA(1, 1, At, B1); PG8_BAR; PG8_SCHED;
            PG8_LDB(B0, 1, 0); PG8_LDB(B1, 1, 1); PG8_SCHED; PG8_LDA(At, 1, 0); PG8_STAGE(PG8_SA(0, 1), a2 + hstepA, voffA);
            PG8_WAIT_V(8); PG8_WAIT_L(0); PG8_BAR; PG8_MMA(0, 0, At, B0); PG8_MMA(0, 1, At, B1); PG8_BAR; PG8_SCHED;
            PG8_LDA(At, 1, 1); PG8_STAGE(PG8_SB(1, 0), b3, voffB); PG8_STAGE(PG8_SB(1, 1), b3 + hstepB, voffB); PG8_STAGE(PG8_SA(1, 0), a3, voffA);
            PG8_WAIT_V(8); PG8_WAIT_L(0); PG8_BAR; PG8_MMA(1, 0, At, B0); PG8_MMA(1, 1, At, B1); PG8_BAR; PG8_SCHED;
            } else {
            PG8_LDB(B0, 0, 0); PG8_SCHED; PG8_LDA(At, 0, 0); PG8_STAGE(PG8_SA(1, 1), a1 + hstepA, voffA);
            PG8_WAIT_L(8); PG8_BAR; PG8_WAIT_L(0); PG8_MMA(0, 0, At, B0); PG8_BAR; PG8_SCHED;
            PG8_LDB(B1, 0, 1); PG8_STAGE(PG8_SB(0, 0), b2, voffB);
            PG8_BAR; PG8_WAIT_L(0); PG8_MMA(0, 1, At, B1); PG8_BAR;
            PG8_LDA(At, 0, 1); PG8_STAGE(PG8_SA(0, 0), a2, voffA);
            PG8_BAR; PG8_WAIT_L(0); PG8_MMA(1, 0, At, B0); PG8_BAR; PG8_SCHED;
            PG8_STAGE(PG8_SB(0, 1), b2 + hstepB, voffB);
            PG8_WAIT_V(6); PG8_BAR; PG8_MMA(1, 1, At, B1); PG8_BAR;
            PG8_LDB(B0, 1, 0); PG8_SCHED; PG8_LDA(At, 1, 0); PG8_STAGE(PG8_SA(0, 1), a2 + hstepA, voffA);
            PG8_WAIT_L(8); PG8_BAR; PG8_WAIT_L(0); PG8_MMA(0, 0, At, B0); PG8_BAR; PG8_SCHED;
            PG8_LDB(B1, 1, 1); PG8_STAGE(PG8_SB(1, 0), b3, voffB);
            PG8_BAR; PG8_WAIT_L(0); PG8_MMA(0, 1, At, B1); PG8_BAR;
            PG8_LDA(At, 1, 1); PG8_STAGE(PG8_SA(1, 0), a3, voffA);
            PG8_BAR; PG8_WAIT_L(0); PG8_MMA(1, 0, At, B0); PG8_BAR; PG8_SCHED;
            PG8_STAGE(PG8_SB(1, 1), b3 + hstepB, voffB);
            PG8_WAIT_V(6); PG8_BAR; PG8_MMA(1, 1, At, B1); PG8_BAR;
            }
        }
        if constexpr (ALIGN_EPI) { if (wr == 0) PG8_BAR; }
        if constexpr (!Epi::AFTER_DRAIN) { E(acc, cur, wr, wc, fr, fq); S.done(cur); }
        if (!has_next) break;
#pragma unroll
        for (int a = 0; a < 2; ++a)
#pragma unroll
            for (int b = 0; b < 2; ++b)
#pragma unroll
                for (int m = 0; m < 4; ++m)
#pragma unroll
                    for (int n = 0; n < 2; ++n) acc[a][b][m][n] = (f32x4){0.f, 0.f, 0.f, 0.f};
        cur = nxt; cA = nA; cB = nB; ++ui;
        if constexpr (ALIGN_EPI) { if (wr == 1) PG8_BAR; }
    }
    PG8_WAIT_V(0);
    if constexpr (!ALIGN_EPI) { if (wr == 0) PG8_BAR; }
    PG8_BAR;
    if constexpr (Epi::AFTER_DRAIN) { E.fused(acc, cur, wr, wc, fr, fq, lds, wid, lane); S.done(cur); }
#undef PG8_SA
#undef PG8_SB
#undef PG8_STAGE
#undef PG8_LDA
#undef PG8_LDB
#undef PG8_MMA
#undef PG8_WAIT_V
#undef PG8_WAIT_L
#undef PG8_BAR
#undef PG8_SCHED
}
}
constexpr int D = 4096, MP = 16384, MS = 128, MR = MP + MS, MPAD = 16640;
constexpr int SEQ = 8192, NBP = 2, NBS = 8, LS = 16, NCH = SEQ / 64;
constexpr int DA = 2048, DB = 2048, NH = 16, DFF = 16384, QKV = 6144;
constexpr int NIN = 12320, NINP = 12544;
constexpr int C_Q = 0, C_K = 2048, C_V = 4096, C_Z = 6144, C_XL = 8192, C_YL = 10240, C_BL = 12288, C_AL = 12304;
constexpr float EPS = 1e-6f;
constexpr int NWAVES = 8, NTHR = 512;
constexpr int NUNIT_P = 4096, NUNIT = 4224;
constexpr size_t O_YP = 0, O_YS = O_YP + (size_t)MP * D, O_PD = O_YS + (size_t)MS * D, O_PCD = O_PD + (size_t)2 * NBP * NH * 128 * 128, O_PL = O_PCD + (size_t)2 * NBP * 3 * QKV,
    O_PCL = O_PL + (size_t)2 * NBP * DB, O_SD = O_PCL + (size_t)2 * NBP * 3 * DB, O_SCD = O_SD + (size_t)2 * NBS * NH * 128 * 128, O_SL = O_SCD + (size_t)2 * NBS * 3 * QKV,
    O_SCL = O_SL + (size_t)2 * NBS * DB, O_END = O_SCL + (size_t)2 * NBS * 3 * DB;
static_assert(O_END == 73408512, "d_out map");
constexpr size_t AL(size_t x) { return (x + 4095) & ~(size_t)4095; }
constexpr size_t WS_CTL = 0, CTL_ZERO_BYTES = 1u << 20;
constexpr size_t WS_WIN = CTL_ZERO_BYTES, WS_WOUT = WS_WIN + AL((size_t)NINP * D * 2), WS_WUP = WS_WOUT + AL((size_t)D * D * 2), WS_WDN = WS_WUP + AL((size_t)DFF * D * 2),
    WS_WG = WS_WDN + AL((size_t)D * DFF * 2), WS_XN = WS_WG + AL((size_t)2 * NH * 128 * 128 * 2), WS_PROJ = WS_XN + AL((size_t)MPAD * D * 2), WS_MIX = WS_PROJ + AL((size_t)MPAD * NINP * 2),
    WS_HIN = WS_MIX + AL((size_t)MPAD * D * 2), WS_OV = WS_HIN + AL((size_t)2 * NBP * NCH * DB * 4);
constexpr size_t DF_MP = 0, DF_BN = 32768, DF_QE = 65536, DF_OU = 81920, DF_GL = 98304, DF_STRIDE = 98560;
constexpr size_t WS_DF = WS_OV, WS_SST = WS_DF + AL((size_t)NUNIT * DF_STRIDE), WS_HLOC = WS_SST + AL((size_t)NUNIT * 32768), WS_CUM = WS_HLOC + AL((size_t)MR * DB * 2), WS_CHK = WS_CUM + AL((size_t)MR * DB * 2), WS_END1 = WS_CHK + AL((size_t)NUNIT * 1024);
constexpr size_t WS_HID = WS_OV, WS_END2 = WS_HID + AL((size_t)MPAD * DFF * 2);
constexpr size_t WS_END = WS_END1 > WS_END2 ? WS_END1 : WS_END2;
static_assert(WS_END <= 2147483648ull, "d_ws map");
constexpr int CW_BAR = 4096;
constexpr size_t WS_RSA = WS_CTL + 65536, WS_RSB = WS_RSA + 131072;
static_assert(WS_RSB + 131072 <= CTL_ZERO_BYTES && (size_t)MPAD * 4 <= 131072, "row-sum arrays");
constexpr int RING_BYTES = 131072, LDSCTL_OFF = 139264, MISC_OFF = LDSCTL_OFF + 320, LDS_BYTES = 147456;
constexpr int L_QN = 0, L_KN = 17408, L_KT = 34816, L_VT = 53248, L_KK = 71680, L_QKT = 89088, L_TU = 105472, L_TW = 114688, L_SC = 123904, L_QKF = 124928;
constexpr int L_XCB = 0, L_XCF = 17408, L_AS = L_XCF + 33792, L_BS = L_AS + 33792, L_SEG = L_BS + 33792;
constexpr int L_OL = 0;
constexpr int SQ_SLOT = 40960 + 256, L_SQ = 0;
static_assert(L_SEG + 8192 <= LDSCTL_OFF && L_QKF + 8192 <= LDSCTL_OFF && 2 * SQ_SLOT <= LDSCTL_OFF, "LDS map");

#define GAS __attribute__((address_space(1)))
#define LAS __attribute__((address_space(3)))
#define DI __device__ __forceinline__
typedef unsigned short bf16;
typedef unsigned v4u __attribute__((ext_vector_type(4)));
typedef unsigned v2u __attribute__((ext_vector_type(2)));
typedef float f32x4 __attribute__((ext_vector_type(4)));
typedef short bf16x8 __attribute__((ext_vector_type(8)));
typedef GAS unsigned gu32;
#define RLX_AGENT __ATOMIC_RELAXED, __HIP_MEMORY_SCOPE_AGENT
#define LDS_WAIT() asm volatile("s_waitcnt lgkmcnt(0)" ::: "memory")
#define VM_WAIT() asm volatile("s_waitcnt vmcnt(0)" ::: "memory")
#define LDS_BARRIER() do { asm volatile("s_waitcnt lgkmcnt(0)" ::: "memory"); __builtin_amdgcn_s_barrier(); asm volatile("" ::: "memory"); } while (0)
#define MFMA16(a, b, c) __builtin_amdgcn_mfma_f32_16x16x32_bf16((a), (b), (c), 0, 0, 0)
typedef float f32x2_t __attribute__((ext_vector_type(2)));
typedef __bf16 bf16x2_t __attribute__((ext_vector_type(2)));
DI unsigned pk2(float lo, float hi) { f32x2_t v = {lo, hi}; bf16x2_t b = __builtin_convertvector(v, bf16x2_t); return __builtin_bit_cast(unsigned, b); }
DI unsigned f2bf(float f) { return pk2(f, 0.f) & 0xffffu; }
DI float bflo(unsigned w) { return __builtin_bit_cast(float, w << 16); }
DI float bfhi(unsigned w) { return __builtin_bit_cast(float, w & 0xffff0000u); }
DI float bf2f(bf16 b) { return __builtin_bit_cast(float, (unsigned)b << 16); }
DI f32x4 bf4_to_f32(v2u w) { return (f32x4){bflo(w.x), bfhi(w.x), bflo(w.y), bfhi(w.y)}; }
DI float sigmoid_(float x) { return __builtin_amdgcn_rcpf(1.f + __builtin_amdgcn_exp2f(-1.4426950408889634f * x)); }
DI float silu_(float x) { return x * sigmoid_(x); }
DI float softplus_(float x) { return x > 20.f ? x : log1pf(__expf(x)); }
DI float gelu_tanh_(float x) { return x * sigmoid_(1.5957691216057308f * (x + 0.044715f * x * x * x)); }
DI float wave_sum(float v) {
#pragma unroll
    for (int o = 1; o < 64; o <<= 1) v += __shfl_xor(v, o);
    return v;
}
DI bf16x8 pack8(f32x4 a, f32x4 b) { v4u p; p.x = pk2(a[0], a[1]); p.y = pk2(a[2], a[3]); p.z = pk2(b[0], b[1]); p.w = pk2(b[2], b[3]); return __builtin_bit_cast(bf16x8, p); }
#define XB_TMO      128
#define XB_XCNT(j)  (256  + 64 * (j))
#define XB_XSUB(j)  (1280 + 64 * (j))
#define XB_XGEN(j)  (2304 + 64 * (j))
#define XB_TOP      3328
#define XB_TOPGEN   3392
#define XCD_BAR_WORDS 3456
#define XB_SPIN_CAP (1u << 18)

__device__ __forceinline__ unsigned xb_ld(unsigned* p)              { return __hip_atomic_load(p, __ATOMIC_RELAXED, __HIP_MEMORY_SCOPE_AGENT); }
__device__ __forceinline__ unsigned xb_add(unsigned* p, unsigned v) { return __hip_atomic_fetch_add(p, v, __ATOMIC_RELAXED, __HIP_MEMORY_SCOPE_AGENT); }
__device__ __forceinline__ unsigned xb_xcc_id() { return (unsigned)__builtin_amdgcn_s_getreg((3 << 11) | 20) & 0xFu; }
#define XB_SPIN(cond, bar) do { unsigned _sp = 0; while (cond) { __builtin_amdgcn_s_sleep(1); \
    if ((++_sp & 255u) == 0u) { if (xb_ld(&(bar)[XB_TMO])) break; if (_sp > XB_SPIN_CAP) { atomicAdd(&(bar)[XB_TMO], 1u); break; } } } } while (0)

struct XcdBarrier {
    unsigned* bar; unsigned x;
    volatile LAS unsigned* st;
};

__device__ __forceinline__ XcdBarrier xcd_barrier_post(unsigned* bar, volatile LAS unsigned* st) {
    XcdBarrier b; b.bar = bar; b.x = xb_xcc_id(); b.st = st;
    if (threadIdx.x == 0) (void)xb_add(&bar[XB_XCNT(b.x)], 1u);
    return b;
}
__device__ __forceinline__ void xcd_barrier_complete(unsigned* bar, unsigned x, unsigned& nloc, unsigned& nx) {
    const unsigned G = gridDim.x * gridDim.y * gridDim.z;
    unsigned sum, cnt, mine, sp = 0u;
    for (;;) {
        sum = 0u; cnt = 0u; mine = 0u;
#pragma unroll
        for (unsigned j = 0; j < 16; ++j) { const unsigned c = xb_ld(&bar[XB_XCNT(j)]); sum += c; cnt += (c > 0u) ? 1u : 0u; mine = (j == x) ? c : mine; }
        if (sum == G) break;
        __builtin_amdgcn_s_sleep(1);
        if ((++sp & 255u) == 0u) { if (xb_ld(&bar[XB_TMO])) break; if (sp > XB_SPIN_CAP) { atomicAdd(&bar[XB_TMO], 1u); break; } }
    }
    nloc = mine > 0u ? mine : 1u; nx = cnt > 0u ? cnt : 1u;
}

__device__ __forceinline__ void xcd_barrier(const XcdBarrier& b) {
    asm volatile("s_waitcnt vmcnt(0)" ::: "memory");
    __syncthreads();
    if (threadIdx.x == 0) {
        unsigned* bar = b.bar;
        __builtin_amdgcn_s_waitcnt(0);
        unsigned nloc = b.st[0], nx = b.st[1];
        if (nloc == 0u) { xcd_barrier_complete(bar, b.x, nloc, nx); b.st[0] = nloc; b.st[1] = nx; }
        const unsigned old = xb_add(&bar[XB_XSUB(b.x)], 1u);
        const unsigned gen = old / nloc;
        if (old + 1u == (gen + 1u) * nloc) {
            __builtin_amdgcn_fence(__ATOMIC_RELEASE, "agent");
            asm volatile("s_waitcnt vmcnt(0)" ::: "memory");
            const unsigned og = xb_add(&bar[XB_TOP], 1u);
            const unsigned tg = og / nx;
            if (og + 1u == (tg + 1u) * nx) xb_add(&bar[XB_TOPGEN], 1u);
            else XB_SPIN(xb_ld(&bar[XB_TOPGEN]) == tg, bar);
            __builtin_amdgcn_fence(__ATOMIC_ACQUIRE, "agent");
            xb_add(&bar[XB_XGEN(b.x)], 1u);
            asm volatile("s_waitcnt vmcnt(0)" ::: "memory");
        } else {
            XB_SPIN(xb_ld(&bar[XB_XGEN(b.x)]) == gen, bar);
            __builtin_amdgcn_fence(__ATOMIC_ACQUIRE, "agent");
            asm volatile("s_waitcnt vmcnt(0)" ::: "memory");
        }
    }
    __syncthreads();
}
struct Args { const float* in[25]; float* out; unsigned char* ws; int ph_lo, ph_hi; };

struct CvItem { const float* src; bf16* dst; int ldw, K; const float* kscale; };
DI void cv_load(const CvItem& d, float (&v)[32], f32x4 (&kg)[2], int lane) {
#pragma unroll
    for (int i = 0; i < 32; ++i) v[i] = __builtin_nontemporal_load((const GAS float*)(d.src + (size_t)(2 * i + (lane >> 5)) * d.ldw + (lane & 31)));
    const GAS f32x4* kp = (const GAS f32x4*)((d.kscale ? d.kscale : d.src) + 8 * (lane & 7));
    kg[0] = kp[0]; kg[1] = kp[1];
}
DI void cv_finish(const CvItem& d, const float (&v)[32], const f32x4 (&kg)[2], LAS float* scr, int lane) {
#pragma unroll
    for (int i = 0; i < 32; ++i) scr[(2 * i + (lane >> 5)) * 33 + (lane & 31)] = v[i];
    LDS_WAIT(); asm volatile("" ::: "memory");
    const int c = lane & 7; const bool ks = d.kscale != nullptr;
    const f32x4 g0 = ks ? kg[0] : (f32x4){1.f, 1.f, 1.f, 1.f}, g1 = ks ? kg[1] : (f32x4){1.f, 1.f, 1.f, 1.f};
#pragma unroll
    for (int j = 0; j < 4; ++j) { const int n = (lane >> 3) + 8 * j; const LAS float* s = scr + (8 * c) * 33 + n;
        v4u o; o.x = pk2(s[0 * 33] * g0.x, s[1 * 33] * g0.y); o.y = pk2(s[2 * 33] * g0.z, s[3 * 33] * g0.w); o.z = pk2(s[4 * 33] * g1.x, s[5 * 33] * g1.y); o.w = pk2(s[6 * 33] * g1.z, s[7 * 33] * g1.w);
        *(GAS v4u*)(d.dst + (size_t)n * d.K + 8 * c) = o; }
    LDS_WAIT(); asm volatile("" ::: "memory");
}
DI void norm_phase(const float* xp, const float* xs, const float* X, bool first, const float* w, bf16* XN, int gw, int NGW, int lane) {
    const GAS f32x4* wr = (const GAS f32x4*)w + lane;
    for (int mb = gw; mb < MR; mb += 2 * NGW) { f32x4 v[2][16];
#pragma unroll
        for (int r = 0; r < 2; ++r) { const int m = mb + r * NGW < MR ? mb + r * NGW : mb;
            const float* src = first ? (m < MP ? xp + (size_t)m * D : xs + (size_t)(m - MP) * D) : X + (size_t)m * D; const GAS f32x4* xr = (const GAS f32x4*)src + lane;
#pragma unroll
            for (int j = 0; j < 16; ++j) v[r][j] = xr[64 * j]; }
#pragma unroll
        for (int r = 0; r < 2; ++r) { const int m = mb + r * NGW; float s = 0.f;
#pragma unroll
            for (int j = 0; j < 16; ++j) s += (v[r][j].x * v[r][j].x + v[r][j].y * v[r][j].y) + (v[r][j].z * v[r][j].z + v[r][j].w * v[r][j].w);
            const float rstd = rsqrtf(wave_sum(s) * (1.f / D) + EPS);
            if (m < MR) { GAS v2u* o8 = (GAS v2u*)(XN + (size_t)m * D) + lane;
#pragma unroll
                for (int j = 0; j < 16; ++j) { const f32x4 g = wr[64 * j]; v2u o; o.x = pk2(v[r][j].x * rstd * g.x, v[r][j].y * rstd * g.y); o.y = pk2(v[r][j].z * rstd * g.z, v[r][j].w * rstd * g.w); o8[64 * j] = o; } } } }
    if (first) for (int m = MR + gw; m < MPAD; m += NGW) { GAS v4u* o = (GAS v4u*)(XN + (size_t)m * D) + lane;
#pragma unroll
        for (int j = 0; j < 8; ++j) o[64 * j] = (v4u){0u, 0u, 0u, 0u}; }
}
DI void rowss_phase(const bf16* XB, float* rss, int m0, int m1, int gw, int NGW, int lane) {
    for (int mb = m0 + gw; mb < m1; mb += 4 * NGW) { v4u w[4][8];
#pragma unroll
        for (int r = 0; r < 4; ++r) { const int m = mb + r * NGW < m1 ? mb + r * NGW : mb; const GAS v4u* xr = (const GAS v4u*)(XB + (size_t)m * D) + lane;
#pragma unroll
            for (int j = 0; j < 8; ++j) w[r][j] = xr[64 * j]; }
#pragma unroll
        for (int r = 0; r < 4; ++r) { float s = 0.f;
#pragma unroll
            for (int j = 0; j < 8; ++j) { const v4u q = w[r][j]; const float f[8] = {bflo(q.x), bfhi(q.x), bflo(q.y), bfhi(q.y), bflo(q.z), bfhi(q.z), bflo(q.w), bfhi(q.w)};
#pragma unroll
                for (int e = 0; e < 8; ++e) s += f[e] * f[e]; }
            s = wave_sum(s); if (lane == 0 && mb + r * NGW < m1) *(GAS float*)(rss + mb + r * NGW) = s; } }
}
constexpr int I_IN = 64 * 385, I_G = 2 * NH * 8, I_DN = 256 * 128, I_UP = 64 * 512, I_OUT = 64 * 128;
constexpr int CV_ITEMS = I_IN + I_G + I_DN + I_UP + I_OUT, CV_SPLIT = I_IN + I_G + I_DN + I_UP / 4;
DI CvItem cv_decode(const Args& a, int l, int it) {
    bf16* WIN = (bf16*)(a.ws + WS_WIN); bf16* WOUT = (bf16*)(a.ws + WS_WOUT); bf16* WUP = (bf16*)(a.ws + WS_WUP); bf16* WDN = (bf16*)(a.ws + WS_WDN); bf16* WG = (bf16*)(a.ws + WS_WG);
    int r = it; CvItem d;
    if (r < I_IN) { const int kb = r / 385, nb = r % 385; const int nsrc = nb < 256 ? nb : (nb < 384 ? nb + 1 : 256);
        d.src = a.in[7] + (size_t)l * D * NIN + (size_t)(64 * kb) * NIN + 32 * nsrc; d.ldw = NIN; d.dst = WIN + ((size_t)((32 * nb) >> 8) * (D / 64) + kb) * 16384 + (size_t)((32 * nb) & 255) * 64; d.K = 64; d.kscale = nullptr; return d; } r -= I_IN;
    if (r < I_G) { const int gm = r >> 3, sub = r & 7;
        d.src = (gm < NH ? a.in[14] : a.in[16]) + ((size_t)l * NH + (gm & 15)) * 128 * 128 + (size_t)(64 * (sub >> 2)) * 128 + 32 * (sub & 3); d.ldw = 128;
        d.dst = WG + (size_t)gm * 128 * 128 + (size_t)(32 * (sub & 3)) * 128 + 64 * (sub >> 2); d.K = 128; d.kscale = nullptr; return d; } r -= I_G;
    if (r < I_DN) { const int kb = r / 128, nb = r % 128, n0 = 32 * nb;
        d.src = a.in[23] + (size_t)l * DFF * D + (size_t)(64 * kb) * D + n0; d.ldw = D; d.dst = WDN + ((size_t)(n0 >> 8) * (DFF / 64) + kb) * 16384 + (size_t)(n0 & 255) * 64; d.K = 64; d.kscale = nullptr; return d; } r -= I_DN;
    if (r < I_UP) { d.src = a.in[22] + (size_t)l * D * DFF + (size_t)(64 * (r / 512)) * DFF + 32 * (r % 512); d.ldw = DFF; d.dst = WUP + ((size_t)((32 * (r % 512)) >> 8) * (D / 64) + r / 512) * 16384 + (size_t)((32 * (r % 512)) & 255) * 64; d.K = 64; d.kscale = a.in[21] + (size_t)l * D + 64 * (r / 512); return d; } r -= I_UP;
    d.src = a.in[20] + (size_t)l * D * D + (size_t)(64 * (r / 128)) * D + 32 * (r % 128); d.ldw = D; d.dst = WOUT + ((size_t)((32 * (r % 128)) >> 8) * (D / 64) + r / 128) * 16384 + (size_t)((32 * (r % 128)) & 255) * 64; d.K = 64; d.kscale = nullptr; return d;
}
DI void convert_range(const Args& a, int l, int it0, int itend, int stride, LAS float* scr, int lane) {
    for (int it = it0; it < itend; it += stride) { const CvItem d = cv_decode(a, l, it); float v[32]; f32x4 kg[2]; cv_load(d, v, kg, lane); cv_finish(d, v, kg, scr, lane); }
}
DI void convert_range2(const Args& a, int l, int it0, int itend, int stride, LAS float* scr, int lane) {
    if (it0 >= itend) return;
    float v0[32], v1[32]; f32x4 k0[2], k1[2];
    { const CvItem d = cv_decode(a, l, it0); cv_load(d, v0, k0, lane); }
    for (int it = it0; it < itend; it += 2 * stride) { const int i1 = it + stride, i2 = it + 2 * stride;
        { const CvItem d = cv_decode(a, l, i1 < itend ? i1 : it); cv_load(d, v1, k1, lane); }
        { const CvItem d = cv_decode(a, l, it); cv_finish(d, v0, k0, scr, lane); }
        { const CvItem d = cv_decode(a, l, i2 < itend ? i2 : it); cv_load(d, v0, k0, lane); }
        if (i1 < itend) { const CvItem d = cv_decode(a, l, i1); cv_finish(d, v1, k1, scr, lane); } }
}
DI void p0_weights(const Args& a, int l, LAS unsigned char* lds, int gw, int NGW, int wave, int lane) {
    LAS float* scr = (LAS float*)(lds + wave * 16384);
    bf16* WIN = (bf16*)(a.ws + WS_WIN);
    if (l == 0) convert_range(a, l, gw, I_IN + I_G, NGW, scr, lane);
    { const int gt = gw * 64 + lane, NT = NGW * 64; constexpr int PER = (NINP - NIN) * 64 / 8;
      for (int i = gt; i < (D / 64) * PER; i += NT) { const int kt = i / PER, o = i % PER; *(GAS v4u*)(WIN + ((size_t)(NIN >> 8) * (D / 64) + kt) * 16384 + (size_t)(NIN & 255) * 64 + 8 * o) = (v4u){0u, 0u, 0u, 0u}; } }
}

DI void unit_decode(int u, bool& samp, int& b, int& n, int& h, int& rowbase, int& L) {
    samp = u >= NUNIT_P;
    if (!samp) { b = u >> 11; n = (u >> 4) & 127; h = u & 15; rowbase = b * SEQ + n * 64; L = 64; }
    else { const int s = u - NUNIT_P; b = s >> 4; h = s & 15; n = 0; rowbase = MP + b * LS; L = LS; }
}
struct DInv { f32x4 w0, w1, w2, w3; float nalog, dtb; };
DI void delta_inv_load(const Args& a, int l, int h, int tid, DInv& v) {
    if (tid < 384) { const int p = tid >> 7, cq = tid & 31; const float* wc = a.in[8] + (size_t)l * 4 * QKV + p * 2048 + h * 128 + 4 * cq;
        v.w0 = *(const GAS f32x4*)(wc); v.w1 = *(const GAS f32x4*)(wc + QKV); v.w2 = *(const GAS f32x4*)(wc + 2 * QKV); v.w3 = *(const GAS f32x4*)(wc + 3 * QKV); }
    v.nalog = -__expf(a.in[9][l * NH + h]); v.dtb = a.in[10][l * NH + h];
}
DI void delta_issue(const Args& a, int u, int tid, v2u (&xraw)[19], unsigned& sraw) {
    asm volatile("" : "+v"(tid)); const int lane = tid & 63, wave = __builtin_amdgcn_readfirstlane(tid >> 6);
    bool samp; int b, n, h, rowbase, L; unit_decode(u, samp, b, n, h, rowbase, L);
    const bf16* PROJ = (const bf16*)(a.ws + WS_PROJ);
    if (tid < 384) { const int p = tid >> 7, cq = tid & 31, rs = (tid >> 5) & 3, t0 = rs * 16, col = p * 2048 + h * 128 + 4 * cq;
#pragma unroll
        for (int i = 0; i < 19; ++i) { int row = rowbase + t0 - 3 + i; row = row < 0 ? 0 : row; xraw[i] = *(const GAS v2u*)(PROJ + (size_t)row * NINP + col); } }
    else if (wave == 7) { const size_t row = (size_t)(rowbase + (lane < L ? lane : 0));
        sraw = (unsigned)*(const GAS bf16*)(PROJ + row * NINP + C_BL + h) | ((unsigned)*(const GAS bf16*)(PROJ + row * NINP + C_AL + h) << 16); }
}
DI void delta_prepass_unit(const Args& a, int l, int u, int u_next, LAS unsigned char* lds, int tid, v2u (&xraw)[19], unsigned& sraw, const DInv& inv) {
    const int tid_in = tid; asm volatile("" : "+v"(tid)); const int lane = tid & 63, wave = __builtin_amdgcn_readfirstlane(tid >> 6);
    bool samp; int b, n, h, rowbase, L; unit_decode(u, samp, b, n, h, rowbase, L);
    const bf16* PROJ = (const bf16*)(a.ws + WS_PROJ);
    unsigned char* rec = a.ws + WS_DF + (size_t)u * DF_STRIDE;
    LAS float* TS = (LAS float*)(lds + L_KN);
    LAS float* SCB = (LAS float*)(lds + L_SC); LAS float* SCG = SCB + 64; LAS float* RK2 = SCB + 128; LAS float* QQ2 = SCB + 192;
    const int fr = lane & 15, fq = lane >> 4;
    if (tid < 384) {
        const int p = tid >> 7, cq = tid & 31, rs = (tid >> 5) & 3, t0 = rs * 16;
        const int col = p * 2048 + h * 128 + 4 * cq;
        const f32x4 w0 = inv.w0, w1 = inv.w1, w2 = inv.w2, w3 = inv.w3;
        const float* cst = a.in[3] + ((size_t)(l * NBS + b) * 3) * QKV + col;
        f32x4 xr[19];
#pragma unroll
        for (int i = 0; i < 19; ++i) xr[i] = bf4_to_f32(xraw[i]);
        if (samp || n == 0) {
#pragma unroll
            for (int i = 0; i < 19; ++i) { const int tl = t0 - 3 + i; const bool use = (tl < L) && (tl >= 0); if (!use) xr[i] = (f32x4){0.f, 0.f, 0.f, 0.f}; }
            if (samp && t0 == 0) {
#pragma unroll
                for (int i = 0; i < 3; ++i) xr[i] = *(const GAS f32x4*)(cst + (size_t)i * QKV); } }
        unsigned tp[4][8];
#pragma unroll
        for (int rp = 0; rp < 8; ++rp) { const int r = 2 * rp;
            const f32x4 y0 = w0 * xr[r] + w1 * xr[r + 1] + w2 * xr[r + 2] + w3 * xr[r + 3], y1 = w0 * xr[r + 1] + w1 * xr[r + 2] + w2 * xr[r + 3] + w3 * xr[r + 4];
            f32x4 s0, s1; s0.x = silu_(y0.x); s0.y = silu_(y0.y); s0.z = silu_(y0.z); s0.w = silu_(y0.w); s1.x = silu_(y1.x); s1.y = silu_(y1.y); s1.z = silu_(y1.z); s1.w = silu_(y1.w);
            if (samp) { if (t0 + r >= L) s0 = (f32x4){0.f, 0.f, 0.f, 0.f}; if (t0 + r + 1 >= L) s1 = (f32x4){0.f, 0.f, 0.f, 0.f}; }
            if (p < 2) { LAS unsigned char* d = lds + (p == 0 ? L_QN : L_KN) + (t0 + r) * 272 + 8 * cq;
                *(LAS v2u*)d = (v2u){pk2(s0.x, s0.y), pk2(s0.z, s0.w)}; *(LAS v2u*)(d + 272) = (v2u){pk2(s1.x, s1.y), pk2(s1.z, s1.w)}; }
            if (p >= 1) { tp[0][rp] = pk2(s0.x, s1.x); tp[1][rp] = pk2(s0.y, s1.y); tp[2][rp] = pk2(s0.z, s1.z); tp[3][rp] = pk2(s0.w, s1.w); }
        }
        if (p >= 1) { const int base = (p == 1 ? L_KT : L_VT);
#pragma unroll
            for (int e = 0; e < 4; ++e) { LAS v4u* d = (LAS v4u*)(lds + base + (4 * cq + e) * 144 + t0 * 2);
                d[0] = (v4u){tp[e][0], tp[e][1], tp[e][2], tp[e][3]}; d[1] = (v4u){tp[e][4], tp[e][5], tp[e][6], tp[e][7]}; } }
        delta_issue(a, u_next, tid_in, xraw, sraw);
    } else if (wave == 7) {
        const bool valid = lane < L;
        const float bl = bflo(sraw), al = bfhi(sraw);
        delta_issue(a, u_next, tid_in, xraw, sraw);
        const float beta = valid ? sigmoid_(bl) : 0.f;
        float g = valid ? inv.nalog * softplus_(al + inv.dtb) : 0.f;
#pragma unroll
        for (int o = 1; o < 64; o <<= 1) { const float t = __shfl_up(g, o); if (lane >= o) g += t; }
        SCB[lane] = beta; SCG[lane] = g;
        if (lane == 63) *(GAS float*)(rec + DF_GL) = __expf(g);
    }
    LDS_BARRIER();
    {
        const int m = wave >> 1, n0 = 2 * (wave & 1);
        bf16x8 ak[4];
#pragma unroll
        for (int s = 0; s < 4; ++s) ak[s] = *(const LAS bf16x8*)(lds + L_KN + (16 * m + fr) * 272 + 16 * fq + 64 * s);
#pragma unroll
        for (int nn = 0; nn < 2; ++nn) { const int nt = n0 + nn;
            f32x4 kk = {0.f, 0.f, 0.f, 0.f}, qk = {0.f, 0.f, 0.f, 0.f};
#pragma unroll
            for (int s = 0; s < 4; ++s) { const bf16x8 bk = *(const LAS bf16x8*)(lds + L_KN + (16 * nt + fr) * 272 + 16 * fq + 64 * s), bq = *(const LAS bf16x8*)(lds + L_QN + (16 * nt + fr) * 272 + 16 * fq + 64 * s);
                kk = MFMA16(ak[s], bk, kk); qk = MFMA16(ak[s], bq, qk); }
#pragma unroll
            for (int r = 0; r < 4; ++r) { ((LAS float*)(lds + L_KK))[(16 * m + 4 * fq + r) * 68 + 16 * nt + fr] = kk[r]; ((LAS float*)(lds + L_QKT))[(16 * m + 4 * fq + r) * 64 + 16 * nt + fr] = qk[r];
                if (nt == m && 4 * fq + r == fr) RK2[16 * m + fr] = kk[r]; } }
        if (wave < 4) { f32x4 qq = {0.f, 0.f, 0.f, 0.f};
#pragma unroll
            for (int s = 0; s < 4; ++s) { const bf16x8 aq = *(const LAS bf16x8*)(lds + L_QN + (16 * wave + fr) * 272 + 16 * fq + 64 * s); qq = MFMA16(aq, aq, qq); }
#pragma unroll
            for (int r = 0; r < 4; ++r) if (4 * fq + r == fr) QQ2[16 * wave + fr] = qq[r]; }
    }
    LDS_BARRIER();
#pragma unroll
    for (int e = 0; e < 8; ++e) { const int idx = tid + 512 * e, i = idx >> 6, j = idx & 63; LAS float* p = (LAS float*)(lds + L_KK) + i * 68 + j;
        const float v = (i > j) ? SCB[i] * rsqrtf(RK2[i] + EPS) * rsqrtf(RK2[j] + EPS) * (*p) * __expf(SCG[i] - SCG[j]) : 0.f; *p = v; }
    LDS_BARRIER();
    if (wave == 0) {
        const LAS float* Ab = (const LAS float*)(lds + L_KK) + (16 * fq) * 68 + 16 * fq;
        float X[16]; X[0] = (fr == 0) ? 1.f : 0.f;
#pragma unroll
        for (int gi = 0; gi < 4; ++gi) { f32x4 ar[4][4];
#pragma unroll
            for (int ii = 0; ii < 4; ++ii)
#pragma unroll
                for (int qd = 0; qd <= gi; ++qd) ar[ii][qd] = *(const LAS f32x4*)(Ab + (4 * gi + ii) * 68 + 4 * qd);
#pragma unroll
            for (int ii = 0; ii < 4; ++ii) { const int i = 4 * gi + ii; if (i == 0) continue; float acc = (i == fr) ? 1.f : 0.f;
#pragma unroll
                for (int j = 0; j < i; ++j) acc -= ar[ii][j >> 2][j & 3] * X[j];
                X[i] = acc; } }
#pragma unroll
        for (int i = 0; i < 16; ++i) TS[(16 * fq + i) * 68 + 16 * fq + fr] = X[i];
    } else {
        for (int f = wave - 1; f < 8; f += 7) { const int mi = f >> 1, s2 = f & 1, i = 16 * mi + fr; const float si = rsqrtf(QQ2[i] + EPS) * 0.08838834764831845f, Gi = SCG[i];
            float v[8];
#pragma unroll
            for (int e = 0; e < 8; ++e) { const int j = 16 * (2 * s2 + (e >> 2)) + 4 * fq + (e & 3);
                v[e] = (i >= j) ? si * rsqrtf(RK2[j] + EPS) * ((const LAS float*)(lds + L_QKT))[j * 64 + i] * __expf(Gi - SCG[j]) : 0.f; }
            v4u o; o.x = pk2(v[0], v[1]); o.y = pk2(v[2], v[3]); o.z = pk2(v[4], v[5]); o.w = pk2(v[6], v[7]);
            *(LAS v4u*)(lds + L_QKF + (f * 64 + lane) * 16) = o; }
    }
    LDS_BARRIER();
#pragma unroll
    for (int d = 1; d < 4; ++d) {
        if (wave < 4 - d) { const int bi = wave + d, bj = wave; const LAS float* As = (const LAS float*)(lds + L_KK);
            f32x4 P = {0.f, 0.f, 0.f, 0.f};
            for (int k = bj; k < bi; ++k)
#pragma unroll
                for (int kk = 0; kk < 4; ++kk) P = __builtin_amdgcn_mfma_f32_16x16x4f32(As[(16 * bi + fr) * 68 + 16 * k + 4 * kk + fq], TS[(16 * k + 4 * kk + fq) * 68 + 16 * bj + fr], P, 0, 0, 0);
            f32x4 R = {0.f, 0.f, 0.f, 0.f};
#pragma unroll
            for (int kk = 0; kk < 4; ++kk) R = __builtin_amdgcn_mfma_f32_16x16x4f32(TS[(16 * bi + fr) * 68 + 16 * bi + 4 * fq + kk], P[kk], R, 0, 0, 0);
#pragma unroll
            for (int r = 0; r < 4; ++r) TS[(16 * bi + 4 * fq + r) * 68 + 16 * bj + fr] = -R[r]; }
        LDS_BARRIER();
    }
#pragma unroll
    for (int e = 0; e < 8; ++e) { const int idx = tid + 512 * e, i = idx >> 6, j = idx & 63; const float t = (i >= j) ? TS[i * 68 + j] : 0.f, bj = SCB[j];
        *(LAS bf16*)(lds + L_TU + i * 144 + 2 * j) = (bf16)f2bf(t * bj); *(LAS bf16*)(lds + L_TW + i * 144 + 2 * j) = (bf16)f2bf(t * bj * rsqrtf(RK2[j] + EPS) * __expf(SCG[j])); }
    LDS_BARRIER();
    {
        bf16x8 bk[2], bv[2];
#pragma unroll
        for (int s2 = 0; s2 < 2; ++s2) { bk[s2] = *(const LAS bf16x8*)(lds + L_KT + (16 * wave + fr) * 144 + 16 * fq + 64 * s2); bv[s2] = *(const LAS bf16x8*)(lds + L_VT + (16 * wave + fr) * 144 + 16 * fq + 64 * s2); }
        f32x4 wt[4], ut[4];
#pragma unroll
        for (int mi = 0; mi < 4; ++mi) { wt[mi] = (f32x4){0.f, 0.f, 0.f, 0.f}; ut[mi] = (f32x4){0.f, 0.f, 0.f, 0.f};
#pragma unroll
            for (int s2 = 0; s2 < 2; ++s2) { const bf16x8 aw = *(const LAS bf16x8*)(lds + L_TW + (16 * mi + fr) * 144 + 16 * fq + 64 * s2), au = *(const LAS bf16x8*)(lds + L_TU + (16 * mi + fr) * 144 + 16 * fq + 64 * s2);
                wt[mi] = MFMA16(aw, bk[s2], wt[mi]); ut[mi] = MFMA16(au, bv[s2], ut[mi]); } }
        const bf16x8 wA[2] = {pack8(wt[0], wt[1]), pack8(wt[2], wt[3])}, uB[2] = {pack8(ut[0], ut[1]), pack8(ut[2], ut[3])};
        const float glast = SCG[63];
        float ksc[2][2][4];
#pragma unroll
        for (int s2 = 0; s2 < 2; ++s2)
#pragma unroll
            for (int hh = 0; hh < 2; ++hh)
#pragma unroll
                for (int e = 0; e < 4; ++e) { const int j = 16 * (2 * s2 + hh) + 4 * fq + e; ksc[s2][hh][e] = rsqrtf(RK2[j] + EPS) * __expf(glast - SCG[j]); }
        const int half = 8 * (wave & 1), sw = wave >> 1;
#pragma unroll
        for (int m = 0; m < 8; ++m) { bf16x8 kdf[2];
#pragma unroll
            for (int s2 = 0; s2 < 2; ++s2) { f32x4 x[2];
#pragma unroll
                for (int hh = 0; hh < 2; ++hh) { x[hh] = bf4_to_f32(*(const LAS v2u*)(lds + L_KT + (16 * m + fr) * 144 + 2 * (16 * (2 * s2 + hh) + 4 * fq)));
#pragma unroll
                    for (int e = 0; e < 4; ++e) x[hh][e] *= ksc[s2][hh][e]; }
                kdf[s2] = pack8(x[0], x[1]); }
            f32x4 c0 = {0.f, 0.f, 0.f, 0.f}, c1 = {0.f, 0.f, 0.f, 0.f};
#pragma unroll
            for (int s2 = 0; s2 < 2; ++s2) { c0 = MFMA16(wA[s2], kdf[s2], c0); c1 = MFMA16(kdf[s2], uB[s2], c1); }
            v2u o; o.x = pk2(-c0[0], -c0[1]); o.y = pk2(-c0[2], -c0[3]); *(GAS v2u*)(rec + DF_MP + (size_t)((m * 4 + sw) * 64 + lane) * 16 + half) = o;
            v2u p; p.x = pk2(c1[0], c1[1]); p.y = pk2(c1[2], c1[3]); *(GAS v2u*)(rec + DF_BN + (size_t)((wave * 8 + m) * 64 + lane) * 8) = p; }
#pragma unroll
        for (int ni = 0; ni < 4; ++ni) { const int i = 16 * ni + fr; f32x4 c0 = {0.f, 0.f, 0.f, 0.f}, c1 = {0.f, 0.f, 0.f, 0.f};
#pragma unroll
            for (int s2 = 0; s2 < 2; ++s2) { const bf16x8 qf = *(const LAS bf16x8*)(lds + L_QKF + ((ni * 2 + s2) * 64 + lane) * 16); c0 = MFMA16(wA[s2], qf, c0); c1 = MFMA16(qf, uB[s2], c1); }
            const float sc = rsqrtf(QQ2[i] + EPS) * 0.08838834764831845f * __expf(SCG[i]);
            const f32x4 qv = bf4_to_f32(*(const LAS v2u*)(lds + L_QN + i * 272 + 2 * (16 * wave + 4 * fq)));
            v2u o; o.x = pk2(qv[0] * sc - c0[0], qv[1] * sc - c0[1]); o.y = pk2(qv[2] * sc - c0[2], qv[3] * sc - c0[3]); __builtin_nontemporal_store(o, (GAS v2u*)(rec + DF_QE + (size_t)((ni * 4 + sw) * 64 + lane) * 16 + half));
            v2u p; p.x = pk2(c1[0], c1[1]); p.y = pk2(c1[2], c1[3]); __builtin_nontemporal_store(p, (GAS v2u*)(rec + DF_OU + (size_t)((wave * 4 + ni) * 64 + lane) * 8)); }
    }
    LDS_BARRIER();
}
struct LInv { f32x4 w0, w1, w2, w3, bc; bf16x8 bw[2][4]; float ba, bx, c8; };
DI void lru_inv_load(const Args& a, int l, int g, int tid, LInv& v) {
    const int lane = tid & 63, wave = tid >> 6, fr = lane & 15, fq = lane >> 4, cq = tid & 31, ch = g * 128 + 4 * cq;
    const float* wc = a.in[12] + (size_t)l * 4 * DB + ch;
    v.w0 = *(const GAS f32x4*)(wc); v.w1 = *(const GAS f32x4*)(wc + DB); v.w2 = *(const GAS f32x4*)(wc + 2 * DB); v.w3 = *(const GAS f32x4*)(wc + 3 * DB); v.bc = *(const GAS f32x4*)(a.in[13] + (size_t)l * DB + ch);
    const bf16* WG = (const bf16*)(a.ws + WS_WG);
#pragma unroll
    for (int gt = 0; gt < 2; ++gt)
#pragma unroll
        for (int s = 0; s < 4; ++s) v.bw[gt][s] = *(const GAS bf16x8*)(WG + ((size_t)(gt * NH + g) * 128 + 16 * wave + fr) * 128 + 32 * s + 8 * fq);
    const int chj = g * 128 + 16 * wave + fr;
    v.ba = a.in[15][(size_t)l * DB + chj]; v.bx = a.in[17][(size_t)l * DB + chj]; v.c8 = -8.f * softplus_(-a.in[18][(size_t)l * DB + chj]);
}
DI void lru_issue(const Args& a, int u, int tid, v2u (&xraw)[7]) {
    asm volatile("" : "+v"(tid));
    bool samp; int b, n, g, rowbase, L; unit_decode(u, samp, b, n, g, rowbase, L);
    const bf16* PROJ = (const bf16*)(a.ws + WS_PROJ);
    const int cq = tid & 31, rs = tid >> 5, t0 = rs * 4, col = C_XL + g * 128 + 4 * cq;
#pragma unroll
    for (int i = 0; i < 7; ++i) { int row = rowbase + t0 - 3 + i; row = row < 0 ? 0 : row; xraw[i] = *(const GAS v2u*)(PROJ + (size_t)row * NINP + col); }
}
DI void lru_prepass_unit(const Args& a, int l, int u, int u_next, LAS unsigned char* lds, int tid, v2u (&xraw)[7], const LInv& inv) {
    const int tid_in = tid; asm volatile("" : "+v"(tid)); const int lane = tid & 63, wave = __builtin_amdgcn_readfirstlane(tid >> 6);
    bool samp; int b, n, g, rowbase, L; unit_decode(u, samp, b, n, g, rowbase, L);
    const bf16* PROJ = (const bf16*)(a.ws + WS_PROJ); const bf16* WG = (const bf16*)(a.ws + WS_WG);
    bf16* HLOC = (bf16*)(a.ws + WS_HLOC); bf16* CUM = (bf16*)(a.ws + WS_CUM);
    const int fr = lane & 15, fq = lane >> 4;
    LAS float* XCF = (LAS float*)(lds + L_XCF); LAS float* AS = (LAS float*)(lds + L_AS); LAS float* BS = (LAS float*)(lds + L_BS); LAS float* SEGA = (LAS float*)(lds + L_SEG); LAS float* SEGB = SEGA + 1024;
    {
        const int cq = tid & 31, rs = tid >> 5, t0 = rs * 4, ch = g * 128 + 4 * cq, col = C_XL + ch;
        const f32x4 w0 = inv.w0, w1 = inv.w1, w2 = inv.w2, w3 = inv.w3, bc = inv.bc;
        const float* cst = a.in[5] + ((size_t)(l * NBS + b) * 3) * DB + ch;
        f32x4 xr[7];
#pragma unroll
        for (int i = 0; i < 7; ++i) { const int tl = t0 - 3 + i;
            const bool use = (tl < L) && (tl >= 0 || (!samp && n > 0)); const f32x4 x = bf4_to_f32(xraw[i]);
            xr[i] = (f32x4){use ? x.x : 0.f, use ? x.y : 0.f, use ? x.z : 0.f, use ? x.w : 0.f}; }
        if (samp && t0 == 0) {
#pragma unroll
            for (int i = 0; i < 3; ++i) xr[i] = *(const GAS f32x4*)(cst + (size_t)i * DB); }
        lru_issue(a, u_next, tid_in, xraw);
#pragma unroll
        for (int r = 0; r < 4; ++r) { const f32x4 y = w0 * xr[r] + w1 * xr[r + 1] + w2 * xr[r + 2] + w3 * xr[r + 3] + bc;
            v2u o; o.x = pk2(y.x, y.y); o.y = pk2(y.z, y.w); *(LAS v2u*)(lds + L_XCB + (t0 + r) * 272 + 8 * cq) = o; *(LAS f32x4*)(XCF + (t0 + r) * 132 + 4 * cq) = y; }
    }
    LDS_BARRIER();
    {
        f32x4 acc[2][4];
#pragma unroll
        for (int gt = 0; gt < 2; ++gt) {
#pragma unroll
            for (int mi = 0; mi < 4; ++mi) { f32x4 c = {0.f, 0.f, 0.f, 0.f};
#pragma unroll
                for (int s = 0; s < 4; ++s) { const bf16x8 ax = *(const LAS bf16x8*)(lds + L_XCB + (16 * mi + fr) * 272 + 16 * fq + 64 * s); c = MFMA16(ax, inv.bw[gt][s], c); }
                acc[gt][mi] = c; } }
        const int j = 16 * wave + fr, ch = g * 128 + j;
        const float ba = inv.ba, bx = inv.bx, c8 = inv.c8;
#pragma unroll
        for (int mi = 0; mi < 4; ++mi)
#pragma unroll
            for (int r = 0; r < 4; ++r) { const int t = 16 * mi + 4 * fq + r; const float xc = XCF[t * 132 + j];
                const float gr = sigmoid_(acc[0][mi][r] + ba), gi = sigmoid_(acc[1][mi][r] + bx), la = c8 * gr;
                float av = __expf(la), bvv = __builtin_amdgcn_sqrtf(fmaxf(1.f - av * av, 0.f)) * gi * xc;
                if (t >= L) { av = 1.f; bvv = 0.f; }
                AS[t * 132 + j] = av; BS[t * 132 + j] = bvv; }
    }
    LDS_BARRIER();
    {
        const int j2 = tid & 63, seg = tid >> 6; float P0 = 1.f, H0 = 0.f, P1 = 1.f, H1 = 0.f;
#pragma unroll
        for (int r = 0; r < 8; ++r) { const int t = seg * 8 + r; LAS float* pa = AS + t * 132 + 2 * j2; LAS float* pb = BS + t * 132 + 2 * j2;
            const float a0 = pa[0], a1 = pa[1], b0 = pb[0], b1 = pb[1]; H0 = a0 * H0 + b0; P0 *= a0; H1 = a1 * H1 + b1; P1 *= a1; pa[0] = P0; pa[1] = P1; pb[0] = H0; pb[1] = H1; }
        SEGA[seg * 128 + 2 * j2] = P0; SEGA[seg * 128 + 2 * j2 + 1] = P1; SEGB[seg * 128 + 2 * j2] = H0; SEGB[seg * 128 + 2 * j2 + 1] = H1;
        LDS_BARRIER();
        float Pc0 = 1.f, Hc0 = 0.f, Pc1 = 1.f, Hc1 = 0.f;
        for (int s = 0; s < seg; ++s) { const float sa0 = SEGA[s * 128 + 2 * j2], sa1 = SEGA[s * 128 + 2 * j2 + 1]; Hc0 = sa0 * Hc0 + SEGB[s * 128 + 2 * j2]; Pc0 *= sa0; Hc1 = sa1 * Hc1 + SEGB[s * 128 + 2 * j2 + 1]; Pc1 *= sa1; }
        float* CHK = (float*)(a.ws + WS_CHK) + (size_t)u * 256;
#pragma unroll
        for (int r = 0; r < 8; ++r) { const int t = seg * 8 + r; if (t < L) { const float pa0 = AS[t * 132 + 2 * j2], pa1 = AS[t * 132 + 2 * j2 + 1], hb0 = BS[t * 132 + 2 * j2], hb1 = BS[t * 132 + 2 * j2 + 1];
                const float h0 = hb0 + pa0 * Hc0, h1 = hb1 + pa1 * Hc1, c0 = Pc0 * pa0, c1 = Pc1 * pa1; const size_t o = (size_t)(rowbase + t) * DB + g * 128 + 2 * j2;
                __builtin_nontemporal_store(pk2(h0, h1), (GAS unsigned*)(HLOC + o)); __builtin_nontemporal_store(pk2(c0, c1), (GAS unsigned*)(CUM + o));
                if (t == L - 1) { *(GAS f32x2_t*)(CHK + 2 * j2) = (f32x2_t){c0, c1}; *(GAS f32x2_t*)(CHK + 128 + 2 * j2) = (f32x2_t){h0, h1}; } } }
    }
    LDS_BARRIER();
}

DI void delta_sample_task(const Args& a, int l, int ts, int lane) {
    const int fr = lane & 15, fq = lane >> 4, b = ts >> 7, h = (ts >> 3) & 15, vs = ts & 7, u = NUNIT_P + b * NH + h;
    const unsigned char* rec = a.ws + WS_DF + (size_t)u * DF_STRIDE;
    const float* s0 = a.in[2] + ((size_t)(l * NBS + b) * NH + h) * 128 * 128;
    f32x4 S[8];
#pragma unroll
    for (int m = 0; m < 8; ++m)
#pragma unroll
        for (int r = 0; r < 4; ++r) S[m][r] = *(const GAS float*)(s0 + (size_t)(16 * m + 4 * fq + r) * 128 + 16 * vs + fr);
    bf16x8 Sb[4];
#pragma unroll
    for (int s = 0; s < 4; ++s) { Sb[s] = pack8(S[2 * s], S[2 * s + 1]); *(GAS bf16x8*)(a.ws + WS_SST + (size_t)u * 32768 + (size_t)((vs * 4 + s) * 64 + lane) * 16) = Sb[s]; }
    const float gl = *(const GAS float*)(rec + DF_GL);
    float* so = a.out + O_SD + ((size_t)(l * NBS + b) * NH + h) * 128 * 128;
#pragma unroll
    for (int m = 0; m < 8; ++m) { f32x4 acc = S[m] * gl + bf4_to_f32(*(const GAS v2u*)(rec + DF_BN + (size_t)((vs * 8 + m) * 64 + lane) * 8));
#pragma unroll
        for (int s = 0; s < 4; ++s) acc = MFMA16(*(const GAS bf16x8*)(rec + DF_MP + (size_t)((m * 4 + s) * 64 + lane) * 16), Sb[s], acc);
#pragma unroll
        for (int r = 0; r < 4; ++r) *(GAS float*)(so + (size_t)(16 * m + 4 * fq + r) * 128 + 16 * vs + fr) = acc[r]; }
}
DI void seq_phase(const Args& a, int l, int c, LAS unsigned char* lds, int wave, int lane) {
    const float* CHK = (const float*)(a.ws + WS_CHK); float* HIN = (float*)(a.ws + WS_HIN);
    if (c >= 128) { const int cc = c - 128;
        delta_sample_task(a, l, cc * 8 + wave, lane);
        if (wave < 2) { const int idx = (cc * 2 + wave) * 64 + lane, b = idx >> 11, ch = idx & 2047; const float* ck = CHK + (size_t)(NUNIT_P + b * NH + (ch >> 7)) * 256 + (ch & 127);
            *(GAS float*)(a.out + O_SL + (size_t)(l * NBS + b) * DB + ch) = *(const GAS float*)(ck) * a.in[4][(size_t)(l * NBS + b) * DB + ch] + *(const GAS float*)(ck + 128); }
        convert_range2(a, l, I_IN + I_G + cc * NWAVES + wave, CV_SPLIT, 128 * NWAVES, (LAS float*)(lds + wave * 16384), lane);
        return; }
    const int jj = c >> 3, bh = (c & 7) * 4 + (jj >> 2), vs = (jj & 3) * 2 + (wave & 1), b = bh >> 4, h = bh & 15, fr = lane & 15, fq = lane >> 4;
    const int u0 = (b << 11) + h;
    const unsigned char* rec0 = a.ws + WS_DF + (size_t)u0 * DF_STRIDE; constexpr size_t USTEP = 16 * DF_STRIDE;
    const int lw = wave - 2;
    unsigned soff[8], doff[8];
#pragma unroll
    for (int k = 0; k < 8; ++k) { const int p = lw * 8 + k; soff[k] = (unsigned)(p < 32 ? DF_MP + p * 1024 : DF_BN + (jj & 3) * 8192 + (p - 32) * 1024) + lane * 16; doff[k] = (unsigned)(p * 1024 + lane * 16); }
    const int lidx = (c & 63) * 64 + lane, lb = lidx >> 11, lch = lidx & 2047;
    const bool lru_on = (wave == 7) && (c < 64);
    float* hin_w = HIN + (c < 64 ? (size_t)0 : (size_t)NBP * NCH * DB);
    f32x4 S[8]; float H = 0.f;
#pragma unroll
    for (int m = 0; m < 8; ++m) S[m] = (f32x4){0.f, 0.f, 0.f, 0.f};
#define SQ_BAR() do { asm volatile("s_waitcnt lgkmcnt(0)" ::: "memory"); __builtin_amdgcn_s_barrier(); asm volatile("" ::: "memory"); } while (0)
    if (wave < 2) {
        SQ_BAR();
        for (int n = 0; n < NCH; ++n) { LAS unsigned char* sb = lds + L_SQ + (n & 1) * SQ_SLOT;
            bf16x8 Sb[4];
#pragma unroll
            for (int s = 0; s < 4; ++s) { Sb[s] = pack8(S[2 * s], S[2 * s + 1]); __builtin_nontemporal_store(Sb[s], (GAS bf16x8*)(a.ws + WS_SST + (size_t)(u0 + 16 * n) * 32768 + (size_t)((vs * 4 + s) * 64 + lane) * 16)); }
            bf16x8 mp[8][4]; v2u bn[8];
#pragma unroll
            for (int m = 0; m < 8; ++m) {
#pragma unroll
                for (int s = 0; s < 4; ++s) mp[m][s] = *(const LAS bf16x8*)(sb + ((m * 4 + s) * 64 + lane) * 16);
                bn[m] = *(const LAS v2u*)(sb + 32768 + wave * 4096 + (m * 64 + lane) * 8); }
            const float gl = *(const LAS float*)(sb + 40960);
            __builtin_amdgcn_sched_barrier(0);
#pragma unroll
            for (int m = 0; m < 8; ++m) S[m] = S[m] * gl + bf4_to_f32(bn[m]);
#pragma unroll
            for (int s = 0; s < 4; ++s)
#pragma unroll
                for (int m = 0; m < 8; ++m) S[m] = MFMA16(mp[m][s], Sb[s], S[m]);
            __builtin_amdgcn_sched_barrier(0);
            SQ_BAR(); }
    } else if (wave <= 6) {
        v4u buf[4][8]; float glb[4];
#define SQ_ISSUE(q, n) do { const int n_ = (n) < NCH ? (n) : NCH - 1; const unsigned char* r_ = rec0 + (size_t)n_ * USTEP; \
        _Pragma("unroll") for (int k = 0; k < 8; ++k) buf[q][k] = *(const GAS v4u*)(r_ + soff[k]); glb[q] = *(const GAS float*)(r_ + DF_GL); } while (0)
#define SQ_WRITE(q, slot) do { _Pragma("unroll") for (int k = 0; k < 8; ++k) *(LAS v4u*)(lds + L_SQ + (slot) * SQ_SLOT + doff[k]) = buf[q][k]; \
        *(LAS float*)(lds + L_SQ + (slot) * SQ_SLOT + 40960 + 4 * (4 - lw)) = glb[q]; } while (0)
        SQ_ISSUE(0, 0); SQ_ISSUE(1, 1); SQ_ISSUE(2, 2); SQ_ISSUE(3, 3);
        SQ_WRITE(0, 0);
        SQ_BAR();
        for (int t = 0; t < NCH; t += 4) {
#pragma unroll
            for (int q = 0; q < 4; ++q) {
                SQ_ISSUE(q, t + q + 4);
                SQ_WRITE((q + 1) & 3, (q + 1) & 1);
                SQ_BAR(); } }
#undef SQ_ISSUE
#undef SQ_WRITE
    } else {
        float la[4], lbv[4];
#define LR_ISSUE(q, n) do { const int n_ = (n) < NCH ? (n) : NCH - 1; const float* ck_ = CHK + (size_t)((lb << 11) + (n_ << 4) + (lch >> 7)) * 256 + (lch & 127); la[q] = *(const GAS float*)(ck_); lbv[q] = *(const GAS float*)(ck_ + 128); } while (0)
        LR_ISSUE(0, 0); LR_ISSUE(1, 1); LR_ISSUE(2, 2); LR_ISSUE(3, 3);
        SQ_BAR();
        for (int t = 0; t < NCH; t += 4) {
#pragma unroll
            for (int q = 0; q < 4; ++q) {
                *(GAS float*)(hin_w + (size_t)(lb * NCH + t + q) * DB + lch) = H; H = la[q] * H + lbv[q]; LR_ISSUE(q, t + q + 4);
                SQ_BAR(); } }
#undef LR_ISSUE
    }
#undef SQ_BAR
    if (wave < 2) { float* so = a.out + O_PD + ((size_t)(l * NBP + b) * NH + h) * 128 * 128;
#pragma unroll
        for (int m = 0; m < 8; ++m)
#pragma unroll
            for (int r = 0; r < 4; ++r) *(GAS float*)(so + (size_t)(16 * m + 4 * fq + r) * 128 + 16 * vs + fr) = S[m][r]; }
    else if (lru_on) *(GAS float*)(a.out + O_PL + (size_t)(l * NBP + lb) * DB + lch) = H;
}
struct PostRaw { bf16x8 sb[4]; bf16x8 qe[16]; v2u ou[4]; v4u z[2]; };
DI void delta_post_issue(const Args& a, int u, int tid, PostRaw& r) {
    asm volatile("" : "+v"(tid)); const int lane = tid & 63, wave = __builtin_amdgcn_readfirstlane(tid >> 6);
    bool samp; int b, n, h, rowbase, L; unit_decode(u, samp, b, n, h, rowbase, L);
    const unsigned char* rec = a.ws + WS_DF + (size_t)u * DF_STRIDE; const unsigned char* sst = a.ws + WS_SST + (size_t)u * 32768 + (size_t)wave * 4096;
#pragma unroll
    for (int s = 0; s < 4; ++s) r.sb[s] = *(const GAS bf16x8*)(sst + (size_t)(s * 64 + lane) * 16);
#pragma unroll
    for (int i = 0; i < 16; ++i) r.qe[i] = *(const GAS bf16x8*)(rec + DF_QE + (size_t)(i * 64 + lane) * 16);
#pragma unroll
    for (int mi = 0; mi < 4; ++mi) r.ou[mi] = *(const GAS v2u*)(rec + DF_OU + (size_t)((wave * 4 + mi) * 64 + lane) * 8);
    const int row = tid >> 3, seg = tid & 7; const size_t grow = (size_t)(rowbase + (row < L ? row : 0));
#pragma unroll
    for (int k2 = 0; k2 < 2; ++k2) r.z[k2] = *(const GAS v4u*)((const bf16*)(a.ws + WS_PROJ) + grow * NINP + C_Z + h * 128 + 16 * seg + 8 * k2);
}
DI void delta_post_unit(const Args& a, int l, int u, int u_next, LAS unsigned char* lds, int tid, PostRaw& raw, const f32x4 (&wnd)[4]) {
    const int tid_in = tid; asm volatile("" : "+v"(tid)); const int lane = tid & 63, wave = __builtin_amdgcn_readfirstlane(tid >> 6), fr = lane & 15, fq = lane >> 4;
    bool samp; int b, n, h, rowbase, L; unit_decode(u, samp, b, n, h, rowbase, L);
    LAS float* OL = (LAS float*)(lds + L_OL);
#pragma unroll
    for (int mi = 0; mi < 4; ++mi) { f32x4 acc = bf4_to_f32(raw.ou[mi]);
#pragma unroll
        for (int s = 0; s < 4; ++s) acc = MFMA16(raw.qe[mi * 4 + s], raw.sb[s], acc);
#pragma unroll
        for (int r = 0; r < 4; ++r) OL[(16 * mi + 4 * fq + r) * 132 + 16 * wave + fr] = acc[r]; }
    const v4u z0 = raw.z[0], z1 = raw.z[1];
    delta_post_issue(a, u_next, tid_in, raw);
    LDS_BARRIER();
    {   const int row = tid >> 3, seg = tid & 7; f32x4 o[4]; float ss = 0.f;
#pragma unroll
        for (int k = 0; k < 4; ++k) { o[k] = *(const LAS f32x4*)(OL + row * 132 + 16 * seg + 4 * k); ss += (o[k].x * o[k].x + o[k].y * o[k].y) + (o[k].z * o[k].z + o[k].w * o[k].w); }
        ss += __shfl_xor(ss, 1); ss += __shfl_xor(ss, 2); ss += __shfl_xor(ss, 4);
        const float rs = rsqrtf(ss * (1.f / 128.f) + EPS);
        if (row < L) { const size_t grow = (size_t)(rowbase + row);
#pragma unroll
            for (int k2 = 0; k2 < 2; ++k2) { const v4u zz = k2 ? z1 : z0;
                const f32x4 w0 = wnd[2 * k2], w1 = wnd[2 * k2 + 1]; const f32x4 a0 = o[2 * k2], a1 = o[2 * k2 + 1];
                v4u r; r.x = pk2(a0.x * rs * w0.x * silu_(bflo(zz.x)), a0.y * rs * w0.y * silu_(bfhi(zz.x))); r.y = pk2(a0.z * rs * w0.z * silu_(bflo(zz.y)), a0.w * rs * w0.w * silu_(bfhi(zz.y)));
                r.z = pk2(a1.x * rs * w1.x * silu_(bflo(zz.z)), a1.y * rs * w1.y * silu_(bfhi(zz.z))); r.w = pk2(a1.z * rs * w1.z * silu_(bflo(zz.w)), a1.w * rs * w1.w * silu_(bfhi(zz.w)));
                *(GAS v4u*)((bf16*)(a.ws + WS_MIX) + grow * D + h * 128 + 16 * seg + 8 * k2) = r; } }
    }
    LDS_BARRIER();
}
struct LruRowRaw { v4u yy[4], hl[4], cm[4]; f32x4 hi[8]; };
DI void post_row_load(const Args& a, int l, int row, int lane, LruRowRaw& r) {
    const bf16* PROJ = (const bf16*)(a.ws + WS_PROJ); const bf16* HLOC = (const bf16*)(a.ws + WS_HLOC); const bf16* CUM = (const bf16*)(a.ws + WS_CUM);
    const float* hin = row < MP ? (const float*)(a.ws + WS_HIN) + (size_t)((row >> 13) * NCH + ((row & (SEQ - 1)) >> 6)) * DB : a.in[4] + (size_t)(l * NBS + ((row - MP) >> 4)) * DB;
    const int c0 = 32 * lane;
#pragma unroll
    for (int k2 = 0; k2 < 4; ++k2) { r.yy[k2] = *(const GAS v4u*)(PROJ + (size_t)row * NINP + C_YL + c0 + 8 * k2); const size_t o = (size_t)row * DB + c0 + 8 * k2;
        r.hl[k2] = *(const GAS v4u*)(HLOC + o); r.cm[k2] = *(const GAS v4u*)(CUM + o); r.hi[2 * k2] = *(const GAS f32x4*)(hin + c0 + 8 * k2); r.hi[2 * k2 + 1] = *(const GAS f32x4*)(hin + c0 + 8 * k2 + 4); }
}
DI void post_row_finish(const Args& a, int row, int lane, const LruRowRaw& r, const f32x4 (&wn)[8]) {
    bf16* MIX = (bf16*)(a.ws + WS_MIX); const int c0 = 32 * lane;
    float y[32]; float ss = 0.f;
#pragma unroll
    for (int k2 = 0; k2 < 4; ++k2) { const v4u yy = r.yy[k2], hl8 = r.hl[k2], cm8 = r.cm[k2];
        const float gy[8] = {bflo(yy.x), bfhi(yy.x), bflo(yy.y), bfhi(yy.y), bflo(yy.z), bfhi(yy.z), bflo(yy.w), bfhi(yy.w)};
        const float hl[8] = {bflo(hl8.x), bfhi(hl8.x), bflo(hl8.y), bfhi(hl8.y), bflo(hl8.z), bfhi(hl8.z), bflo(hl8.w), bfhi(hl8.w)};
        const float cm[8] = {bflo(cm8.x), bfhi(cm8.x), bflo(cm8.y), bfhi(cm8.y), bflo(cm8.z), bfhi(cm8.z), bflo(cm8.w), bfhi(cm8.w)};
#pragma unroll
        for (int hh = 0; hh < 2; ++hh) { const f32x4 hi = r.hi[2 * k2 + hh];
#pragma unroll
            for (int e = 0; e < 4; ++e) { const float hv = hl[4 * hh + e] + cm[4 * hh + e] * hi[e]; const float v = gelu_tanh_(gy[4 * hh + e]) * hv; y[8 * k2 + 4 * hh + e] = v; ss += v * v; } } }
    const float rs = rsqrtf(wave_sum(ss) * (1.f / DB) + EPS);
#pragma unroll
    for (int k2 = 0; k2 < 4; ++k2) { const f32x4 w0 = wn[2 * k2], w1 = wn[2 * k2 + 1];
        v4u o; o.x = pk2(y[8 * k2] * rs * w0.x, y[8 * k2 + 1] * rs * w0.y); o.y = pk2(y[8 * k2 + 2] * rs * w0.z, y[8 * k2 + 3] * rs * w0.w);
        o.z = pk2(y[8 * k2 + 4] * rs * w1.x, y[8 * k2 + 5] * rs * w1.y); o.w = pk2(y[8 * k2 + 6] * rs * w1.z, y[8 * k2 + 7] * rs * w1.w);
        *(GAS v4u*)(MIX + (size_t)row * D + DA + c0 + 8 * k2) = o; }
}
DI void post_phase(const Args& a, int l, int gw, int NGW, int lane) {
    bf16* MIX = (bf16*)(a.ws + WS_MIX); const bf16* PROJ = (const bf16*)(a.ws + WS_PROJ);
    f32x4 wn[8];
#pragma unroll
    for (int k = 0; k < 8; ++k) wn[k] = *(const GAS f32x4*)(a.in[19] + (size_t)l * DB + 32 * lane + 4 * k);
    {
        LruRowRaw ra; int m = gw; if (m < MR) post_row_load(a, l, m, lane, ra);
        for (; m < MR; m += NGW) { const int mn = m + NGW < MR ? m + NGW : m; LruRowRaw rb; post_row_load(a, l, mn, lane, rb); post_row_finish(a, m, lane, ra, wn); ra = rb; } }
    for (int m = MR + gw; m < MPAD; m += NGW) { GAS v4u* o = (GAS v4u*)(MIX + (size_t)m * D) + lane;
#pragma unroll
        for (int j = 0; j < 8; ++j) o[64 * j] = (v4u){0u, 0u, 0u, 0u}; }
    const int gt = gw * 64 + lane, NT = NGW * 64;
    for (int i = gt; i < (NBP + NBS) * 3 * 8192; i += NT) { const int col = i & 8191, rr = (i >> 13) % 3, st = i / (3 * 8192);
        const int row = st < NBP ? st * SEQ + SEQ - 3 + rr : MP + (st - NBP) * LS + LS - 3 + rr;
        const float v = bf2f(*(const GAS bf16*)(PROJ + (size_t)row * NINP + (col < QKV ? col : C_XL + col - QKV)));
        if (col < QKV) { float* d = st < NBP ? a.out + O_PCD + ((size_t)(l * NBP + st) * 3 + rr) * QKV : a.out + O_SCD + ((size_t)(l * NBS + st - NBP) * 3 + rr) * QKV; *(GAS float*)(d + col) = v; }
        else { float* d = st < NBP ? a.out + O_PCL + ((size_t)(l * NBP + st) * 3 + rr) * DB : a.out + O_SCL + ((size_t)(l * NBS + st - NBP) * 3 + rr) * DB; *(GAS float*)(d + col - QKV) = v; } }
}
DI void final_norm_phase(const Args& a, int gw, int NGW, int lane) {
    const GAS f32x4* wr = (const GAS f32x4*)a.in[24] + lane;
    for (int mb = gw; mb < MR; mb += 2 * NGW) { f32x4 v[2][16];
#pragma unroll
        for (int r = 0; r < 2; ++r) { const int m = mb + r * NGW < MR ? mb + r * NGW : mb; const GAS f32x4* xr = (const GAS f32x4*)(a.out + (size_t)m * D) + lane;
#pragma unroll
            for (int j = 0; j < 16; ++j) v[r][j] = xr[64 * j]; }
#pragma unroll
        for (int r = 0; r < 2; ++r) { const int m = mb + r * NGW; float s = 0.f;
#pragma unroll
            for (int j = 0; j < 16; ++j) s += (v[r][j].x * v[r][j].x + v[r][j].y * v[r][j].y) + (v[r][j].z * v[r][j].z + v[r][j].w * v[r][j].w);
            const float rstd = rsqrtf(wave_sum(s) * (1.f / D) + EPS);
            if (m < MR) { GAS f32x4* xo = (GAS f32x4*)(a.out + (size_t)m * D) + lane;
#pragma unroll
                for (int j = 0; j < 16; ++j) xo[64 * j] = v[r][j] * rstd * wr[64 * j]; } } }
}
constexpr int TG_A = 0, TG_B = 34816, TG_BUF = 52224;
static_assert(2 * TG_BUF <= LDSCTL_OFF && 4 * 8704 * 4 <= LDSCTL_OFF, "thin GEMM LDS");
template <class F> DI void thin_gemm_unit(const bf16* A, int lda, int a_blk, int arow0, const bf16* Bt, int ldb, int b_blk, int brow0, int kslab, LAS unsigned char* lds, int tid, F&& epi) {
    asm volatile("" : "+v"(tid)); const int lane = tid & 63, wave = __builtin_amdgcn_readfirstlane(tid >> 6), fr = lane & 15, fq = lane >> 4, wm = wave >> 2, ks = wave & 3;
    const int nchunk = kslab >> 7, koff = (int)(blockIdx.x >> 3) & (nchunk - 1);
    const bf16* ga[4]; const bf16* gb[2]; unsigned da[4], db[2];
#pragma unroll
    for (int i = 0; i < 4; ++i) { const int row = 16 * wave + 4 * i + fq; ga[i] = a_blk ? A + (size_t)(fr >> 3) * 16384 + (size_t)(arow0 + row) * 64 + 8 * (fr & 7) : A + (size_t)row * lda + 8 * fr; da[i] = (unsigned)(TG_A + row * 272 + 16 * fr); }
#pragma unroll
    for (int i = 0; i < 2; ++i) { const int row = 8 * wave + 4 * i + fq; gb[i] = b_blk ? Bt + (size_t)(fr >> 3) * 16384 + (size_t)(brow0 + row) * 64 + 8 * (fr & 7) : Bt + (size_t)row * ldb + 8 * fr; db[i] = (unsigned)(TG_B + row * 272 + 16 * fr); }
    const size_t astep = a_blk ? 32768 : 128, bstep = b_blk ? 32768 : 128;
    v4u buf[4][6];
#define TG_ISSUE(q, ch) do { const int c_ = (((ch) < nchunk ? (ch) : nchunk - 1) + koff) & (nchunk - 1); \
        _Pragma("unroll") for (int i = 0; i < 4; ++i) buf[q][i] = *(const GAS v4u*)(ga[i] + c_ * astep); _Pragma("unroll") for (int i = 0; i < 2; ++i) buf[q][4 + i] = *(const GAS v4u*)(gb[i] + c_ * bstep); } while (0)
#define TG_WRITE(q, b) do { _Pragma("unroll") for (int i = 0; i < 4; ++i) *(LAS v4u*)(lds + (b) * TG_BUF + da[i]) = buf[q][i]; _Pragma("unroll") for (int i = 0; i < 2; ++i) *(LAS v4u*)(lds + (b) * TG_BUF + db[i]) = buf[q][4 + i]; } while (0)
    f32x4 acc[4][4];
#pragma unroll
    for (int mi = 0; mi < 4; ++mi)
#pragma unroll
        for (int ni = 0; ni < 4; ++ni) acc[mi][ni] = (f32x4){0.f, 0.f, 0.f, 0.f};
#define TG_FENCE() asm volatile("" ::: "memory")
#define TG_SYNC() do { asm volatile("s_waitcnt lgkmcnt(0)" ::: "memory"); __builtin_amdgcn_s_barrier(); asm volatile("" ::: "memory"); } while (0)
    TG_ISSUE(0, 0); TG_FENCE(); TG_ISSUE(1, 1); TG_FENCE(); TG_ISSUE(2, 2); TG_FENCE(); TG_ISSUE(3, 3); TG_FENCE();
    TG_WRITE(0, 0); TG_FENCE(); TG_ISSUE(0, 4); TG_FENCE(); TG_SYNC();
    for (int t = 0; t < nchunk; t += 4) {
#pragma unroll
        for (int q = 0; q < 4; ++q) {
            TG_WRITE((q + 1) & 3, (q + 1) & 1);
            TG_FENCE(); TG_ISSUE((q + 1) & 3, t + q + 5); TG_FENCE();
            const LAS unsigned char* sb = lds + (q & 1) * TG_BUF;
            bf16x8 af[4], bfr[4];
#pragma unroll
            for (int mi = 0; mi < 4; ++mi) af[mi] = *(const LAS bf16x8*)(sb + TG_A + (64 * wm + 16 * mi + fr) * 272 + 16 * fq + 64 * ks);
#pragma unroll
            for (int ni = 0; ni < 4; ++ni) bfr[ni] = *(const LAS bf16x8*)(sb + TG_B + (16 * ni + fr) * 272 + 16 * fq + 64 * ks);
#pragma unroll
            for (int mi = 0; mi < 4; ++mi)
#pragma unroll
                for (int ni = 0; ni < 4; ++ni) acc[mi][ni] = MFMA16(af[mi], bfr[ni], acc[mi][ni]);
            TG_SYNC();
        }
    }
#undef TG_ISSUE
#undef TG_FENCE
#undef TG_WRITE
#undef TG_SYNC
    asm volatile("s_waitcnt vmcnt(0) lgkmcnt(0)" ::: "memory"); __builtin_amdgcn_s_barrier(); asm volatile("" ::: "memory");
    LAS float* R = (LAS float*)lds;
#pragma unroll
    for (int mi = 0; mi < 4; ++mi)
#pragma unroll
        for (int ni = 0; ni < 4; ++ni)
#pragma unroll
            for (int r = 0; r < 4; ++r) R[ks * 8704 + (64 * wm + 16 * mi + 4 * fq + r) * 68 + 16 * ni + fr] = acc[mi][ni][r];
    __syncthreads();
    { const int row = tid >> 2, col0 = (tid & 3) * 16; f32x4 v[4];
#pragma unroll
      for (int k = 0; k < 4; ++k) { const LAS float* rp = R + row * 68 + col0 + 4 * k; v[k] = (*(const LAS f32x4*)(rp) + *(const LAS f32x4*)(rp + 8704)) + (*(const LAS f32x4*)(rp + 2 * 8704) + *(const LAS f32x4*)(rp + 3 * 8704)); }
      epi(row, col0, v); }
    __syncthreads();
}
constexpr int N_PHASES = 19;
__global__ void __launch_bounds__(NTHR, 2) fwd(Args a) {
    extern __shared__ __attribute__((aligned(16))) unsigned char lds_raw[];
    LAS unsigned char* lds = (LAS unsigned char*)lds_raw;
    const int tid0 = threadIdx.x;
    const int G = gridDim.x, c = blockIdx.x, NGW = G * NWAVES;
#define FRESH() int tid = tid0; asm volatile("" : "+v"(tid)); const int lane = tid & 63, wave = __builtin_amdgcn_readfirstlane(tid >> 6), gw = c * NWAVES + wave; (void)lane; (void)gw
    const int lo = a.ph_lo, hi = a.ph_hi;
    for (int u = tid0; u < (LDS_BYTES - LDSCTL_OFF) / 4; u += NTHR) ((LAS unsigned*)(lds + LDSCTL_OFF))[u] = 0u;
    __syncthreads();
    const bool use_bar = (hi - lo) > 1;
    XcdBarrier bar; bar.bar = (unsigned*)(a.ws + WS_CTL) + CW_BAR; bar.x = 0; bar.st = nullptr;
    if (use_bar) bar = xcd_barrier_post((unsigned*)(a.ws + WS_CTL) + CW_BAR, (volatile LAS unsigned*)(lds + MISC_OFF) + 8);
#define IN(k) (lo <= (k) && (k) < hi)
#define SEAM(k) do { if (IN(k) && IN((k) + 1)) xcd_barrier(bar); } while (0)
    float* X = a.out;
    float* RSA = (float*)(a.ws + WS_RSA); float* RSB = (float*)(a.ws + WS_RSB);
    bf16* XN = (bf16*)(a.ws + WS_XN); bf16* PROJ = (bf16*)(a.ws + WS_PROJ); bf16* MIX = (bf16*)(a.ws + WS_MIX); bf16* HID = (bf16*)(a.ws + WS_HID);
    float* PART = (float*)(a.ws + WS_PROJ);
    bf16* WIN = (bf16*)(a.ws + WS_WIN); bf16* WOUT = (bf16*)(a.ws + WS_WOUT); bf16* WUP = (bf16*)(a.ws + WS_WUP); bf16* WDN = (bf16*)(a.ws + WS_WDN);
    { constexpr int l = 0; constexpr int ph = 9 * l;
        if (IN(ph + 0)) { FRESH(); p0_weights(a, l, lds, gw, NGW, wave, lane);
            norm_phase(a.in[0], a.in[1], X, l == 0, a.in[6] + (size_t)l * D, XN, gw, NGW, lane); }
        SEAM(ph + 0);
        if (IN(ph + 1)) { FRESH(); pg8::Gemm g{XN, WIN, MPAD, NINP, D, 0, 1}; pg8::StaticOrder S; S.init(MPAD, NINP, G, c); pg8::EpiBf16<0> E{PROJ, NINP, 0, 0};
            pg8::gemm_phase<pg8::EpiBf16<0>, pg8::StaticOrder, true, true>(lds, g, S, E, tid);
            if (c >= 113) { LAS float* scr = (LAS float*)(lds + wave * 16384);
                convert_range(a, l, CV_SPLIT + (c - 113) * NWAVES + wave, CV_ITEMS, (G - 113) * NWAVES, scr, lane); } }
        SEAM(ph + 1);
        if (IN(ph + 2)) {
            { v2u xraw[19]; unsigned sraw = 0u; DInv inv; delta_inv_load(a, l, c & 15, tid0, inv); delta_issue(a, c, tid0, xraw, sraw);
              for (int u = c; u < NUNIT; u += G) delta_prepass_unit(a, l, u, u + G < NUNIT ? u + G : u, lds, tid0, xraw, sraw, inv); }
            { v2u xraw[7]; LInv inv; lru_inv_load(a, l, (G - 1 - c) & 15, tid0, inv); lru_issue(a, G - 1 - c, tid0, xraw);
              for (int u = (G - 1 - c); u < NUNIT; u += G) lru_prepass_unit(a, l, u, u + G < NUNIT ? u + G : u, lds, tid0, xraw, inv); }
        }
        SEAM(ph + 2);
        if (IN(ph + 3)) { FRESH(); seq_phase(a, l, c, lds, wave, lane); }
        SEAM(ph + 3);
        if (IN(ph + 4)) { { PostRaw raw; f32x4 wnd[4]; for (int q = 0; q < 4; ++q) wnd[q] = *(const GAS f32x4*)(a.in[11] + (size_t)l * 128 + 16 * (tid0 & 7) + 4 * q);
            delta_post_issue(a, c, tid0, raw); for (int u = c; u < NUNIT; u += G) delta_post_unit(a, l, u, u + G < NUNIT ? u + G : u, lds, tid0, raw, wnd); } FRESH(); post_phase(a, l, gw, NGW, lane); }
        SEAM(ph + 4);
        if (IN(ph + 5)) { FRESH(); pg8::Gemm g{MIX, WOUT, MP, D, D, 0, 1}; pg8::StaticOrder S; S.init(MP, D, G, c); pg8::EpiResid<true> E{l == 0 ? a.in[0] : X, X, D, XN, nullptr, 0.f, 0.f};
            pg8::gemm_phase<pg8::EpiResid<true>, pg8::StaticOrder, true, true>(lds, g, S, E, tid);
            if (l == 0 && (c & 3) != 0) { LAS float* scr = (LAS float*)(lds + wave * 16384);
                convert_range(a, 1, ((c >> 2) * 3 + (c & 3) - 1) * NWAVES + wave, I_IN + I_G, 192 * NWAVES, scr, lane); }
            if ((c & 3) == 0) { const int j = c >> 2;
                thin_gemm_unit(MIX + (size_t)MP * D, D, 0, 0, WOUT + (size_t)(j >> 2) * (D / 64) * 16384, 0, 1, (j & 3) * 64, D, lds, tid0, [&](int row, int col0, const f32x4 (&v)[4]) {
                    GAS f32x4* d = (GAS f32x4*)(X + (size_t)(MP + row) * D + 64 * j + col0); const GAS f32x4* bs = l == 0 ? (const GAS f32x4*)(a.in[1] + (size_t)row * D + 64 * j + col0) : (const GAS f32x4*)d;
                    f32x4 x[4];
                    for (int q = 0; q < 4; ++q) { x[q] = bs[q] + v[q]; d[q] = x[q]; }
                    v4u o0, o1; o0.x = pk2(x[0].x, x[0].y); o0.y = pk2(x[0].z, x[0].w); o0.z = pk2(x[1].x, x[1].y); o0.w = pk2(x[1].z, x[1].w); o1.x = pk2(x[2].x, x[2].y); o1.y = pk2(x[2].z, x[2].w); o1.z = pk2(x[3].x, x[3].y); o1.w = pk2(x[3].z, x[3].w);
                    GAS v4u* xb = (GAS v4u*)(XN + (size_t)(MP + row) * D + 64 * j + col0); xb[0] = o0; xb[1] = o1; }); } }
        SEAM(ph + 5);
        if (IN(ph + 7)) { FRESH(); rowss_phase(XN, RSB, 0, MR, gw, NGW, lane);
            pg8::Gemm g{XN, WUP, MP, DFF, D, 0, 1}; pg8::StaticOrder S; S.init(MP, DFF, G, c); pg8::EpiBf16<1> E{HID, DFF, DFF / 64, 1};
            pg8::gemm_phase<pg8::EpiBf16<1>, pg8::StaticOrder, true, true>(lds, g, S, E, tid);
            for (int j = c; j < DFF / 64; j += G)
                thin_gemm_unit(XN + (size_t)MP * D, D, 0, 0, WUP + (size_t)(j >> 2) * (D / 64) * 16384, 0, 1, (j & 3) * 64, D, lds, tid0, [&](int row, int col0, const f32x4 (&v)[4]) {
                    float r[16];
                    for (int q = 0; q < 4; ++q) for (int e = 0; e < 4; ++e) { const float t = fmaxf(v[q][e], 0.f); r[4 * q + e] = t * t; }
                    v4u o0, o1; o0.x = pk2(r[0], r[1]); o0.y = pk2(r[2], r[3]); o0.z = pk2(r[4], r[5]); o0.w = pk2(r[6], r[7]); o1.x = pk2(r[8], r[9]); o1.y = pk2(r[10], r[11]); o1.z = pk2(r[12], r[13]); o1.w = pk2(r[14], r[15]);
                    GAS v4u* d = (GAS v4u*)(HID + ((size_t)(MP / 256) * (DFF / 64) + j) * 16384 + (size_t)row * 64 + col0); d[0] = o0; d[1] = o1; }); }
        SEAM(ph + 7);
        if (IN(ph + 8)) { FRESH(); pg8::Gemm g{HID, WDN, MP, D, DFF, 1, 1};     pg8::DownOrder S; S.init(c);
            { pg8::EpiResid<false> E{X, X, D, nullptr, RSB, 1.f / D, EPS}; pg8::gemm_phase<pg8::EpiResid<false>, pg8::DownOrder, true, true>(lds, g, S, E, tid); }
            for (int uu = c; uu < 256; uu += G) { const int j = uu >> 2, ks = uu & 3;
                thin_gemm_unit(HID + ((size_t)(MP / 256) * (DFF / 64) + ks * 64) * 16384, 0, 1, 0, WDN + ((size_t)(j >> 2) * (DFF / 64) + ks * 64) * 16384, 0, 1, (j & 3) * 64, 4096, lds, tid0, [&](int row, int col0, const f32x4 (&v)[4]) {
                    GAS f32x4* d = (GAS f32x4*)(PART + ((size_t)ks * MS + row) * D + 64 * j + col0);
                    for (int q = 0; q < 4; ++q) d[q] = v[q]; }); }
            if (use_bar) xcd_barrier(bar);
            { const int row = gw >> 4, seg = gw & 15; const float sc = __builtin_amdgcn_rcpf(*(const GAS float*)(RSB + MP + row) * (1.f / D) + EPS);
              GAS f32x4* xr = (GAS f32x4*)(X + (size_t)(MP + row) * D) + 64 * seg + lane; const GAS f32x4* pr = (const GAS f32x4*)(PART + (size_t)row * D) + 64 * seg + lane;
              const f32x4 x = *xr, p0 = pr[0], p1 = pr[(size_t)MS * D / 4], p2 = pr[(size_t)2 * MS * D / 4], p3 = pr[(size_t)3 * MS * D / 4];
              *xr = x + ((p0 + p1) + (p2 + p3)) * sc; } }
        SEAM(ph + 8);
    }
    { constexpr int l = 1; constexpr int ph = 9 * l;
        if (IN(ph + 0)) { FRESH(); p0_weights(a, l, lds, gw, NGW, wave, lane);
            norm_phase(a.in[0], a.in[1], X, l == 0, a.in[6] + (size_t)l * D, XN, gw, NGW, lane); }
        SEAM(ph + 0);
        if (IN(ph + 1)) { FRESH(); pg8::Gemm g{XN, WIN, MPAD, NINP, D, 0, 1}; pg8::StaticOrder S; S.init(MPAD, NINP, G, c); pg8::EpiBf16<0> E{PROJ, NINP, 0, 0};
            pg8::gemm_phase<pg8::EpiBf16<0>, pg8::StaticOrder, true, true>(lds, g, S, E, tid);
            if (c >= 113) { LAS float* scr = (LAS float*)(lds + wave * 16384);
                convert_range(a, l, CV_SPLIT + (c - 113) * NWAVES + wave, CV_ITEMS, (G - 113) * NWAVES, scr, lane); } }
        SEAM(ph + 1);
        if (IN(ph + 2)) {
            { v2u xraw[19]; unsigned sraw = 0u; DInv inv; delta_inv_load(a, l, c & 15, tid0, inv); delta_issue(a, c, tid0, xraw, sraw);
              for (int u = c; u < NUNIT; u += G) delta_prepass_unit(a, l, u, u + G < NUNIT ? u + G : u, lds, tid0, xraw, sraw, inv); }
            { v2u xraw[7]; LInv inv; lru_inv_load(a, l, (G - 1 - c) & 15, tid0, inv); lru_issue(a, G - 1 - c, tid0, xraw);
              for (int u = (G - 1 - c); u < NUNIT; u += G) lru_prepass_unit(a, l, u, u + G < NUNIT ? u + G : u, lds, tid0, xraw, inv); }
        }
        SEAM(ph + 2);
        if (IN(ph + 3)) { FRESH(); seq_phase(a, l, c, lds, wave, lane); }
        SEAM(ph + 3);
        if (IN(ph + 4)) { { PostRaw raw; f32x4 wnd[4]; for (int q = 0; q < 4; ++q) wnd[q] = *(const GAS f32x4*)(a.in[11] + (size_t)l * 128 + 16 * (tid0 & 7) + 4 * q);
            delta_post_issue(a, c, tid0, raw); for (int u = c; u < NUNIT; u += G) delta_post_unit(a, l, u, u + G < NUNIT ? u + G : u, lds, tid0, raw, wnd); } FRESH(); post_phase(a, l, gw, NGW, lane); }
        SEAM(ph + 4);
        if (IN(ph + 5)) { FRESH(); pg8::Gemm g{MIX, WOUT, MP, D, D, 0, 1}; pg8::StaticOrder S; S.init(MP, D, G, c); pg8::EpiResid<true> E{l == 0 ? a.in[0] : X, X, D, XN, nullptr, 0.f, 0.f};
            pg8::gemm_phase<pg8::EpiResid<true>, pg8::StaticOrder, true, true>(lds, g, S, E, tid);
            if ((c & 3) == 0) { const int j = c >> 2;
                thin_gemm_unit(MIX + (size_t)MP * D, D, 0, 0, WOUT + (size_t)(j >> 2) * (D / 64) * 16384, 0, 1, (j & 3) * 64, D, lds, tid0, [&](int row, int col0, const f32x4 (&v)[4]) {
                    GAS f32x4* d = (GAS f32x4*)(X + (size_t)(MP + row) * D + 64 * j + col0); const GAS f32x4* bs = l == 0 ? (const GAS f32x4*)(a.in[1] + (size_t)row * D + 64 * j + col0) : (const GAS f32x4*)d;
                    f32x4 x[4];
                    for (int q = 0; q < 4; ++q) { x[q] = bs[q] + v[q]; d[q] = x[q]; }
                    v4u o0, o1; o0.x = pk2(x[0].x, x[0].y); o0.y = pk2(x[0].z, x[0].w); o0.z = pk2(x[1].x, x[1].y); o0.w = pk2(x[1].z, x[1].w); o1.x = pk2(x[2].x, x[2].y); o1.y = pk2(x[2].z, x[2].w); o1.z = pk2(x[3].x, x[3].y); o1.w = pk2(x[3].z, x[3].w);
                    GAS v4u* xb = (GAS v4u*)(XN + (size_t)(MP + row) * D + 64 * j + col0); xb[0] = o0; xb[1] = o1; }); } }
        SEAM(ph + 5);
        if (IN(ph + 7)) { FRESH(); rowss_phase(XN, RSB, 0, MR, gw, NGW, lane);
            pg8::Gemm g{XN, WUP, MP, DFF, D, 0, 1}; pg8::StaticOrder S; S.init(MP, DFF, G, c); pg8::EpiBf16<1> E{HID, DFF, DFF / 64, 1};
            pg8::gemm_phase<pg8::EpiBf16<1>, pg8::StaticOrder, true, true>(lds, g, S, E, tid);
            for (int j = c; j < DFF / 64; j += G)
                thin_gemm_unit(XN + (size_t)MP * D, D, 0, 0, WUP + (size_t)(j >> 2) * (D / 64) * 16384, 0, 1, (j & 3) * 64, D, lds, tid0, [&](int row, int col0, const f32x4 (&v)[4]) {
                    float r[16];
                    for (int q = 0; q < 4; ++q) for (int e = 0; e < 4; ++e) { const float t = fmaxf(v[q][e], 0.f); r[4 * q + e] = t * t; }
                    v4u o0, o1; o0.x = pk2(r[0], r[1]); o0.y = pk2(r[2], r[3]); o0.z = pk2(r[4], r[5]); o0.w = pk2(r[6], r[7]); o1.x = pk2(r[8], r[9]); o1.y = pk2(r[10], r[11]); o1.z = pk2(r[12], r[13]); o1.w = pk2(r[14], r[15]);
                    GAS v4u* d = (GAS v4u*)(HID + ((size_t)(MP / 256) * (DFF / 64) + j) * 16384 + (size_t)row * 64 + col0); d[0] = o0; d[1] = o1; }); }
        SEAM(ph + 7);
        if (IN(ph + 8)) { FRESH(); pg8::Gemm g{HID, WDN, MP, D, DFF, 1, 1};     pg8::DownOrder S; S.init(c);
            { pg8::EpiResid<false> E{X, X, D, nullptr, RSB, 1.f / D, EPS}; pg8::gemm_phase<pg8::EpiResid<false>, pg8::DownOrder, true, true>(lds, g, S, E, tid); }
            for (int uu = c; uu < 256; uu += G) { const int j = uu >> 2, ks = uu & 3;
                thin_gemm_unit(HID + ((size_t)(MP / 256) * (DFF / 64) + ks * 64) * 16384, 0, 1, 0, WDN + ((size_t)(j >> 2) * (DFF / 64) + ks * 64) * 16384, 0, 1, (j & 3) * 64, 4096, lds, tid0, [&](int row, int col0, const f32x4 (&v)[4]) {
                    GAS f32x4* d = (GAS f32x4*)(PART + ((size_t)ks * MS + row) * D + 64 * j + col0);
                    for (int q = 0; q < 4; ++q) d[q] = v[q]; }); }
            if (use_bar) xcd_barrier(bar);
            { const int row = gw >> 4, seg = gw & 15; const float sc = __builtin_amdgcn_rcpf(*(const GAS float*)(RSB + MP + row) * (1.f / D) + EPS);
              GAS f32x4* xr = (GAS f32x4*)(X + (size_t)(MP + row) * D) + 64 * seg + lane; const GAS f32x4* pr = (const GAS f32x4*)(PART + (size_t)row * D) + 64 * seg + lane;
              const f32x4 x = *xr, p0 = pr[0], p1 = pr[(size_t)MS * D / 4], p2 = pr[(size_t)2 * MS * D / 4], p3 = pr[(size_t)3 * MS * D / 4];
              *xr = x + ((p0 + p1) + (p2 + p3)) * sc; } }
        SEAM(ph + 8);
    }
    if (IN(18)) { FRESH(); final_norm_phase(a, gw, NGW, lane); }
#undef IN
#undef SEAM
}

#ifndef PROBE_PH
#define PROBE_PH -1
#endif
#ifndef MK_SPLIT
#define MK_SPLIT 0
#endif
extern "C" void kernel_launch(void* const* d_in, const int* in_sizes, int n_in, void* d_out, int out_size, void* d_ws, size_t ws_size, hipStream_t stream) {
    static int grid = 0;
    if (grid == 0) {
        if (n_in != 25 || (size_t)out_size != O_END || ws_size < WS_END) { fprintf(stderr, "kernel_launch: unexpected sizes n_in %d out %d ws %zu (need %zu)\n", n_in, out_size, ws_size, (size_t)WS_END); grid = -1; return; }
        int dev = 0, cus = 0, per_cu = 0;
        if (hipGetDevice(&dev) != hipSuccess || hipDeviceGetAttribute(&cus, hipDeviceAttributeMultiprocessorCount, dev) != hipSuccess) { grid = -1; return; }
        if (hipFuncSetAttribute((const void*)fwd, hipFuncAttributeMaxDynamicSharedMemorySize, LDS_BYTES) != hipSuccess) { fprintf(stderr, "kernel_launch: hipFuncSetAttribute failed\n"); grid = -1; return; }
        if (hipOccupancyMaxActiveBlocksPerMultiprocessor(&per_cu, (const void*)fwd, NTHR, LDS_BYTES) != hipSuccess || per_cu < 1) fprintf(stderr, "kernel_launch: occupancy query reports %d\n", per_cu);
        (void)hipGetLastError();
        if (cus != 256) { fprintf(stderr, "kernel_launch: built for a 256-CU device (one workgroup per CU), found %d\n", cus); grid = -1; return; }
        grid = cus;
    }
    if (grid < 0) return;
    if (hipMemsetAsync((char*)d_ws + WS_CTL, 0, CTL_ZERO_BYTES, stream) != hipSuccess) return;
    Args a{};
    for (int i = 0; i < 25; ++i) a.in[i] = (const float*)d_in[i];
    a.out = (float*)d_out; a.ws = (unsigned char*)d_ws;
#if MK_SPLIT
    for (int k = 0; k < N_PHASES; ++k) { a.ph_lo = k; a.ph_hi = k + 1; hipLaunchKernelGGL(fwd, dim3(grid), dim3(NTHR), LDS_BYTES, stream, a);
        if (k < 18 && (k % 9) == PROBE_PH) hipLaunchKernelGGL(fwd, dim3(grid), dim3(NTHR), LDS_BYTES, stream, a); }
#else
    a.ph_lo = 0; a.ph_hi = N_PHASES; hipLaunchKernelGGL(fwd, dim3(grid), dim3(NTHR), LDS_BYTES, stream, a);
#endif
}
```
